# Optimizing an MI355X kernel written in HIP

```python
import math
import jax
import jax.numpy as jnp
from jax import lax
import numpy as np

D_MODEL = 1024
BATCH = 2
SEQ = 8192
DEPTH = 1

HEAD_DIM = 64
NSA_HEADS = 8
NSA_KV_GROUPS = 2
NSA_HPG = NSA_HEADS // NSA_KV_GROUPS
RWKV_HEADS = 8
D_NSA = NSA_HEADS * HEAD_DIM
D_RWKV = RWKV_HEADS * HEAD_DIM
D_MIX = D_NSA + D_RWKV
D_KV = NSA_KV_GROUPS * HEAD_DIM
CMP_BLOCK = 32
CMP_STRIDE = 16
CMP_HIDDEN = 128
SEL_BLOCK = 64
SEL_TOPN = 16
WINDOW = 512
Q_BLOCK = 128
N_BUCKETS = 32
MAX_DISTANCE = 128
LORA_W = 64
LORA_A = 64
LORA_G = 128
D_FF = 2816
CONV_W = 3
NORM_EPS = 1e-6
GN_EPS = 64e-5
NEG_INF = -1e30
FORCE_SCORE = 1e9
NSA_SPLITS = (D_NSA, D_KV, D_KV, D_KV, D_KV, D_KV, D_KV, 3 * NSA_HEADS)
RWKV_SPLITS = (D_RWKV, D_RWKV, D_RWKV, LORA_W, LORA_A, LORA_G)
D_NSA_IN = sum(NSA_SPLITS)
D_RWKV_IN = sum(RWKV_SPLITS)
D_IN = D_NSA_IN + D_RWKV_IN

kernel_name = 'hymba_nsa_rwkv7_convffn'


def rmsnorm(x, g, eps=NORM_EPS):
    xf = x.astype(jnp.float32)
    y = xf * lax.rsqrt(jnp.mean(xf * xf, axis=-1, keepdims=True) + eps)
    return (y * g).astype(x.dtype)


def t5_bucket(dist):
    n = jnp.maximum(dist, 0)
    max_exact = N_BUCKETS // 2
    nf = jnp.maximum(n, 1).astype(jnp.float32)
    large = max_exact + (jnp.log(nf / max_exact) / math.log(MAX_DISTANCE / max_exact)
                         * (N_BUCKETS - max_exact)).astype(jnp.int32)
    large = jnp.minimum(large, N_BUCKETS - 1)
    return jnp.where(n < max_exact, n, large)


def token_shift(z):
    return jnp.pad(z, ((0, 0), (1, 0), (0, 0)))[:, :-1]


def causal_dwconv(z, w, b):
    T = z.shape[1]
    zp = jnp.pad(z, ((0, 0), (CONV_W - 1, 0), (0, 0)))
    return b + sum(zp[:, i:i + T] * w[i] for i in range(CONV_W))


def compress(kv, pos, w1, b1, w2, b2):
    B, T, G, dh = kv.shape
    nc = (T - CMP_BLOCK) // CMP_STRIDE + 1
    idx = jnp.arange(nc)[:, None] * CMP_STRIDE + jnp.arange(CMP_BLOCK)[None, :]
    blk = kv[:, idx] + pos[None, None, :, None, :]
    blk = blk.transpose(0, 1, 3, 2, 4).reshape(B, nc, G, CMP_BLOCK * dh)
    return jax.nn.gelu(blk @ w1 + b1) @ w2 + b2


def nsa_attention(q, k_cmp, v_cmp, k_sel, v_sel, k_win, v_win, gates, rel_bias):
    B, T = q.shape[0], q.shape[1]
    G, R, dh = NSA_KV_GROUPS, NSA_HPG, HEAD_DIM
    nc = k_cmp.shape[1]
    ns = T // SEL_BLOCK
    n_top = min(SEL_TOPN, ns)
    scale = dh ** -0.5
    bias_grq = rel_bias.reshape(N_BUCKETS, G, R)
    bias_gbr = bias_grq.transpose(1, 0, 2)
    cmp_start = jnp.arange(nc) * CMP_STRIDE
    cmp_end = cmp_start + CMP_BLOCK - 1
    sel_start = jnp.arange(ns) * SEL_BLOCK
    overlap = ((cmp_start[:, None] < sel_start[None, :] + SEL_BLOCK)
               & (cmp_end[:, None] >= sel_start[None, :])).astype(jnp.float32)
    ks_blk = k_sel.reshape(B, ns, SEL_BLOCK, G, dh).transpose(0, 3, 1, 2, 4)
    vs_blk = v_sel.reshape(B, ns, SEL_BLOCK, G, dh).transpose(0, 3, 1, 2, 4)
    kw_pad = jnp.pad(k_win, ((0, 0), (WINDOW, 0), (0, 0), (0, 0)))
    vw_pad = jnp.pad(v_win, ((0, 0), (WINDOW, 0), (0, 0), (0, 0)))
    b_ix = jnp.arange(B)[:, None, None, None]
    g_ix = jnp.arange(G)[None, :, None, None]
    blk_ix = jnp.arange(SEL_BLOCK)
    win_ix = jnp.arange(Q_BLOCK + WINDOW)
    sel_ix = jnp.arange(ns)[None, :]

    def query_block(qb):
        q0 = qb * Q_BLOCK
        t = q0 + jnp.arange(Q_BLOCK)
        qq = lax.dynamic_slice_in_dim(q, q0, Q_BLOCK, axis=1).reshape(B, Q_BLOCK, G, R, dh)
        gg = lax.dynamic_slice_in_dim(gates, q0, Q_BLOCK, axis=1).reshape(B, Q_BLOCK, G, R, 3)

        d_c = t[:, None] - cmp_end[None, :]
        m_c = d_c >= 0
        l_c = (jnp.einsum('bqgrd,bcgd->bgrqc', qq, k_cmp).astype(jnp.float32) * scale
               + bias_grq[t5_bucket(d_c)].transpose(2, 3, 0, 1))
        p_c = jax.nn.softmax(jnp.where(m_c, l_c, NEG_INF), axis=-1) * m_c
        o_c = jnp.einsum('bgrqc,bcgd->bqgrd', p_c.astype(v_cmp.dtype), v_cmp)

        imp = jnp.einsum('bgrqc,cn->bgqn', p_c, overlap)
        cur = (t // SEL_BLOCK)[:, None]
        forced = (sel_ix == 0) | (sel_ix == cur) | (sel_ix == cur - 1)
        score = jnp.where(sel_start[None, :] <= t[:, None],
                          jnp.where(forced, FORCE_SCORE, imp), NEG_INF)
        _, top_idx = lax.top_k(score, n_top)
        k_s = ks_blk[b_ix, g_ix, top_idx].reshape(B, G, Q_BLOCK, n_top * SEL_BLOCK, dh)
        v_s = vs_blk[b_ix, g_ix, top_idx].reshape(B, G, Q_BLOCK, n_top * SEL_BLOCK, dh)
        s_pos = (top_idx[..., None] * SEL_BLOCK + blk_ix).reshape(B, G, Q_BLOCK, n_top * SEL_BLOCK)
        d_s = t[None, None, :, None] - s_pos
        m_s = (d_s >= 0)[:, :, None]
        l_s = (jnp.einsum('bqgrd,bgqkd->bgrqk', qq, k_s).astype(jnp.float32) * scale
               + bias_gbr[g_ix, t5_bucket(d_s)].transpose(0, 1, 4, 2, 3))
        p_s = jax.nn.softmax(jnp.where(m_s, l_s, NEG_INF), axis=-1)
        o_s = jnp.einsum('bgrqk,bgqkd->bqgrd', p_s.astype(v_s.dtype), v_s)

        k_w = lax.dynamic_slice_in_dim(kw_pad, q0, Q_BLOCK + WINDOW, axis=1)
        v_w = lax.dynamic_slice_in_dim(vw_pad, q0, Q_BLOCK + WINDOW, axis=1)
        s_w = q0 - WINDOW + win_ix
        d_w = t[:, None] - s_w[None, :]
        m_w = (d_w >= 0) & (d_w < WINDOW) & (s_w[None, :] >= 0)
        l_w = (jnp.einsum('bqgrd,bkgd->bgrqk', qq, k_w).astype(jnp.float32) * scale
               + bias_grq[t5_bucket(d_w)].transpose(2, 3, 0, 1))
        p_w = jax.nn.softmax(jnp.where(m_w, l_w, NEG_INF), axis=-1)
        o_w = jnp.einsum('bgrqk,bkgd->bqgrd', p_w.astype(v_w.dtype), v_w)

        o = gg[..., 0:1] * o_c + gg[..., 1:2] * o_s + gg[..., 2:3] * o_w
        return o.reshape(B, Q_BLOCK, D_NSA)

    out = lax.map(query_block, jnp.arange(T // Q_BLOCK))
    return out.transpose(1, 0, 2, 3).reshape(B, T, D_NSA)


def _wkv7_step(state, inp):
    r, w, k, v, a, b = inp
    sa = jnp.einsum('bhvk,bhk->bhv', state, a)
    state = state * w[:, :, None, :] + sa[..., None] * b[:, :, None, :] + v[..., None] * k[:, :, None, :]
    return state, jnp.einsum('bhvk,bhk->bhv', state, r)


def rwkv7_time_mix(feats, w0, w2, a0, a2, g2, k_k, k_a, r_k, ln_w, ln_b):
    B, T, _ = feats.shape
    H, N = RWKV_HEADS, HEAD_DIM
    r, k, v, xw, xa, xg = jnp.split(feats, np.cumsum(RWKV_SPLITS)[:-1].tolist(), axis=-1)
    w = -jax.nn.softplus(-(w0 + jnp.tanh(xw) @ w2)) - 0.5
    decay = jnp.exp(-jnp.exp(w.astype(jnp.float32)))
    a = jax.nn.sigmoid(a0 + xa @ a2)
    g = jax.nn.sigmoid(xg) @ g2

    def heads(z):
        return z.reshape(B, T, H, N).astype(jnp.float32)

    kk = heads(k * k_k)
    kk = kk / jnp.maximum(jnp.sqrt(jnp.sum(kk * kk, axis=-1, keepdims=True)), 1e-12)
    k = k * (1.0 + (a - 1.0) * k_a)
    rh, kh, vh, ah = heads(r), heads(k), heads(v), heads(a)
    xs = tuple(z.transpose(1, 0, 2, 3) for z in (rh, heads(decay), kh, vh, -kk, kk * ah))
    state0 = jnp.zeros((B, H, N, N), jnp.float32)
    _, y = lax.scan(_wkv7_step, state0, xs)
    y = y.transpose(1, 0, 2, 3)
    mu = jnp.mean(y, axis=-1, keepdims=True)
    var = jnp.mean(jnp.square(y - mu), axis=-1, keepdims=True)
    y = ((y - mu) * lax.rsqrt(var + GN_EPS)).reshape(B, T, D_RWKV) * ln_w + ln_b
    bonus = jnp.sum(rh * kh * r_k, axis=-1, keepdims=True) * vh
    y = (y + bonus.reshape(B, T, D_RWKV)) * g
    return y.astype(feats.dtype)


def setup_inputs(seed: int = 0) -> dict:
    key = jax.random.key(seed)
    ks = list(jax.random.split(key, 32))
    L = DEPTH

    def nrm(shape, scale):
        return scale * jax.random.normal(ks.pop(), shape, jnp.float32)

    def unif(shape, lo, hi):
        return jax.random.uniform(ks.pop(), shape, jnp.float32, minval=lo, maxval=hi)

    return {
        'x': nrm((BATCH, SEQ, D_MODEL), 1.0),
        'norm1_g': 1.0 + nrm((L, D_MODEL), 0.02),
        'w_in': nrm((L, D_MODEL, D_IN), D_MODEL ** -0.5),
        'q_norm_g': 1.0 + nrm((L, HEAD_DIM), 0.02),
        'k_norm_g': 1.0 + nrm((L, 3, HEAD_DIM), 0.02),
        'cmp_pos': nrm((L, 2, CMP_BLOCK, HEAD_DIM), 0.02),
        'cmp_w1': nrm((L, 2, CMP_BLOCK * HEAD_DIM, CMP_HIDDEN), (CMP_BLOCK * HEAD_DIM) ** -0.5),
        'cmp_b1': nrm((L, 2, CMP_HIDDEN), 0.02),
        'cmp_w2': nrm((L, 2, CMP_HIDDEN, HEAD_DIM), CMP_HIDDEN ** -0.5),
        'cmp_b2': nrm((L, 2, HEAD_DIM), 0.02),
        'rel_bias': nrm((N_BUCKETS, NSA_HEADS), 0.5),
        'rwkv_mu': unif((L, D_RWKV_IN), 0.0, 1.0),
        'w0': unif((L, D_RWKV), -6.0, -1.0),
        'w2': nrm((L, LORA_W, D_RWKV), 0.1 * LORA_W ** -0.5),
        'a0': nrm((L, D_RWKV), 0.1),
        'a2': nrm((L, LORA_A, D_RWKV), 0.5 * LORA_A ** -0.5),
        'g2': nrm((L, LORA_G, D_RWKV), LORA_G ** -0.5),
        'k_k': 0.85 + nrm((L, D_RWKV), 0.02),
        'k_a': 1.0 + nrm((L, D_RWKV), 0.02),
        'r_k': nrm((L, RWKV_HEADS, HEAD_DIM), 0.1),
        'ln_x_w': 1.0 + nrm((L, D_RWKV), 0.02),
        'ln_x_b': nrm((L, D_RWKV), 0.02),
        'w_out': nrm((L, D_MIX, D_MODEL), D_MIX ** -0.5),
        'norm2_g': 1.0 + nrm((L, D_MODEL), 0.02),
        'ffn_up': nrm((L, D_MODEL, 2 * D_FF), D_MODEL ** -0.5),
        'conv_w': nrm((L, CONV_W, 2 * D_FF), CONV_W ** -0.5),
        'conv_b': nrm((L, 2 * D_FF), 0.02),
        'ffn_down': nrm((L, D_FF, D_MODEL), D_FF ** -0.5),
    }


def reference(x, norm1_g, w_in, q_norm_g, k_norm_g, cmp_pos, cmp_w1, cmp_b1, cmp_w2, cmp_b2,
              rel_bias, rwkv_mu, w0, w2, a0, a2, g2, k_k, k_a, r_k, ln_x_w, ln_x_b,
              w_out, norm2_g, ffn_up, conv_w, conv_b, ffn_down):
    B, T, _ = x.shape
    G, H, dh = NSA_KV_GROUPS, NSA_HEADS, HEAD_DIM
    nsa_cuts = np.cumsum(NSA_SPLITS)[:-1].tolist()

    def kv_heads(z):
        return z.reshape(B, T, G, dh)

    for l in range(DEPTH):
        h = rmsnorm(x, norm1_g[l])
        proj = h @ w_in[l]
        q, kc, vc, ksl, vsl, kwn, vwn, gl = jnp.split(proj[..., :D_NSA_IN], nsa_cuts, axis=-1)
        q = rmsnorm(q.reshape(B, T, H, dh), q_norm_g[l])
        k_cmp = rmsnorm(compress(kv_heads(kc), cmp_pos[l, 0], cmp_w1[l, 0], cmp_b1[l, 0],
                                 cmp_w2[l, 0], cmp_b2[l, 0]), k_norm_g[l, 0])
        v_cmp = compress(kv_heads(vc), cmp_pos[l, 1], cmp_w1[l, 1], cmp_b1[l, 1],
                         cmp_w2[l, 1], cmp_b2[l, 1])
        k_sel = rmsnorm(kv_heads(ksl), k_norm_g[l, 1])
        k_win = rmsnorm(kv_heads(kwn), k_norm_g[l, 2])
        gates = jax.nn.sigmoid(gl).reshape(B, T, H, 3)
        o_nsa = nsa_attention(q, k_cmp, v_cmp, k_sel, kv_heads(vsl), k_win, kv_heads(vwn),
                              gates, rel_bias)

        rw = proj[..., D_NSA_IN:]
        rw = rw + (token_shift(rw) - rw) * rwkv_mu[l]
        o_rwkv = rwkv7_time_mix(rw, w0[l], w2[l], a0[l], a2[l], g2[l], k_k[l], k_a[l],
                                r_k[l], ln_x_w[l], ln_x_b[l])
        x = x + jnp.concatenate([o_nsa, o_rwkv], axis=-1) @ w_out[l]

        h = rmsnorm(x, norm2_g[l])
        u = causal_dwconv(h @ ffn_up[l], conv_w[l], conv_b[l])
        u_val, u_gate = jnp.split(u, 2, axis=-1)
        x = x + (jax.nn.silu(u_gate) * u_val) @ ffn_down[l]
    return x
```

```cpp
#include <hip/hip_runtime.h>
#include <hip/hip_cooperative_groups.h>
#include <cstdio>
#include <cstdint>
namespace cg = cooperative_groups;
namespace pg8 {
#define PG8_LAS __attribute__((address_space(3)))
typedef unsigned short bf16_t;
typedef short bf16x8 __attribute__((ext_vector_type(8)));
typedef float f32x4 __attribute__((ext_vector_type(4)));
typedef unsigned u32x4 __attribute__((ext_vector_type(4)));
constexpr int BM = 256, BK = 64, HALF = 128, HTB = HALF * BK * 2  , STAGE_BYTES = 8 * HTB, NXCD = 8, WGM = 8;

__host__ __device__ __forceinline__ int lds_byte(int r, int c) { const int st = (r >> 4) * 2 + (c >> 5), rr = r & 15, cc = c & 31, ob = rr * 64 + cc * 2; return st * 1024 + (ob ^ (((ob >> 9) & 1) << 5)); }
__host__ __device__ __forceinline__ void stage_rc(int b, int& R, int& C) { const int st = b / 1024, sb = b % 1024, swz = sb ^ (((sb >> 9) & 1) << 5); R = (st >> 1) * 16 + swz / 64; C = (st & 1) * 32 + (swz % 64) / 2; }
__host__ __device__ __forceinline__ int perm32(int rho) { const int n = rho >> 4, i = rho & 15; return 8 * (i >> 2) + 4 * n + (i & 3); }

struct Unit { int pm, pn; };
struct Gemm { const bf16_t* A; const bf16_t* Bt; int M, N, K; };

struct StaticOrder {
    int nM, nN, nwg, G, c;
    __host__ __device__ void init(int M, int N, int G_, int c_) { nM = M / BM; nN = N / BM; nwg = nM * nN; G = G_; c = c_; }
    __host__ __device__ bool next(int i, Unit& u) const {
        const long L = (long)i * G + c; if (L >= nwg) return false;
        int wgid = (int)L; { const int q = nwg / NXCD, r = nwg % NXCD, xcd = wgid % NXCD, off = wgid / NXCD; wgid = (xcd < r ? xcd * (q + 1) : r * (q + 1) + (xcd - r) * q) + off; }
        const int nig = WGM * nN, gid = wgid / nig, fm = gid * WGM, gsz = (nM - fm) < WGM ? (nM - fm) : WGM;
        u.pm = fm + ((wgid % nig) % gsz); u.pn = (wgid % nig) / gsz; return true;
    }
    __device__ __forceinline__ void a_ready(const Unit&) const {}
    __device__ __forceinline__ void done(const Unit&) const {}
};

__device__ __forceinline__ unsigned cvt_pk_bf16(float lo, float hi) { unsigned r; asm volatile("v_cvt_pk_bf16_f32 %0, %1, %2" : "=v"(r) : "v"(lo), "v"(hi)); return r; }
typedef float f32x2 __attribute__((ext_vector_type(2)));
__device__ __forceinline__ f32x2 gelu_pk(f32x2 v) {
    const f32x2 av = __builtin_elementwise_abs(v), d = av * 0.2316418882f + 1.0f;
    f32x2 t; t.x = __builtin_amdgcn_rcpf(d.x); t.y = __builtin_amdgcn_rcpf(d.y);
    f32x2 q = t * 0.5307027145f + (-0.7265760135f); q = q * t + 0.7107068705f; q = q * t + (-0.142248368f); q = q * t + 0.127414796f; q = q * t;
    const f32x2 s = (v * v) * (-0.72134752044f);
    f32x2 e; e.x = __builtin_amdgcn_exp2f(s.x); e.y = __builtin_amdgcn_exp2f(s.y);
    const f32x2 m = v * (q * e), r = v - m;
    f32x2 o; o.x = v.x < 0.f ? m.x : r.x; o.y = v.y < 0.f ? m.y : r.y; return o;
}

template <int ACT  > struct EpiBf16 {
    static constexpr bool PERM = true, AFTER_DRAIN = false; static_assert(ACT == 0 || ACT == 1, "EpiBf16: ACT is 0 (none) or 1 (gelu_pk)");
    bf16_t* O; int ldc; const float* bias; int split_cols; size_t split_stride; float scale0;
    __device__ __forceinline__ void operator()(const f32x4 (&acc)[2][2][4][2], const Unit& u, int wr, int wc, int fr, int fq) const {
        const int row0 = u.pm * BM + wr * 64 + fr; int colt = u.pn * BM; bf16_t* base = O;
        float sc = 1.f; if (split_cols) { const int t = colt / split_cols; base += (size_t)t * split_stride; colt -= t * split_cols; if (t == 0) sc = scale0; }
        const int col0 = colt + wc * 32 + 8 * fq, bcol0 = u.pn * BM + wc * 32 + 8 * fq;
        f32x4 bv[2][2];
#pragma unroll
        for (int bj = 0; bj < 2; ++bj)
#pragma unroll
            for (int n = 0; n < 2; ++n) bv[bj][n] = bias ? *(const f32x4*)(bias + bcol0 + bj * HALF + 4 * n) : (f32x4){0.f, 0.f, 0.f, 0.f};
#pragma unroll
        for (int ai = 0; ai < 2; ++ai)
#pragma unroll
            for (int m = 0; m < 4; ++m) { bf16_t* rowp = base + (size_t)(row0 + ai * HALF + m * 16) * ldc + col0;
#pragma unroll
                for (int bj = 0; bj < 2; ++bj) { f32x4 v0 = acc[ai][bj][m][0] + bv[bj][0], v1 = acc[ai][bj][m][1] + bv[bj][1];
                    if (ACT == 1) { f32x2 a = gelu_pk((f32x2){v0[0], v0[1]}), b = gelu_pk((f32x2){v0[2], v0[3]}), c = gelu_pk((f32x2){v1[0], v1[1]}), d = gelu_pk((f32x2){v1[2], v1[3]});
                        v0 = (f32x4){a.x, a.y, b.x, b.y}; v1 = (f32x4){c.x, c.y, d.x, d.y}; }
                    v0 = v0 * sc; v1 = v1 * sc; u32x4 w; w.x = cvt_pk_bf16(v0[0], v0[1]); w.y = cvt_pk_bf16(v0[2], v0[3]); w.z = cvt_pk_bf16(v1[0], v1[1]); w.w = cvt_pk_bf16(v1[2], v1[3]);
                    *(u32x4*)(rowp + bj * HALF) = w; } }
    }
};
struct EpiResF32 {
    static constexpr bool PERM = false, AFTER_DRAIN = false;
    const float* base; float* out; int ldc;
    __device__ __forceinline__ void operator()(const f32x4 (&acc)[2][2][4][2], const Unit& u, int wr, int wc, int fr, int fq) const {
        const int row0 = u.pm * BM + wr * 64 + fr, col0 = u.pn * BM + wc * 32 + 4 * fq;
#pragma unroll
        for (int ai = 0; ai < 2; ++ai)
#pragma unroll
            for (int m = 0; m < 4; ++m) { const size_t off = (size_t)(row0 + ai * HALF + m * 16) * ldc + col0;
#pragma unroll
                for (int bj = 0; bj < 2; ++bj)
#pragma unroll
                    for (int n = 0; n < 2; ++n) { const f32x4 b = *(const f32x4*)(base + off + bj * HALF + n * 16); *(f32x4*)(out + off + bj * HALF + n * 16) = b + acc[ai][bj][m][n]; } }
    }
};
struct EpiProj {
    static constexpr bool PERM = true, AFTER_DRAIN = false;
    bf16_t* Q; bf16_t* SLAB;   bf16_t* RW; float* GATES; const float* qg; const float* kg;
    __device__ __forceinline__ void operator()(const f32x4 (&acc)[2][2][4][2], const Unit& u, int wr, int wc, int fr, int fq) const {
        const int grp = 4 * u.pn + wc;
        if (grp >= 49) return;
        const int row0 = u.pm * BM + wr * 64 + fr, d0 = 8 * fq;
        int kind; const float* g = nullptr;
        if (grp < 8) { kind = 1; g = qg; } else if (grp < 20) { const int which = (grp - 8) >> 1; kind = (which == 2 || which == 4) ? 1 : 0; g = kg + (which == 2 ? 64 : 128); } else if (grp == 20) kind = 2; else kind = 0;
        float gv[16];
        if (kind == 1) {
#pragma unroll
            for (int i = 0; i < 8; ++i) { gv[i] = g[d0 + i]; gv[8 + i] = g[32 + d0 + i]; }
        }
#pragma unroll
        for (int ai = 0; ai < 2; ++ai)
#pragma unroll
            for (int m = 0; m < 4; ++m) {
                const int row = row0 + ai * HALF + m * 16;
                f32x4 v0 = acc[ai][0][m][0], v1 = acc[ai][0][m][1], v2 = acc[ai][1][m][0], v3 = acc[ai][1][m][1];
                if (kind == 2) {
                    if (fq < 3) { float* gp = GATES + (size_t)row * 32 + d0;
                        f32x4 a, b;
#pragma unroll
                        for (int i = 0; i < 4; ++i) { a[i] = 1.f / (1.f + __expf(-v0[i])); b[i] = 1.f / (1.f + __expf(-v1[i])); }
                        *(f32x4*)gp = a; *(f32x4*)(gp + 4) = b; }
                    continue;
                }
                if (kind == 1) {
                    float ss = 0.f;
#pragma unroll
                    for (int i = 0; i < 4; ++i) ss += v0[i] * v0[i] + v1[i] * v1[i] + v2[i] * v2[i] + v3[i] * v3[i];
                    ss += __shfl_xor(ss, 16); ss += __shfl_xor(ss, 32);
                    const float s = rsqrtf(ss * (1.f / 64.f) + 1e-6f);
#pragma unroll
                    for (int i = 0; i < 4; ++i) { v0[i] *= s * gv[i]; v1[i] *= s * gv[4 + i]; v2[i] *= s * gv[8 + i]; v3[i] *= s * gv[12 + i]; }
                }
                bf16_t* p;
                if (grp < 8) p = Q + (size_t)row * 512 + grp * 64;
                else if (grp < 20) { const int sl = grp - 8; p = SLAB + ((size_t)(sl >> 1) * 4 + (size_t)((row >> 13) * 2 + (sl & 1))) * (8192 * 64) + (size_t)(row & 8191) * 64; }
                else p = RW + (size_t)row * 1792 + (grp - 21) * 64;
                u32x4 w0, w1; w0.x = cvt_pk_bf16(v0[0], v0[1]); w0.y = cvt_pk_bf16(v0[2], v0[3]); w0.z = cvt_pk_bf16(v1[0], v1[1]); w0.w = cvt_pk_bf16(v1[2], v1[3]);
                w1.x = cvt_pk_bf16(v2[0], v2[1]); w1.y = cvt_pk_bf16(v2[2], v2[3]); w1.z = cvt_pk_bf16(v3[0], v3[1]); w1.w = cvt_pk_bf16(v3[2], v3[3]);
                *(u32x4*)(p + d0) = w0; *(u32x4*)(p + 32 + d0) = w1;
            }
    }
};
template <class Epi, class Sched, bool ALIGN_EPI = false, bool SP2 = false>
__device__ __forceinline__ void gemm_phase(PG8_LAS unsigned char* lds, const Gemm g, const Sched& S, const Epi& E) {
    const int tid = threadIdx.x, wid = __builtin_amdgcn_readfirstlane(tid >> 6), lane = tid & 63, wr = wid >> 2, wc = wid & 3, fr = lane & 15, fq = lane >> 4;
    const int K = g.K, nt = K / BK;
    unsigned voffA[2], voffB[2];
#pragma unroll
    for (int i = 0; i < 2; ++i) { int R, C; stage_rc(tid * 16 + i * 8192, R, C); const int Rb = Epi::PERM ? ((R & ~31) + perm32(R & 31)) : R;
        voffA[i] = (unsigned)(R * K + C) * 2u; voffB[i] = (unsigned)(Rb * K + C) * 2u; }
    const size_t kstep = (size_t)(BK * 2);
    const size_t hstep = (size_t)HALF * K * 2;
    const size_t tstep = 2 * hstep;
    const unsigned ldsw = (unsigned)wid * 1024u;
    const int aoff = lds_byte(wr * 64 + fr, fq * 8), boff = lds_byte(wc * 32 + fr, fq * 8);
#define PG8_SA(b, h) (((b) * 2 + (h)) * HTB)
#define PG8_SB(b, h) ((4 + (b) * 2 + (h)) * HTB)
#define PG8_STAGE(bufoff, gbase, voff) do { _Pragma("unroll") for (int _i = 0; _i < 2; ++_i) \
        __builtin_amdgcn_global_load_lds((const unsigned*)((const char*)(gbase) + (voff)[_i]), (PG8_LAS unsigned*)(lds + (bufoff) + ldsw + _i * 8192), 16, 0, 0); } while (0)
#define PG8_LDA(dst, b, h) do { _Pragma("unroll") for (int m = 0; m < 4; ++m) _Pragma("unroll") for (int k = 0; k < 2; ++k) dst[m][k] = *(const PG8_LAS bf16x8*)(lds + PG8_SA(b, h) + aoff + m * 2048 + k * 1024); } while (0)
#define PG8_LDB(dst, b, h) do { _Pragma("unroll") for (int n = 0; n < 2; ++n) _Pragma("unroll") for (int k = 0; k < 2; ++k) dst[n][k] = *(const PG8_LAS bf16x8*)(lds + PG8_SB(b, h) + boff + n * 2048 + k * 1024); } while (0)
#define PG8_MMA(ai, bj, At, Bt) do { __builtin_amdgcn_s_setprio(1); _Pragma("unroll") for (int m = 0; m < 4; ++m) _Pragma("unroll") for (int n = 0; n < 2; ++n) _Pragma("unroll") for (int k = 0; k < 2; ++k) \
        acc[ai][bj][m][n] = __builtin_amdgcn_mfma_f32_16x16x32_bf16(Bt[n][k], At[m][k], acc[ai][bj][m][n], 0, 0, 0); __builtin_amdgcn_s_setprio(0); } while (0)
#define PG8_WAIT_V(n) asm volatile("s_waitcnt vmcnt(" #n ")" ::: "memory")
#define PG8_WAIT_L(n) asm volatile("s_waitcnt lgkmcnt(" #n ")" ::: "memory")
#define PG8_BAR __builtin_amdgcn_s_barrier()
#define PG8_SCHED __builtin_amdgcn_sched_barrier(0)
    Unit cur, nxt; int ui = 0;
    if (!S.next(0, cur)) return;
    f32x4 acc[2][2][4][2];
#pragma unroll
    for (int a = 0; a < 2; ++a)
#pragma unroll
        for (int b = 0; b < 2; ++b)
#pragma unroll
            for (int m = 0; m < 4; ++m)
#pragma unroll
                for (int n = 0; n < 2; ++n) acc[a][b][m][n] = (f32x4){0.f, 0.f, 0.f, 0.f};
    bf16x8 At[4][2], B0[2][2], B1[2][2];
    const char* cA = (const char*)g.A + (size_t)cur.pm * tstep; const char* cB = (const char*)g.Bt + (size_t)cur.pn * tstep;
    S.a_ready(cur);
    if constexpr (SP2) {
        PG8_STAGE(PG8_SB(0, 0), cB, voffB); PG8_STAGE(PG8_SB(0, 1), cB + hstep, voffB); PG8_STAGE(PG8_SA(0, 0), cA, voffA); PG8_STAGE(PG8_SA(0, 1), cA + hstep, voffA);
        if (wr == 1) PG8_BAR;
        PG8_WAIT_V(2); PG8_BAR;
        PG8_STAGE(PG8_SB(1, 0), cB + kstep, voffB); PG8_STAGE(PG8_SA(1, 0), cA + kstep, voffA); PG8_STAGE(PG8_SB(1, 1), cB + hstep + kstep, voffB);
        PG8_WAIT_V(6); PG8_BAR;
    } else {
        PG8_STAGE(PG8_SB(0, 0), cB, voffB); PG8_STAGE(PG8_SA(0, 0), cA, voffA); PG8_STAGE(PG8_SB(0, 1), cB + hstep, voffB); PG8_STAGE(PG8_SA(0, 1), cA + hstep, voffA);
        if (wr == 1) PG8_BAR;
        PG8_WAIT_V(4); PG8_BAR;
        PG8_STAGE(PG8_SB(1, 0), cB + kstep, voffB); PG8_STAGE(PG8_SA(1, 0), cA + kstep, voffA); PG8_STAGE(PG8_SB(1, 1), cB + hstep + kstep, voffB);
        PG8_WAIT_V(6); PG8_BAR;
    }
    for (;;) {
        const bool has_next = S.next(ui + 1, nxt);
        const char* nA = has_next ? (const char*)g.A + (size_t)nxt.pm * tstep : cA; const char* nB = has_next ? (const char*)g.Bt + (size_t)nxt.pn * tstep : cB;
        for (int t = 0; t < nt; t += 2) {
            const bool last = (t == nt - 2);
            const char* a1 = cA + (size_t)(t + 1) * kstep;
            const char* a2 = last ? nA : cA + (size_t)(t + 2) * kstep; const char* b2 = last ? nB : cB + (size_t)(t + 2) * kstep;
            const char* a3 = a2 + kstep; const char* b3 = b2 + kstep;
            if (last && has_next) S.a_ready(nxt);
            if constexpr (SP2) {
            PG8_LDB(B0, 0, 0); PG8_LDB(B1, 0, 1); PG8_SCHED; PG8_LDA(At, 0, 0); PG8_STAGE(PG8_SA(1, 1), a1 + hstep, voffA);
            PG8_WAIT_V(8); PG8_WAIT_L(0); PG8_BAR; PG8_MMA(0, 0, At, B0); PG8_MMA(0, 1, At, B1); PG8_BAR; PG8_SCHED;
            PG8_LDA(At, 0, 1); PG8_STAGE(PG8_SB(0, 0), b2, voffB); PG8_STAGE(PG8_SB(0, 1), b2 + hstep, voffB); PG8_STAGE(PG8_SA(0, 0), a2, voffA);
            PG8_WAIT_V(8); PG8_WAIT_L(0); PG8_BAR; PG8_MMA(1, 0, At, B0); PG8_MMA(1, 1, At, B1); PG8_BAR; PG8_SCHED;
            PG8_LDB(B0, 1, 0); PG8_LDB(B1, 1, 1); PG8_SCHED; PG8_LDA(At, 1, 0); PG8_STAGE(PG8_SA(0, 1), a2 + hstep, voffA);
            PG8_WAIT_V(8); PG8_WAIT_L(0); PG8_BAR; PG8_MMA(0, 0, At, B0); PG8_MMA(0, 1, At, B1); PG8_BAR; PG8_SCHED;
            PG8_LDA(At, 1, 1); PG8_STAGE(PG8_SB(1, 0), b3, voffB); PG8_STAGE(PG8_SB(1, 1), b3 + hstep, voffB); PG8_STAGE(PG8_SA(1, 0), a3, voffA);
            PG8_WAIT_V(8); PG8_WAIT_L(0); PG8_BAR; PG8_MMA(1, 0, At, B0); PG8_MMA(1, 1, At, B1); PG8_BAR; PG8_SCHED;
            } else {
            PG8_LDB(B0, 0, 0); PG8_SCHED; PG8_LDA(At, 0, 0); PG8_STAGE(PG8_SA(1, 1), a1 + hstep, voffA);
            PG8_WAIT_L(8); PG8_BAR; PG8_WAIT_L(0); PG8_MMA(0, 0, At, B0); PG8_BAR; PG8_SCHED;
            PG8_LDB(B1, 0, 1); PG8_STAGE(PG8_SB(0, 0), b2, voffB);
            PG8_BAR; PG8_WAIT_L(0); PG8_MMA(0, 1, At, B1); PG8_BAR;
            PG8_LDA(At, 0, 1); PG8_STAGE(PG8_SA(0, 0), a2, voffA);
            PG8_BAR; PG8_WAIT_L(0); PG8_MMA(1, 0, At, B0); PG8_BAR; PG8_SCHED;
            PG8_STAGE(PG8_SB(0, 1), b2 + hstep, voffB);
            PG8_WAIT_V(6); PG8_BAR; PG8_MMA(1, 1, At, B1); PG8_BAR;
            PG8_LDB(B0, 1, 0); PG8_SCHED; PG8_LDA(At, 1, 0); PG8_STAGE(PG8_SA(0, 1), a2 + hstep, voffA);
            PG8_WAIT_L(8); PG8_BAR; PG8_WAIT_L(0); PG8_MMA(0, 0, At, B0); PG8_BAR; PG8_SCHED;
            PG8_LDB(B1, 1, 1); PG8_STAGE(PG8_SB(1, 0), b3, voffB);
            PG8_BAR; PG8_WAIT_L(0); PG8_MMA(0, 1, At, B1); PG8_BAR;
            PG8_LDA(At, 1, 1); PG8_STAGE(PG8_SA(1, 0), a3, voffA);
            PG8_BAR; PG8_WAIT_L(0); PG8_MMA(1, 0, At, B0); PG8_BAR; PG8_SCHED;
            PG8_STAGE(PG8_SB(1, 1), b3 + hstep, voffB);
            PG8_WAIT_V(6); PG8_BAR; PG8_MMA(1, 1, At, B1); PG8_BAR;
            }
        }
        if constexpr (ALIGN_EPI) { if (wr == 0) PG8_BAR; }
        if constexpr (!Epi::AFTER_DRAIN) { E(acc, cur, wr, wc, fr, fq); S.done(cur); }
        if (!has_next) break;
#pragma unroll
        for (int a = 0; a < 2; ++a)
#pragma unroll
            for (int b = 0; b < 2; ++b)
#pragma unroll
                for (int m = 0; m < 4; ++m)
#pragma unroll
                    for (int n = 0; n < 2; ++n) acc[a][b][m][n] = (f32x4){0.f, 0.f, 0.f, 0.f};
        cur = nxt; cA = nA; cB = nB; ++ui;
        if constexpr (ALIGN_EPI) { if (wr == 1) PG8_BAR; }
    }
    PG8_WAIT_V(0);
    if constexpr (!ALIGN_EPI) { if (wr == 0) PG8_BAR; }
    PG8_BAR;
    if constexpr (Epi::AFTER_DRAIN) { E.fused(acc, cur, wr, wc, fr, fq, lds, wid, lane); S.done(cur); }
#undef PG8_SA
#undef PG8_SB
#undef PG8_STAGE
#undef PG8_LDA
#undef PG8_LDB
#undef PG8_MMA
#undef PG8_WAIT_V
#undef PG8_WAIT_L
#undef PG8_BAR
#undef PG8_SCHED
}
}

namespace {
#define LAS __attribute__((address_space(3)))
typedef unsigned short bf16;
typedef unsigned v4u __attribute__((ext_vector_type(4)));
typedef float f32x4 __attribute__((ext_vector_type(4)));
constexpr int NWAVES = 8, NTHREADS = 512;
constexpr int B_ = 2, T_ = 8192, D_ = 1024, M_ = B_ * T_, DIN = 3096, DFF = 2816, NPROJ = 3328, NLORA = 1536, KLORA = 256, NUPH = 2816;
constexpr size_t MiB = 1u << 20;
constexpr size_t WS_WIN = 1 * MiB, WS_WOUT = 8 * MiB, WS_WUP = 10 * MiB, WS_WDN = 21 * MiB, WS_LORAW = 27 * MiB, WS_B1P = 28 * MiB;
constexpr size_t WS_XN = 32 * MiB;
constexpr size_t WS_Q = 64 * MiB;
constexpr size_t WS_SLAB = 80 * MiB;
constexpr size_t WS_GATES = 104 * MiB;
constexpr size_t WS_RW = 106 * MiB;
constexpr size_t WS_LORA = 162 * MiB;
constexpr size_t WS_ACT = 210 * MiB;
constexpr size_t WS_CMP = 218 * MiB;
constexpr size_t WS_MIX = 220 * MiB;
constexpr size_t WS_U = 64 * MiB;
constexpr size_t WS_ACT2 = 152 * MiB;
constexpr size_t WS_END = 256 * MiB;
constexpr int LDS_BYTES = 147456;

__device__ __forceinline__ float bf2f(bf16 v) { return __uint_as_float((unsigned)v << 16); }
__device__ __forceinline__ unsigned f2bf(float f) { unsigned u = __float_as_uint(f); return (u + 0x7fffu + ((u >> 16) & 1u)) >> 16; }
__device__ __forceinline__ unsigned pk2(float lo, float hi) { return f2bf(lo) | (f2bf(hi) << 16); }
__device__ __forceinline__ float wsum(float v) {
#pragma unroll
  for (int o = 32; o >= 1; o >>= 1) v += __shfl_xor(v, o);
  return v;
}
__device__ __forceinline__ float wmax(float v) {
#pragma unroll
  for (int o = 32; o >= 1; o >>= 1) v = fmaxf(v, __shfl_xor(v, o));
  return v;
}
__device__ __forceinline__ int t5b(int n) {
  if (n < 16) return n < 0 ? 0 : n;
  if (n >= 128) return 31;
  int v = 16 + (int)(logf((float)n / 16.f) / 2.0794415416798357f * 16.f);
  return v > 31 ? 31 : v;
}
__device__ __forceinline__ float sigm(float x) { return 1.f / (1.f + expf(-x)); }
__device__ __forceinline__ float gelu_tanh(float x) { return 0.5f * x * (1.f + tanhf(0.7978845608028654f * (x + 0.044715f * x * x * x))); }

struct Params {
  const float* in[28]; float* out; unsigned char* ws; int ph_lo, ph_hi;
};

__device__ __forceinline__ void tr_item(const float* W, int ldn, int k0, int nsrc0, int nvalid, bf16* WT, int K, int dstrow0, LAS float* scr, int lane) {
#pragma unroll 8
  for (int i = 0; i < 32; ++i) { const int kk = 2 * i + (lane >> 5), c = lane & 31; scr[kk * 33 + c] = (c < nvalid) ? W[(size_t)(k0 + kk) * ldn + nsrc0 + c] : 0.f; }
  asm volatile("s_waitcnt lgkmcnt(0)" ::: "memory");
  const int c = lane & 7;
#pragma unroll
  for (int j = 0; j < 4; ++j) { const int n = (lane >> 3) + 8 * j; const LAS float* s = scr + (8 * c) * 33 + n;
    v4u o; o.x = pk2(s[0 * 33], s[1 * 33]); o.y = pk2(s[2 * 33], s[3 * 33]); o.z = pk2(s[4 * 33], s[5 * 33]); o.w = pk2(s[6 * 33], s[7 * 33]);
    *(v4u*)(WT + (size_t)(dstrow0 + n) * K + k0 + 8 * c) = o; }
  asm volatile("s_waitcnt lgkmcnt(0)" ::: "memory");
}
__device__ __forceinline__ void proj_src(int c, int& src, int& nv) {
  const int pn = c >> 8, bj = (c >> 7) & 1, wc = (c >> 5) & 3, grp = 4 * pn + wc, dim0 = 32 * bj;
  if (grp < 20) { src = grp * 64 + dim0; nv = 32; } else if (grp == 20) { src = 1280 + dim0; nv = bj == 0 ? 24 : 0; } else if (grp < 49) { src = 1304 + (grp - 21) * 64 + dim0; nv = 32; } else { src = 0; nv = 0; }
}
__device__ __forceinline__ void rms_row_to_bf16(const float* xrow, const float* g, bf16* orow, int lane) {
  const f32x4* xr = (const f32x4*)xrow + lane; const f32x4* gr = (const f32x4*)g + lane;
  f32x4 v[4]; float s = 0.f;
#pragma unroll
  for (int j = 0; j < 4; ++j) { v[j] = xr[64 * j]; s += (v[j].x * v[j].x + v[j].y * v[j].y) + (v[j].z * v[j].z + v[j].w * v[j].w); }
  const float r = rsqrtf(wsum(s) * (1.f / D_) + 1e-6f);
  unsigned long long* o8 = (unsigned long long*)orow + lane;
#pragma unroll
  for (int j = 0; j < 4; ++j) { const f32x4 gg = gr[64 * j]; o8[64 * j] = (unsigned long long)pk2(v[j].x * r * gg.x, v[j].y * r * gg.y) | ((unsigned long long)pk2(v[j].z * r * gg.z, v[j].w * r * gg.w) << 32); }
}

__device__ __forceinline__ void phase_prologue(const Params& p, LAS unsigned char* lds, int wave, int lane) {
  LAS float* scr = (LAS float*)(lds + wave * 16384);
  const int gw = blockIdx.x * NWAVES + wave, NGW = gridDim.x * NWAVES;
  const float* w_in = p.in[2]; const float* w_out = p.in[22]; const float* ffn_up = p.in[24]; const float* ffn_down = p.in[27];
  bf16* WIN = (bf16*)(p.ws + WS_WIN); bf16* WOUT = (bf16*)(p.ws + WS_WOUT); bf16* WUP = (bf16*)(p.ws + WS_WUP); bf16* WDN = (bf16*)(p.ws + WS_WDN);
  constexpr int I_IN = 16 * (NPROJ / 32), I_OUT = 16 * 32, I_UP = 16 * (2 * DFF / 32), I_DN = 44 * 32, NITEMS = I_IN + I_OUT + I_UP + I_DN;
  for (int it = gw; it < NITEMS; it += NGW) {
    int r = it;
    if (r < I_IN) { const int nr = NPROJ / 32, kb = r / nr, run = r % nr; int src, nv; proj_src(32 * run, src, nv); tr_item(w_in, DIN, 64 * kb, src, nv, WIN, D_, 32 * run, scr, lane); continue; } r -= I_IN;
    if (r < I_OUT) { const int kb = r / 32, run = r % 32; tr_item(w_out, D_, 64 * kb, 32 * run, 32, WOUT, D_, 32 * run, scr, lane); continue; } r -= I_OUT;
    if (r < I_UP) { const int nr = 2 * DFF / 32, kb = r / nr, run = r % nr; const int c = 32 * run, hh = c / NUPH, w = c % NUPH; const int src = (w < 1408) ? hh * 1408 + w : DFF + hh * 1408 + (w - 1408);
      tr_item(ffn_up, 2 * DFF, 64 * kb, src, 32, WUP, D_, c, scr, lane); continue; } r -= I_UP;
    { const int kb = r / 32, run = r % 32; tr_item(ffn_down, D_, 64 * kb, 32 * run, 32, WDN, DFF, 32 * run, scr, lane); }
  }
  { bf16* LW = (bf16*)(p.ws + WS_LORAW); const float* w2 = p.in[13]; const float* a2 = p.in[15]; const float* g2 = p.in[16];
    for (int i = blockIdx.x * NTHREADS + threadIdx.x; i < NLORA * KLORA; i += gridDim.x * NTHREADS) { const int n = i >> 8, k = i & 255; float v = 0.f;
      if (n < 512) { if (k < 64) v = w2[k * 512 + n]; } else if (n < 1024) { if (k >= 64 && k < 128) v = a2[(k - 64) * 512 + n - 512]; } else { if (k >= 128) v = g2[(k - 128) * 512 + n - 1024]; }
      LW[i] = (bf16)f2bf(v); } }
  { float* b1p = (float*)(p.ws + WS_B1P); const float* pos = p.in[5]; const float* w1 = p.in[6]; const float* b1 = p.in[7];
    for (int o = gw; o < 256; o += NGW) { const int kv = o >> 7, j = o & 127; float s = 0.f;
      for (int k = lane; k < 2048; k += 64) s += pos[kv * 2048 + k] * w1[((size_t)kv * 2048 + k) * 128 + j];
      s = wsum(s); if (lane == 0) b1p[o] = s + b1[o]; } }
  { const float* x = p.in[0]; const float* g = p.in[1]; bf16* XN = (bf16*)(p.ws + WS_XN);
    for (int m = gw; m < M_; m += NGW) rms_row_to_bf16(x + (size_t)m * D_, g, XN + (size_t)m * D_, lane); }
}

__device__ __forceinline__ void phase_mid(const Params& p, LAS unsigned char* lds, int wave, int lane) {
  const int tid = threadIdx.x;
  {
    LAS bf16* blk = (LAS bf16*)lds;
    LAS float* part = (LAS float*)(lds + 36864);
    LAS float* hid = (LAS float*)(lds + 36864 + 32768);
    const float* w1 = p.in[6]; const float* w2 = p.in[8]; const float* b2 = p.in[9]; const float* kg0 = p.in[4]; const float* b1p = (const float*)(p.ws + WS_B1P);
    float* CMP = (float*)(p.ws + WS_CMP);
    for (int it = blockIdx.x; it < 256; it += gridDim.x) {
      const int kv = it >> 7, slab = (it >> 5) & 3, ct = it & 31, c0 = ct * 16;
      const bf16* src = (const bf16*)(p.ws + WS_SLAB) + ((size_t)kv * 4 + slab) * (8192 * 64) + (size_t)c0 * 16 * 64;
      const int ntok = (c0 * 16 + 272 <= 8192) ? 272 : 8192 - c0 * 16;
      for (int i = tid; i < 272 * 8; i += NTHREADS) { v4u v = {0u, 0u, 0u, 0u}; if ((i >> 3) < ntok) v = *(const v4u*)(src + (size_t)i * 8); *(LAS v4u*)(blk + i * 8) = v; }
      __syncthreads();
      { const int j = tid & 127, kq = tid >> 7; float acc[16];
#pragma unroll
        for (int c = 0; c < 16; ++c) acc[c] = 0.f;
        const float* w = w1 + ((size_t)kv * 2048 + kq * 512) * 128 + j;
        for (int k = 0; k < 512; ++k) { const float wv = w[(size_t)k * 128];
#pragma unroll
          for (int c = 0; c < 16; ++c) acc[c] += bf2f(blk[c * 1024 + kq * 512 + k]) * wv; }
#pragma unroll
        for (int c = 0; c < 16; ++c) part[(kq * 16 + c) * 128 + j] = acc[c]; }
      __syncthreads();
      for (int i = tid; i < 16 * 128; i += NTHREADS) { const int j = i & 127; const float s = b1p[kv * 128 + j] + ((part[i] + part[2048 + i]) + (part[4096 + i] + part[6144 + i])); hid[i] = gelu_tanh(s); }
      __syncthreads();
#pragma unroll
      for (int cc = 0; cc < 2; ++cc) { const int c = wave * 2 + cc; float o = b2[kv * 64 + lane];
        for (int k = 0; k < 128; ++k) o += hid[c * 128 + k] * w2[((size_t)kv * 128 + k) * 64 + lane];
        if (kv == 0) { const float ss = wsum(o * o); o = o * rsqrtf(ss * (1.f / 64.f) + 1e-6f) * kg0[lane]; }
        if (c0 + c < 511) CMP[(((size_t)kv * 4 + slab) * 512 + c0 + c) * 64 + lane] = o; }
      __syncthreads();
    }
  }
  {
    const bf16* RW = (const bf16*)(p.ws + WS_RW); bf16* ACT = (bf16*)(p.ws + WS_ACT); const float* mu = p.in[11];
    const int gw = blockIdx.x * NWAVES + wave, NGW = gridDim.x * NWAVES;
    for (int m = gw; m < M_; m += NGW) {
      const int t = m & (T_ - 1); const bf16* cur = RW + (size_t)m * 1792 + 1536 + lane * 4; float o[4];
#pragma unroll
      for (int i = 0; i < 4; ++i) { const float c = bf2f(cur[i]); const float pv = t > 0 ? bf2f(cur[i - 1792]) : 0.f; const float v = c + (pv - c) * mu[1536 + lane * 4 + i];
        o[i] = (lane < 16) ? tanhf(v) : (lane < 32) ? v : sigm(v); }
      *(unsigned long long*)(ACT + (size_t)m * 256 + lane * 4) = (unsigned long long)pk2(o[0], o[1]) | ((unsigned long long)pk2(o[2], o[3]) << 32);
    }
  }
}

__device__ __forceinline__ void nsa_item(const Params& p, int b, int t, int g, int r  , int lane, LAS float* q_s  , LAS float* sc  , LAS float* score_s  , LAS int* sel_s  ) {
  const int h = g * 4 + r; const int slab = b * 2 + g; const size_t tok = (size_t)b * T_ + t;
  const bf16* Q = (const bf16*)(p.ws + WS_Q); const bf16* SL = (const bf16*)(p.ws + WS_SLAB);
  const bf16* KS = SL + ((size_t)2 * 4 + slab) * (8192 * 64); const bf16* VS = SL + ((size_t)3 * 4 + slab) * (8192 * 64);
  const bf16* KW = SL + ((size_t)4 * 4 + slab) * (8192 * 64); const bf16* VW = SL + ((size_t)5 * 4 + slab) * (8192 * 64);
  const float* CMP = (const float*)(p.ws + WS_CMP); const float* kcmp = CMP + ((size_t)0 * 4 + slab) * 512 * 64; const float* vcmp = CMP + ((size_t)1 * 4 + slab) * 512 * 64;
  const float* rel_bias = p.in[10];
  LAS float* qs = q_s + r * 64; LAS float* scr = sc + r * 1024;
  qs[lane] = bf2f(Q[tok * 512 + h * 64 + lane]) * 0.125f;
  __syncthreads();
  const int ncv = (t >= 31) ? ((t - 31) / 16 + 1) : 0;
  float o_c = 0.f;
  {
    float mx = -3e38f;
    for (int c = lane; c < ncv; c += 64) { const float* kr = kcmp + (size_t)c * 64; float s = 0.f;
      for (int d = 0; d < 64; ++d) s += qs[d] * kr[d];
      s += rel_bias[t5b(t - (16 * c + 31)) * 8 + h]; scr[c] = s; mx = fmaxf(mx, s); }
    mx = wmax(mx); float sum = 0.f;
    for (int c = lane; c < ncv; c += 64) { const float pr = expf(scr[c] - mx); scr[c] = pr; sum += pr; }
    sum = wsum(sum); const float inv = ncv > 0 ? 1.f / sum : 0.f;
    for (int c = lane; c < ncv; c += 64) scr[c] *= inv;
    __syncthreads();
    for (int c = 0; c < ncv; ++c) o_c += scr[c] * vcmp[(size_t)c * 64 + lane];
  }
  { const int n = r * 64 + lane;
    if (n < 128) { float imp = 0.f;
      for (int c = 4 * n - 1; c <= 4 * n + 3; ++c) if (c >= 0 && c < ncv) imp += (sc[c] + sc[1024 + c]) + (sc[2048 + c] + sc[3072 + c]);
      const int cur = t >> 6; const bool forced = (n == 0) || (n == cur) || (n == cur - 1);
      score_s[n] = (64 * n <= t) ? (forced ? 1e9f : imp) : -1e30f; } }
  __syncthreads();
  if (r == 0) {
    float s0 = score_s[lane], s1 = score_s[lane + 64];
    for (int i = 0; i < 16; ++i) { float bv; int bi;
      if (s0 >= s1) { bv = s0; bi = lane; } else { bv = s1; bi = lane + 64; }
      for (int o = 32; o >= 1; o >>= 1) { const float ov = __shfl_xor(bv, o); const int oi = __shfl_xor(bi, o); if (ov > bv || (ov == bv && oi < bi)) { bv = ov; bi = oi; } }
      if (lane == 0) sel_s[i] = bi;
      if (bi == lane) s0 = -3.4e38f; if (bi == lane + 64) s1 = -3.4e38f; }
  }
  __syncthreads();
  float o_s = 0.f;
  {
    float mx = -3e38f;
    for (int i = 0; i < 16; ++i) { const int s = sel_s[i] * 64 + lane; float v = -3e38f;
      if (s <= t) { const bf16* kr = KS + (size_t)s * 64; float a = 0.f; for (int d = 0; d < 64; ++d) a += qs[d] * bf2f(kr[d]); v = a + rel_bias[t5b(t - s) * 8 + h]; }
      scr[i * 64 + lane] = v; mx = fmaxf(mx, v); }
    mx = wmax(mx); float sum = 0.f;
    for (int i = 0; i < 16; ++i) { const float v = scr[i * 64 + lane]; const float pr = (v > -1e38f) ? expf(v - mx) : 0.f; scr[i * 64 + lane] = pr; sum += pr; }
    sum = wsum(sum); const float inv = 1.f / sum;
    __syncthreads();
    for (int i = 0; i < 16; ++i) { const int sb = sel_s[i] * 64;
      for (int l = 0; l < 64; ++l) { const int s = sb + l; if (s > t) break; o_s += scr[i * 64 + l] * bf2f(VS[(size_t)s * 64 + lane]); } }
    o_s *= inv;
  }
  __syncthreads();
  float o_w = 0.f;
  {
    const int s0 = t - 511 > 0 ? t - 511 : 0; const int n = t - s0 + 1;
    float mx = -3e38f;
    for (int i = lane; i < n; i += 64) { const int s = s0 + i; const bf16* kr = KW + (size_t)s * 64; float a = 0.f; for (int d = 0; d < 64; ++d) a += qs[d] * bf2f(kr[d]);
      a += rel_bias[t5b(t - s) * 8 + h]; scr[i] = a; mx = fmaxf(mx, a); }
    mx = wmax(mx); float sum = 0.f;
    for (int i = lane; i < n; i += 64) { const float pr = expf(scr[i] - mx); scr[i] = pr; sum += pr; }
    sum = wsum(sum); const float inv = 1.f / sum;
    __syncthreads();
    for (int i = 0; i < n; ++i) o_w += scr[i] * bf2f(VW[(size_t)(s0 + i) * 64 + lane]);
    o_w *= inv;
  }
  const float* gl = (const float*)(p.ws + WS_GATES) + tok * 32 + h * 3;
  ((bf16*)(p.ws + WS_MIX))[tok * 1024 + h * 64 + lane] = (bf16)f2bf(gl[0] * o_c + gl[1] * o_s + gl[2] * o_w);
  __syncthreads();
}

constexpr int CH = 32;
__device__ __forceinline__ void scan_bh(const Params& p, int b, int h, LAS unsigned char* lds) {
  const int tid = threadIdx.x;
  typedef LAS float (*arr_t)[64];
  arr_t r_s = (arr_t)(lds), d_s = (arr_t)(lds + 8192), k_s = (arr_t)(lds + 16384), v_s = (arr_t)(lds + 24576), a_s = (arr_t)(lds + 32768), b_s = (arr_t)(lds + 40960), y_s = (arr_t)(lds + 49152);
  const bf16* RW = (const bf16*)(p.ws + WS_RW) + (size_t)b * T_ * 1792; const bf16* LO = (const bf16*)(p.ws + WS_LORA) + (size_t)b * T_ * 1536;
  bf16* MIX = (bf16*)(p.ws + WS_MIX) + (size_t)b * T_ * 1024;
  const float* mu = p.in[11]; const float* w0 = p.in[12]; const float* a0 = p.in[14]; const float* k_k = p.in[17]; const float* k_a = p.in[18]; const float* r_k = p.in[19]; const float* ln_w = p.in[20]; const float* ln_b = p.in[21];
  const int row = tid >> 3, sub = tid & 7;
  float S[8];
#pragma unroll
  for (int j = 0; j < 8; ++j) S[j] = 0.f;
  const int lt = tid >> 4, le = (tid & 15) * 4;
  for (int t0 = 0; t0 < T_; t0 += CH) {
    {
      const int t = t0 + lt; const bf16* rw = RW + (size_t)t * 1792; const int hc = h * 64 + le;
      float kkv[4], av[4], ss = 0.f;
#pragma unroll
      for (int j = 0; j < 4; ++j) {
        const int c = hc + j;
        const float rc = bf2f(rw[c]), kc = bf2f(rw[512 + c]), vc = bf2f(rw[1024 + c]);
        float rp = 0.f, kp = 0.f, vp = 0.f; if (t > 0) { rp = bf2f(rw[c - 1792]); kp = bf2f(rw[512 + c - 1792]); vp = bf2f(rw[1024 + c - 1792]); }
        const float rm = rc + (rp - rc) * mu[c], km = kc + (kp - kc) * mu[512 + c], vm = vc + (vp - vc) * mu[1024 + c];
        const float wr = w0[c] + bf2f(LO[(size_t)t * 1536 + c]);
        const float sp = (-wr > 20.f) ? -wr : log1pf(expf(-wr));
        const float w = -sp - 0.5f; const float dec = expf(-expf(w));
        const float a = sigm(a0[c] + bf2f(LO[(size_t)t * 1536 + 512 + c]));
        const float kk = km * k_k[c]; kkv[j] = kk; ss += kk * kk; av[j] = a;
        const float kpr = km * (1.f + (a - 1.f) * k_a[c]);
        r_s[lt][le + j] = rm; d_s[lt][le + j] = dec; k_s[lt][le + j] = kpr; v_s[lt][le + j] = vm;
      }
      ss += __shfl_xor(ss, 1); ss += __shfl_xor(ss, 2); ss += __shfl_xor(ss, 4); ss += __shfl_xor(ss, 8);
      const float inv = 1.f / fmaxf(sqrtf(ss), 1e-12f);
#pragma unroll
      for (int j = 0; j < 4; ++j) { const float kk = kkv[j] * inv; a_s[lt][le + j] = -kk; b_s[lt][le + j] = kk * av[j]; }
    }
    __syncthreads();
    for (int tt = 0; tt < CH; ++tt) {
      float sa = 0.f;
#pragma unroll
      for (int j = 0; j < 8; ++j) sa += S[j] * a_s[tt][sub * 8 + j];
      sa += __shfl_xor(sa, 1); sa += __shfl_xor(sa, 2); sa += __shfl_xor(sa, 4);
      const float vv = v_s[tt][row]; float y = 0.f;
#pragma unroll
      for (int j = 0; j < 8; ++j) { const int k = sub * 8 + j; S[j] = S[j] * d_s[tt][k] + sa * b_s[tt][k] + vv * k_s[tt][k]; y += S[j] * r_s[tt][k]; }
      y += __shfl_xor(y, 1); y += __shfl_xor(y, 2); y += __shfl_xor(y, 4);
      if (sub == 0) y_s[tt][row] = y;
    }
    __syncthreads();
    {
      const int t = t0 + lt; float yv[4], s = 0.f, bo = 0.f;
#pragma unroll
      for (int j = 0; j < 4; ++j) { yv[j] = y_s[lt][le + j]; s += yv[j]; bo += r_s[lt][le + j] * k_s[lt][le + j] * r_k[h * 64 + le + j]; }
      s += __shfl_xor(s, 1); s += __shfl_xor(s, 2); s += __shfl_xor(s, 4); s += __shfl_xor(s, 8);
      bo += __shfl_xor(bo, 1); bo += __shfl_xor(bo, 2); bo += __shfl_xor(bo, 4); bo += __shfl_xor(bo, 8);
      const float mean = s * (1.f / 64.f); float q = 0.f;
#pragma unroll
      for (int j = 0; j < 4; ++j) { const float d = yv[j] - mean; q += d * d; }
      q += __shfl_xor(q, 1); q += __shfl_xor(q, 2); q += __shfl_xor(q, 4); q += __shfl_xor(q, 8);
      const float rstd = rsqrtf(q * (1.f / 64.f) + 64e-5f); float o[4];
#pragma unroll
      for (int j = 0; j < 4; ++j) { const int c = h * 64 + le + j;
        o[j] = ((yv[j] - mean) * rstd * ln_w[c] + ln_b[c] + bo * v_s[lt][le + j]) * bf2f(LO[(size_t)t * 1536 + 1024 + c]); }
      *(unsigned long long*)(MIX + (size_t)t * 1024 + 512 + h * 64 + le) = (unsigned long long)pk2(o[0], o[1]) | ((unsigned long long)pk2(o[2], o[3]) << 32);
    }
    __syncthreads();
  }
}

__device__ __forceinline__ void phase_attn(const Params& p, LAS unsigned char* lds, int wave, int lane) {
  if (blockIdx.x < 16) { scan_bh(p, blockIdx.x >> 3, blockIdx.x & 7, lds); return; }
  const int half = wave >> 2, r = wave & 3;
  LAS float* base = (LAS float*)(lds + half * 20480);
  LAS float* q_s = base; LAS float* sc = base + 256; LAS float* score_s = base + 256 + 4096; LAS int* sel_s = (LAS int*)(base + 256 + 4096 + 128);
  const int nb = gridDim.x - 16, bi = blockIdx.x - 16;
  for (int pr = bi; pr < M_; pr += nb) {
    nsa_item(p, pr >> 13, pr & (T_ - 1), half, r, lane, q_s, sc, score_s, sel_s);
  }
}

__device__ __forceinline__ void phase_rms2(const Params& p, int wave, int lane) {
  const int gw = blockIdx.x * NWAVES + wave, NGW = gridDim.x * NWAVES; bf16* XN = (bf16*)(p.ws + WS_XN);
  for (int m = gw; m < M_; m += NGW) rms_row_to_bf16(p.out + (size_t)m * D_, p.in[23], XN + (size_t)m * D_, lane);
}
__device__ __forceinline__ void phase_convgate(const Params& p, int hh) {
  const bf16* U = (const bf16*)(p.ws + WS_U); bf16* ACT2 = (bf16*)(p.ws + WS_ACT2); const float* cw = p.in[25]; const float* cb = p.in[26];
  const long total = (long)M_ * 176;
  for (long it = (long)blockIdx.x * NTHREADS + threadIdx.x; it < total; it += (long)gridDim.x * NTHREADS) {
    const int m = (int)(it / 176), i0 = (int)(it % 176) * 8, t = m & (T_ - 1), j0 = hh * 1408 + i0;
    float uv[8], ug[8];
#pragma unroll
    for (int i = 0; i < 8; ++i) { uv[i] = cb[j0 + i]; ug[i] = cb[DFF + j0 + i]; }
#pragma unroll
    for (int k = 0; k < 3; ++k) { if (t - 2 + k < 0) continue;
      const bf16* ur = U + (size_t)(m - 2 + k) * NUPH + i0; const v4u a = *(const v4u*)ur, g = *(const v4u*)(ur + 1408);
      const unsigned aw[4] = {a.x, a.y, a.z, a.w}, gw[4] = {g.x, g.y, g.z, g.w};
#pragma unroll
      for (int i = 0; i < 8; ++i) { const float av = __uint_as_float((i & 1) ? (aw[i >> 1] & 0xffff0000u) : (aw[i >> 1] << 16)); const float gv = __uint_as_float((i & 1) ? (gw[i >> 1] & 0xffff0000u) : (gw[i >> 1] << 16));
        uv[i] += av * cw[k * 2 * DFF + j0 + i]; ug[i] += gv * cw[k * 2 * DFF + DFF + j0 + i]; } }
    v4u o; float r[8];
#pragma unroll
    for (int i = 0; i < 8; ++i) r[i] = ug[i] * sigm(ug[i]) * uv[i];
    o.x = pk2(r[0], r[1]); o.y = pk2(r[2], r[3]); o.z = pk2(r[4], r[5]); o.w = pk2(r[6], r[7]);
    *(v4u*)(ACT2 + (size_t)m * DFF + j0) = o;
  }
}

constexpr int NPHASE = 12;
__global__ void __launch_bounds__(NTHREADS, 2) mk_fwd(Params p) {
  extern __shared__ __attribute__((aligned(16))) unsigned char lds_raw[];
  LAS unsigned char* lds = (LAS unsigned char*)lds_raw;
  const int tid = threadIdx.x, lane = tid & 63, wave = __builtin_amdgcn_readfirstlane(tid >> 6);
  cg::grid_group grid = cg::this_grid();
  const int lo = p.ph_lo, hi = p.ph_hi;
#define IN(k) (lo <= (k) && (k) < hi)
#define SEAM(k) do { if (IN(k) && IN((k) + 1)) grid.sync(); } while (0)
  unsigned char* ws = p.ws;
  if (IN(0)) { phase_prologue(p, lds, wave, lane); } SEAM(0);
  if (IN(1)) { pg8::Gemm g{(const pg8::bf16_t*)(ws + WS_XN), (const pg8::bf16_t*)(ws + WS_WIN), M_, NPROJ, D_}; pg8::StaticOrder S; S.init(M_, NPROJ, gridDim.x, blockIdx.x);
    pg8::EpiProj E{(pg8::bf16_t*)(ws + WS_Q), (pg8::bf16_t*)(ws + WS_SLAB), (pg8::bf16_t*)(ws + WS_RW), (float*)(ws + WS_GATES), p.in[3], p.in[4]};
    pg8::gemm_phase<pg8::EpiProj, pg8::StaticOrder, true, true>(lds, g, S, E); } SEAM(1);
  if (IN(2)) { phase_mid(p, lds, wave, lane); } SEAM(2);
  if (IN(3)) { pg8::Gemm g{(const pg8::bf16_t*)(ws + WS_ACT), (const pg8::bf16_t*)(ws + WS_LORAW), M_, NLORA, KLORA}; pg8::StaticOrder S; S.init(M_, NLORA, gridDim.x, blockIdx.x);
    pg8::EpiBf16<0> E{(pg8::bf16_t*)(ws + WS_LORA), NLORA, nullptr, 0, 0, 1.f};
    pg8::gemm_phase<pg8::EpiBf16<0>, pg8::StaticOrder, true, true>(lds, g, S, E); } SEAM(3);
  if (IN(4)) { phase_attn(p, lds, wave, lane); } SEAM(4);
  if (IN(5)) { pg8::Gemm g{(const pg8::bf16_t*)(ws + WS_MIX), (const pg8::bf16_t*)(ws + WS_WOUT), M_, D_, D_}; pg8::StaticOrder S; S.init(M_, D_, gridDim.x, blockIdx.x);
    pg8::EpiResF32 E{p.in[0], p.out, D_};
    pg8::gemm_phase<pg8::EpiResF32, pg8::StaticOrder, true, true>(lds, g, S, E); } SEAM(5);
  if (IN(6)) { phase_rms2(p, wave, lane); } SEAM(6);
#pragma unroll 1
  for (int hh = 0; hh < 2; ++hh) {
    if (IN(7 + 2 * hh)) { pg8::Gemm g{(const pg8::bf16_t*)(ws + WS_XN), (const pg8::bf16_t*)(ws + WS_WUP) + (size_t)hh * NUPH * D_, M_, NUPH, D_}; pg8::StaticOrder S; S.init(M_, NUPH, gridDim.x, blockIdx.x);
      pg8::EpiBf16<0> E{(pg8::bf16_t*)(ws + WS_U), NUPH, nullptr, 0, 0, 1.f};
      pg8::gemm_phase<pg8::EpiBf16<0>, pg8::StaticOrder, true, true>(lds, g, S, E); } SEAM(7 + 2 * hh);
    if (IN(8 + 2 * hh)) { phase_convgate(p, hh); } SEAM(8 + 2 * hh);
  }
  if (IN(11)) { pg8::Gemm g{(const pg8::bf16_t*)(ws + WS_ACT2), (const pg8::bf16_t*)(ws + WS_WDN), M_, D_, DFF}; pg8::StaticOrder S; S.init(M_, D_, gridDim.x, blockIdx.x);
    pg8::EpiResF32 E{p.out, p.out, D_};
    pg8::gemm_phase<pg8::EpiResF32, pg8::StaticOrder, true, true>(lds, g, S, E); }
#undef IN
#undef SEAM
}
}

#ifndef MK_N_LAUNCHES
#define MK_N_LAUNCHES 1
#endif
extern "C" void kernel_launch(void* const* d_in, const int* in_sizes, int n_in, void* d_out, int out_size, void* d_ws, size_t ws_size, hipStream_t stream) {
  static int grid = 0;
  if (grid == 0) {
    if (n_in != 28 || out_size != M_ * D_ || ws_size < WS_END) { fprintf(stderr, "kernel_launch: unexpected shapes (n_in %d out %d ws %zu)\n", n_in, out_size, ws_size); grid = -1; return; }
    int dev = 0, cus = 0, per_cu = 0; hipGetDevice(&dev); hipDeviceGetAttribute(&cus, hipDeviceAttributeMultiprocessorCount, dev);
    if (hipFuncSetAttribute((const void*)mk_fwd, hipFuncAttributeMaxDynamicSharedMemorySize, LDS_BYTES) != hipSuccess) { fprintf(stderr, "kernel_launch: hipFuncSetAttribute failed\n"); grid = -1; return; }
    if (hipOccupancyMaxActiveBlocksPerMultiprocessor(&per_cu, (const void*)mk_fwd, NTHREADS, LDS_BYTES) != hipSuccess || per_cu < 1) { fprintf(stderr, "kernel_launch: occupancy query says %d\n", per_cu); (void)hipGetLastError(); per_cu = 1; }
    grid = cus;
    fprintf(stderr, "kernel_launch: cus %d per_cu %d grid %d\n", cus, per_cu, grid);
  }
  if (grid < 0) return;
  Params p{};
  for (int i = 0; i < 28; ++i) p.in[i] = (const float*)d_in[i];
  p.out = (float*)d_out; p.ws = (unsigned char*)d_ws;
  for (int li = 0; li < MK_N_LAUNCHES; ++li) {
    p.ph_lo = (MK_N_LAUNCHES == 1) ? 0 : li; p.ph_hi = (MK_N_LAUNCHES == 1) ? NPHASE : li + 1;
    void* args[] = {&p};
    hipError_t e = hipLaunchCooperativeKernel((const void*)mk_fwd, dim3(grid), dim3(NTHREADS), args, LDS_BYTES, stream);
    if (e != hipSuccess) { fprintf(stderr, "kernel_launch: cooperative launch %d failed: %s\n", li, hipGetErrorString(e)); break; }
  }
}
```

```cpp
#include <hip/hip_runtime.h>
#include <hip/hip_cooperative_groups.h>
#include <cstdio>
#include <cstdint>
namespace cg = cooperative_groups;
namespace pg8 {
#define PG8_LAS __attribute__((address_space(3)))
typedef unsigned short bf16_t;
typedef short bf16x8 __attribute__((ext_vector_type(8)));
typedef float f32x4 __attribute__((ext_vector_type(4)));
typedef unsigned u32x4 __attribute__((ext_vector_type(4)));
constexpr int BM = 256, BK = 64, HALF = 128, HTB = HALF * BK * 2  , STAGE_BYTES = 8 * HTB, NXCD = 8, WGM = 8;

__host__ __device__ __forceinline__ int lds_byte(int r, int c) { const int st = (r >> 4) * 2 + (c >> 5), rr = r & 15, cc = c & 31, ob = rr * 64 + cc * 2; return st * 1024 + (ob ^ (((ob >> 9) & 1) << 5)); }
__host__ __device__ __forceinline__ void stage_rc(int b, int& R, int& C) { const int st = b / 1024, sb = b % 1024, swz = sb ^ (((sb >> 9) & 1) << 5); R = (st >> 1) * 16 + swz / 64; C = (st & 1) * 32 + (swz % 64) / 2; }
__host__ __device__ __forceinline__ int perm32(int rho) { const int n = rho >> 4, i = rho & 15; return 8 * (i >> 2) + 4 * n + (i & 3); }

struct Unit { int pm, pn; };
struct Gemm { const bf16_t* A; const bf16_t* Bt; int M, N, K; };

struct StaticOrder {
    int nM, nN, nwg, G, c;
    __host__ __device__ void init(int M, int N, int G_, int c_) { nM = M / BM; nN = N / BM; nwg = nM * nN; G = G_; c = c_; }
    __host__ __device__ bool next(int i, Unit& u) const {
        const long L = (long)i * G + c; if (L >= nwg) return false;
        int wgid = (int)L; { const int q = nwg / NXCD, r = nwg % NXCD, xcd = wgid % NXCD, off = wgid / NXCD; wgid = (xcd < r ? xcd * (q + 1) : r * (q + 1) + (xcd - r) * q) + off; }
        const int nig = WGM * nN, gid = wgid / nig, fm = gid * WGM, gsz = (nM - fm) < WGM ? (nM - fm) : WGM;
        u.pm = fm + ((wgid % nig) % gsz); u.pn = (wgid % nig) / gsz; return true;
    }
    __device__ __forceinline__ void a_ready(const Unit&) const {}
    __device__ __forceinline__ void done(const Unit&) const {}
};

__device__ __forceinline__ unsigned cvt_pk_bf16(float lo, float hi) { unsigned r; asm volatile("v_cvt_pk_bf16_f32 %0, %1, %2" : "=v"(r) : "v"(lo), "v"(hi)); return r; }
typedef float f32x2 __attribute__((ext_vector_type(2)));
__device__ __forceinline__ f32x2 gelu_pk(f32x2 v) {
    const f32x2 av = __builtin_elementwise_abs(v), d = av * 0.2316418882f + 1.0f;
    f32x2 t; t.x = __builtin_amdgcn_rcpf(d.x); t.y = __builtin_amdgcn_rcpf(d.y);
    f32x2 q = t * 0.5307027145f + (-0.7265760135f); q = q * t + 0.7107068705f; q = q * t + (-0.142248368f); q = q * t + 0.127414796f; q = q * t;
    const f32x2 s = (v * v) * (-0.72134752044f);
    f32x2 e; e.x = __builtin_amdgcn_exp2f(s.x); e.y = __builtin_amdgcn_exp2f(s.y);
    const f32x2 m = v * (q * e), r = v - m;
    f32x2 o; o.x = v.x < 0.f ? m.x : r.x; o.y = v.y < 0.f ? m.y : r.y; return o;
}

template <int ACT  > struct EpiBf16 {
    static constexpr bool PERM = true, AFTER_DRAIN = false; static_assert(ACT == 0 || ACT == 1, "EpiBf16: ACT is 0 (none) or 1 (gelu_pk)");
    bf16_t* O; int ldc; const float* bias; int split_cols; size_t split_stride; float scale0;
    __device__ __forceinline__ void operator()(const f32x4 (&acc)[2][2][4][2], const Unit& u, int wr, int wc, int fr, int fq) const {
        const int row0 = u.pm * BM + wr * 64 + fr; int colt = u.pn * BM; bf16_t* base = O;
        float sc = 1.f; if (split_cols) { const int t = colt / split_cols; base += (size_t)t * split_stride; colt -= t * split_cols; if (t == 0) sc = scale0; }
        const int col0 = colt + wc * 32 + 8 * fq, bcol0 = u.pn * BM + wc * 32 + 8 * fq;
        f32x4 bv[2][2];
#pragma unroll
        for (int bj = 0; bj < 2; ++bj)
#pragma unroll
            for (int n = 0; n < 2; ++n) bv[bj][n] = bias ? *(const f32x4*)(bias + bcol0 + bj * HALF + 4 * n) : (f32x4){0.f, 0.f, 0.f, 0.f};
#pragma unroll
        for (int ai = 0; ai < 2; ++ai)
#pragma unroll
            for (int m = 0; m < 4; ++m) { bf16_t* rowp = base + (size_t)(row0 + ai * HALF + m * 16) * ldc + col0;
#pragma unroll
                for (int bj = 0; bj < 2; ++bj) { f32x4 v0 = acc[ai][bj][m][0] + bv[bj][0], v1 = acc[ai][bj][m][1] + bv[bj][1];
                    if (ACT == 1) { f32x2 a = gelu_pk((f32x2){v0[0], v0[1]}), b = gelu_pk((f32x2){v0[2], v0[3]}), c = gelu_pk((f32x2){v1[0], v1[1]}), d = gelu_pk((f32x2){v1[2], v1[3]});
                        v0 = (f32x4){a.x, a.y, b.x, b.y}; v1 = (f32x4){c.x, c.y, d.x, d.y}; }
                    v0 = v0 * sc; v1 = v1 * sc; u32x4 w; w.x = cvt_pk_bf16(v0[0], v0[1]); w.y = cvt_pk_bf16(v0[2], v0[3]); w.z = cvt_pk_bf16(v1[0], v1[1]); w.w = cvt_pk_bf16(v1[2], v1[3]);
                    *(u32x4*)(rowp + bj * HALF) = w; } }
    }
};
struct EpiResF32 {
    static constexpr bool PERM = false, AFTER_DRAIN = false;
    const float* base; float* out; int ldc;
    __device__ __forceinline__ void operator()(const f32x4 (&acc)[2][2][4][2], const Unit& u, int wr, int wc, int fr, int fq) const {
        const int row0 = u.pm * BM + wr * 64 + fr, col0 = u.pn * BM + wc * 32 + 4 * fq;
#pragma unroll
        for (int ai = 0; ai < 2; ++ai)
#pragma unroll
            for (int m = 0; m < 4; ++m) { const size_t off = (size_t)(row0 + ai * HALF + m * 16) * ldc + col0;
#pragma unroll
                for (int bj = 0; bj < 2; ++bj)
#pragma unroll
                    for (int n = 0; n < 2; ++n) { const f32x4 b = *(const f32x4*)(base + off + bj * HALF + n * 16); *(f32x4*)(out + off + bj * HALF + n * 16) = b + acc[ai][bj][m][n]; } }
    }
};
struct EpiProj {
    static constexpr bool PERM = true, AFTER_DRAIN = false; static constexpr float QS = 0.125f * 1.4426950408889634f;
    bf16_t* Q; bf16_t* SLAB;   bf16_t* RW; float* GATES; const float* qg; const float* kg;
    __device__ __forceinline__ void operator()(const f32x4 (&acc)[2][2][4][2], const Unit& u, int wr, int wc, int fr, int fq) const {
        const int grp = 4 * u.pn + wc;
        if (grp >= 49) return;
        const int row0 = u.pm * BM + wr * 64 + fr, d0 = 8 * fq;
        int kind; const float* g = nullptr;
        if (grp < 8) { kind = 1; g = qg; } else if (grp < 20) { const int which = (grp - 8) >> 1; kind = (which == 2 || which == 4) ? 1 : 0; g = kg + (which == 2 ? 64 : 128); } else if (grp == 20) kind = 2; else kind = 0;
        float gv[16];
        if (kind == 1) {
#pragma unroll
            for (int i = 0; i < 8; ++i) { gv[i] = g[d0 + i]; gv[8 + i] = g[32 + d0 + i]; }
        }
#pragma unroll
        for (int ai = 0; ai < 2; ++ai)
#pragma unroll
            for (int m = 0; m < 4; ++m) {
                const int row = row0 + ai * HALF + m * 16;
                f32x4 v0 = acc[ai][0][m][0], v1 = acc[ai][0][m][1], v2 = acc[ai][1][m][0], v3 = acc[ai][1][m][1];
                if (kind == 2) {
                    if (fq < 3) { float* gp = GATES + (size_t)row * 32 + d0;
                        f32x4 a, b;
#pragma unroll
                        for (int i = 0; i < 4; ++i) { a[i] = 1.f / (1.f + __expf(-v0[i])); b[i] = 1.f / (1.f + __expf(-v1[i])); }
                        *(f32x4*)gp = a; *(f32x4*)(gp + 4) = b; }
                    continue;
                }
                if (kind == 1) {
                    float ss = 0.f;
#pragma unroll
                    for (int i = 0; i < 4; ++i) ss += v0[i] * v0[i] + v1[i] * v1[i] + v2[i] * v2[i] + v3[i] * v3[i];
                    ss += __shfl_xor(ss, 16); ss += __shfl_xor(ss, 32);
                    const float s = rsqrtf(ss * (1.f / 64.f) + 1e-6f);
#pragma unroll
                    for (int i = 0; i < 4; ++i) { v0[i] *= s * gv[i]; v1[i] *= s * gv[4 + i]; v2[i] *= s * gv[8 + i]; v3[i] *= s * gv[12 + i]; }
                    if (grp < 8) { v0 = v0 * QS; v1 = v1 * QS; v2 = v2 * QS; v3 = v3 * QS; }
                }
                bf16_t* p;
                if (grp < 8) p = Q + (size_t)row * 512 + grp * 64;
                else if (grp < 20) { const int sl = grp - 8; p = SLAB + ((size_t)(sl >> 1) * 4 + (size_t)((row >> 13) * 2 + (sl & 1))) * (8192 * 64) + (size_t)(row & 8191) * 64; }
                else p = RW + (size_t)row * 1792 + (grp - 21) * 64;
                u32x4 w0, w1; w0.x = cvt_pk_bf16(v0[0], v0[1]); w0.y = cvt_pk_bf16(v0[2], v0[3]); w0.z = cvt_pk_bf16(v1[0], v1[1]); w0.w = cvt_pk_bf16(v1[2], v1[3]);
                w1.x = cvt_pk_bf16(v2[0], v2[1]); w1.y = cvt_pk_bf16(v2[2], v2[3]); w1.z = cvt_pk_bf16(v3[0], v3[1]); w1.w = cvt_pk_bf16(v3[2], v3[3]);
                *(u32x4*)(p + d0) = w0; *(u32x4*)(p + 32 + d0) = w1;
            }
    }
};
template <class Epi, class Sched, bool ALIGN_EPI = false, bool SP2 = false>
__device__ __forceinline__ void gemm_phase(PG8_LAS unsigned char* lds, const Gemm g, const Sched& S, const Epi& E) {
    const int tid = threadIdx.x, wid = __builtin_amdgcn_readfirstlane(tid >> 6), lane = tid & 63, wr = wid >> 2, wc = wid & 3, fr = lane & 15, fq = lane >> 4;
    const int K = g.K, nt = K / BK;
    unsigned voffA[2], voffB[2];
#pragma unroll
    for (int i = 0; i < 2; ++i) { int R, C; stage_rc(tid * 16 + i * 8192, R, C); const int Rb = Epi::PERM ? ((R & ~31) + perm32(R & 31)) : R;
        voffA[i] = (unsigned)(R * K + C) * 2u; voffB[i] = (unsigned)(Rb * K + C) * 2u; }
    const size_t kstep = (size_t)(BK * 2);
    const size_t hstep = (size_t)HALF * K * 2;
    const size_t tstep = 2 * hstep;
    const unsigned ldsw = (unsigned)wid * 1024u;
    const int aoff = lds_byte(wr * 64 + fr, fq * 8), boff = lds_byte(wc * 32 + fr, fq * 8);
#define PG8_SA(b, h) (((b) * 2 + (h)) * HTB)
#define PG8_SB(b, h) ((4 + (b) * 2 + (h)) * HTB)
#define PG8_STAGE(bufoff, gbase, voff) do { _Pragma("unroll") for (int _i = 0; _i < 2; ++_i) \
        __builtin_amdgcn_global_load_lds((const unsigned*)((const char*)(gbase) + (voff)[_i]), (PG8_LAS unsigned*)(lds + (bufoff) + ldsw + _i * 8192), 16, 0, 0); } while (0)
#define PG8_LDA(dst, b, h) do { _Pragma("unroll") for (int m = 0; m < 4; ++m) _Pragma("unroll") for (int k = 0; k < 2; ++k) dst[m][k] = *(const PG8_LAS bf16x8*)(lds + PG8_SA(b, h) + aoff + m * 2048 + k * 1024); } while (0)
#define PG8_LDB(dst, b, h) do { _Pragma("unroll") for (int n = 0; n < 2; ++n) _Pragma("unroll") for (int k = 0; k < 2; ++k) dst[n][k] = *(const PG8_LAS bf16x8*)(lds + PG8_SB(b, h) + boff + n * 2048 + k * 1024); } while (0)
#define PG8_MMA(ai, bj, At, Bt) do { __builtin_amdgcn_s_setprio(1); _Pragma("unroll") for (int m = 0; m < 4; ++m) _Pragma("unroll") for (int n = 0; n < 2; ++n) _Pragma("unroll") for (int k = 0; k < 2; ++k) \
        acc[ai][bj][m][n] = __builtin_amdgcn_mfma_f32_16x16x32_bf16(Bt[n][k], At[m][k], acc[ai][bj][m][n], 0, 0, 0); __builtin_amdgcn_s_setprio(0); } while (0)
#define PG8_WAIT_V(n) asm volatile("s_waitcnt vmcnt(" #n ")" ::: "memory")
#define PG8_WAIT_L(n) asm volatile("s_waitcnt lgkmcnt(" #n ")" ::: "memory")
#define PG8_BAR __builtin_amdgcn_s_barrier()
#define PG8_SCHED __builtin_amdgcn_sched_barrier(0)
    Unit cur, nxt; int ui = 0;
    if (!S.next(0, cur)) return;
    f32x4 acc[2][2][4][2];
#pragma unroll
    for (int a = 0; a < 2; ++a)
#pragma unroll
        for (int b = 0; b < 2; ++b)
#pragma unroll
            for (int m = 0; m < 4; ++m)
#pragma unroll
                for (int n = 0; n < 2; ++n) acc[a][b][m][n] = (f32x4){0.f, 0.f, 0.f, 0.f};
    bf16x8 At[4][2], B0[2][2], B1[2][2];
    const char* cA = (const char*)g.A + (size_t)cur.pm * tstep; const char* cB = (const char*)g.Bt + (size_t)cur.pn * tstep;
    S.a_ready(cur);
    if constexpr (SP2) {
        PG8_STAGE(PG8_SB(0, 0), cB, voffB); PG8_STAGE(PG8_SB(0, 1), cB + hstep, voffB); PG8_STAGE(PG8_SA(0, 0), cA, voffA); PG8_STAGE(PG8_SA(0, 1), cA + hstep, voffA);
        if (wr == 1) PG8_BAR;
        PG8_WAIT_V(2); PG8_BAR;
        PG8_STAGE(PG8_SB(1, 0), cB + kstep, voffB); PG8_STAGE(PG8_SA(1, 0), cA + kstep, voffA); PG8_STAGE(PG8_SB(1, 1), cB + hstep + kstep, voffB);
        PG8_WAIT_V(6); PG8_BAR;
    } else {
        PG8_STAGE(PG8_SB(0, 0), cB, voffB); PG8_STAGE(PG8_SA(0, 0), cA, voffA); PG8_STAGE(PG8_SB(0, 1), cB + hstep, voffB); PG8_STAGE(PG8_SA(0, 1), cA + hstep, voffA);
        if (wr == 1) PG8_BAR;
        PG8_WAIT_V(4); PG8_BAR;
        PG8_STAGE(PG8_SB(1, 0), cB + kstep, voffB); PG8_STAGE(PG8_SA(1, 0), cA + kstep, voffA); PG8_STAGE(PG8_SB(1, 1), cB + hstep + kstep, voffB);
        PG8_WAIT_V(6); PG8_BAR;
    }
    for (;;) {
        const bool has_next = S.next(ui + 1, nxt);
        const char* nA = has_next ? (const char*)g.A + (size_t)nxt.pm * tstep : cA; const char* nB = has_next ? (const char*)g.Bt + (size_t)nxt.pn * tstep : cB;
        for (int t = 0; t < nt; t += 2) {
            const bool last = (t == nt - 2);
            const char* a1 = cA + (size_t)(t + 1) * kstep;
            const char* a2 = last ? nA : cA + (size_t)(t + 2) * kstep; const char* b2 = last ? nB : cB + (size_t)(t + 2) * kstep;
            const char* a3 = a2 + kstep; const char* b3 = b2 + kstep;
            if (last && has_next) S.a_ready(nxt);
            if constexpr (SP2) {
            PG8_LDB(B0, 0, 0); PG8_LDB(B1, 0, 1); PG8_SCHED; PG8_LDA(At, 0, 0); PG8_STAGE(PG8_SA(1, 1), a1 + hstep, voffA);
            PG8_WAIT_V(8); PG8_WAIT_L(0); PG8_BAR; PG8_MMA(0, 0, At, B0); PG8_MMA(0, 1, At, B1); PG8_BAR; PG8_SCHED;
            PG8_LDA(At, 0, 1); PG8_STAGE(PG8_SB(0, 0), b2, voffB); PG8_STAGE(PG8_SB(0, 1), b2 + hstep, voffB); PG8_STAGE(PG8_SA(0, 0), a2, voffA);
            PG8_WAIT_V(8); PG8_WAIT_L(0); PG8_BAR; PG8_MMA(1, 0, At, B0); PG8_MMA(1, 1, At, B1); PG8_BAR; PG8_SCHED;
            PG8_LDB(B0, 1, 0); PG8_LDB(B1, 1, 1); PG8_SCHED; PG8_LDA(At, 1, 0); PG8_STAGE(PG8_SA(0, 1), a2 + hstep, voffA);
            PG8_WAIT_V(8); PG8_WAIT_L(0); PG8_BAR; PG8_MMA(0, 0, At, B0); PG8_MMA(0, 1, At, B1); PG8_BAR; PG8_SCHED;
            PG8_LDA(At, 1, 1); PG8_STAGE(PG8_SB(1, 0), b3, voffB); PG8_STAGE(PG8_SB(1, 1), b3 + hstep, voffB); PG8_STAGE(PG8_SA(1, 0), a3, voffA);
            PG8_WAIT_V(8); PG8_WAIT_L(0); PG8_BAR; PG8_MMA(1, 0, At, B0); PG8_MMA(1, 1, At, B1); PG8_BAR; PG8_SCHED;
            } else {
            PG8_LDB(B0, 0, 0); PG8_SCHED; PG8_LDA(At, 0, 0); PG8_STAGE(PG8_SA(1, 1), a1 + hstep, voffA);
            PG8_WAIT_L(8); PG8_BAR; PG8_WAIT_L(0); PG8_MMA(0, 0, At, B0); PG8_BAR; PG8_SCHED;
            PG8_LDB(B1, 0, 1); PG8_STAGE(PG8_SB(0, 0), b2, voffB);
            PG8_BAR; PG8_WAIT_L(0); PG8_MMA(0, 1, At, B1); PG8_BAR;
            PG8_LDA(At, 0, 1); PG8_STAGE(PG8_SA(0, 0), a2, voffA);
            PG8_BAR; PG8_WAIT_L(0); PG8_MMA(1, 0, At, B0); PG8_BAR; PG8_SCHED;
            PG8_STAGE(PG8_SB(0, 1), b2 + hstep, voffB);
            PG8_WAIT_V(6); PG8_BAR; PG8_MMA(1, 1, At, B1); PG8_BAR;
            PG8_LDB(B0, 1, 0); PG8_SCHED; PG8_LDA(At, 1, 0); PG8_STAGE(PG8_SA(0, 1), a2 + hstep, voffA);
            PG8_WAIT_L(8); PG8_BAR; PG8_WAIT_L(0); PG8_MMA(0, 0, At, B0); PG8_BAR; PG8_SCHED;
            PG8_LDB(B1, 1, 1); PG8_STAGE(PG8_SB(1, 0), b3, voffB);
            PG8_BAR; PG8_WAIT_L(0); PG8_MMA(0, 1, At, B1); PG8_BAR;
            PG8_LDA(At, 1, 1); PG8_STAGE(PG8_SA(1, 0), a3, voffA);
            PG8_BAR; PG8_WAIT_L(0); PG8_MMA(1, 0, At, B0); PG8_BAR; PG8_SCHED;
            PG8_STAGE(PG8_SB(1, 1), b3 + hstep, voffB);
            PG8_WAIT_V(6); PG8_BAR; PG8_MMA(1, 1, At, B1); PG8_BAR;
            }
        }
        if constexpr (ALIGN_EPI) { if (wr == 0) PG8_BAR; }
        if constexpr (!Epi::AFTER_DRAIN) { E(acc, cur, wr, wc, fr, fq); S.done(cur); }
        if (!has_next) break;
#pragma unroll
        for (int a = 0; a < 2; ++a)
#pragma unroll
            for (int b = 0; b < 2; ++b)
#pragma unroll
                for (int m = 0; m < 4; ++m)
#pragma unroll
                    for (int n = 0; n < 2; ++n) acc[a][b][m][n] = (f32x4){0.f, 0.f, 0.f, 0.f};
        cur = nxt; cA = nA; cB = nB; ++ui;
        if constexpr (ALIGN_EPI) { if (wr == 1) PG8_BAR; }
    }
    PG8_WAIT_V(0);
    if constexpr (!ALIGN_EPI) { if (wr == 0) PG8_BAR; }
    PG8_BAR;
    if constexpr (Epi::AFTER_DRAIN) { E.fused(acc, cur, wr, wc, fr, fq, lds, wid, lane); S.done(cur); }
#undef PG8_SA
#undef PG8_SB
#undef PG8_STAGE
#undef PG8_LDA
#undef PG8_LDB
#undef PG8_MMA
#undef PG8_WAIT_V
#undef PG8_WAIT_L
#undef PG8_BAR
#undef PG8_SCHED
}
}

namespace nsa {
#define NLAS __attribute__((address_space(3)))
typedef short bf16x8 __attribute__((ext_vector_type(8)));
typedef short s16x4 __attribute__((ext_vector_type(4)));
typedef float f32x16 __attribute__((ext_vector_type(16)));
typedef unsigned u32x4 __attribute__((ext_vector_type(4)));
typedef short v4i16_t __attribute__((ext_vector_type(4)));
typedef unsigned short bf16;
typedef float f32x2_t __attribute__((ext_vector_type(2))); typedef __bf16 bf16x2_t __attribute__((ext_vector_type(2)));

constexpr float LOG2E = 1.4426950408889634f;
constexpr float QSCALE = 0.125f * LOG2E;
constexpr float NEGBIG = -1e30f;
constexpr int L_K = 0, L_V = 16384, L_IMP = 32768, L_SELM = 65536, L_TAB = 66560, L_WSF = 69120, L_OST = 71168, L_BYTES = 136704;
constexpr int TOPN = 16;

struct Tensors { const bf16* Q; const bf16* KS; const bf16* VS; const bf16* KW; const bf16* VW; const bf16* KC; const bf16* VC; const float* gates; const float* rel_bias; bf16* MIX; };

__device__ __forceinline__ int crow(int r, int hi) { return (r & 3) + 8 * (r >> 2) + 4 * hi; }
__device__ __forceinline__ int t5bucket(int n) {
  if (n < 16) return n < 0 ? 0 : n;
  if (n >= 128) return 31;
  int v = 16 + (int)(logf((float)n / 16.f) / 2.0794415416798357f * 16.f);
  return v > 31 ? 31 : v;
}
__device__ __forceinline__ unsigned cvtpk(float lo, float hi) { f32x2_t v = {lo, hi}; bf16x2_t b = __builtin_convertvector(v, bf16x2_t); return __builtin_bit_cast(unsigned, b); }
__device__ __forceinline__ void dma16(const void* g, NLAS unsigned char* l) { __builtin_amdgcn_global_load_lds((const unsigned*)g, (NLAS unsigned*)l, 16, 0, 0); }
__device__ __forceinline__ s16x4 vtr(const NLAS unsigned char* p) { return __builtin_bit_cast(s16x4, __builtin_amdgcn_ds_read_tr16_b64_v4i16((NLAS v4i16_t*)p)); }
__device__ __forceinline__ void lds_add(NLAS unsigned* p, unsigned v) { (void)__hip_atomic_fetch_add(p, v, __ATOMIC_RELAXED, __HIP_MEMORY_SCOPE_WORKGROUP); }
#define NSA_WAITBAR() asm volatile("s_waitcnt vmcnt(0) lgkmcnt(0)\n\ts_barrier" ::: "memory")

__device__ __forceinline__ void issue_tile(NLAS unsigned char* lds, int slot, const bf16* Kb, const bf16* Vb, int row0, int wid, int lane, bool withV) {
  dma16(Kb + (size_t)(row0 + lane) * 64 + wid * 8, lds + L_K + slot * 8192 + wid * 1024);
  if (withV) dma16(Vb + (size_t)(row0 + 16 * (wid & 3) + (lane >> 2)) * 64 + (wid >> 2) * 32 + (lane & 3) * 8, lds + L_V + slot * 8192 + wid * 1024);
}

template <int PASS>
__device__ __forceinline__ void tile_compute(NLAS unsigned char* lds, int slot, const bf16x8 (&qr)[4], f32x16& o0, f32x16& o1, float& mhat, float& lsum,
                                             float cbase, bool lanesel, bool near, int dq, int step, int dmax, const NLAS float* tabr,
                                             float invl, NLAS unsigned* impq, int nbase, NLAS float* wsf, int lane) {
  const int r32 = lane & 31, hi = lane >> 5;
  const float cinit = lanesel ? (cbase - mhat) : NEGBIG;
  f32x16 p0, p1;
#pragma unroll
  for (int r = 0; r < 16; ++r) { p0[r] = cinit; p1[r] = cinit; }
  {
    const NLAS unsigned char* kb = lds + L_K + slot * 8192 + hi * 1024 + r32 * 16;
#pragma unroll
    for (int d0 = 0; d0 < 4; ++d0) {
      const bf16x8 b0 = *(const NLAS bf16x8*)(kb + d0 * 2048), b1 = *(const NLAS bf16x8*)(kb + d0 * 2048 + 512);
      p0 = __builtin_amdgcn_mfma_f32_32x32x16_bf16(b0, qr[d0], p0, 0, 0, 0);
      p1 = __builtin_amdgcn_mfma_f32_32x32x16_bf16(b1, qr[d0], p1, 0, 0, 0);
    }
  }
  if (near) {
#pragma unroll
    for (int r = 0; r < 16; ++r) {
      const int kk = crow(r, hi);
      { const int d = dq - step * kk; const bool vis = (d >= 0) && (d < dmax); const int idx = d < 0 ? 0 : (d > 128 ? 128 : d); const float v = p0[r] + tabr[idx]; p0[r] = vis ? v : NEGBIG; }
      { const int d = dq - step * (kk + 32); const bool vis = (d >= 0) && (d < dmax); const int idx = d < 0 ? 0 : (d > 128 ? 128 : d); const float v = p1[r] + tabr[idx]; p1[r] = vis ? v : NEGBIG; }
    }
  }
  if (PASS != 2) {
    float a = fmaxf(fmaxf(p0[0], p0[1]), p1[0]), b = fmaxf(fmaxf(p0[2], p0[3]), p1[1]); a = fmaxf(fmaxf(a, p1[2]), p1[3]);
#pragma unroll
    for (int r = 4; r < 16; r += 4) { a = fmaxf(fmaxf(a, p0[r]), p0[r + 1]); b = fmaxf(fmaxf(b, p0[r + 2]), p0[r + 3]); a = fmaxf(fmaxf(a, p1[r]), p1[r + 1]); b = fmaxf(fmaxf(b, p1[r + 2]), p1[r + 3]); }
    float rm = fmaxf(a, b);
    { auto rr = __builtin_amdgcn_permlane32_swap(__float_as_uint(rm), __float_as_uint(rm), false, false); rm = fmaxf(__uint_as_float(rr[0]), __uint_as_float(rr[1])); }
    if (__any(rm > 8.f)) {
      const float dl = fmaxf(rm, 0.f); mhat += dl;
#pragma unroll
      for (int r = 0; r < 16; ++r) { p0[r] -= dl; p1[r] -= dl; }
      const float f = __builtin_amdgcn_exp2f(-dl); lsum *= f;
      if (PASS == 0) {
        if (hi == 0) wsf[r32] = f;
        asm volatile("s_waitcnt lgkmcnt(0)" ::: "memory");
#pragma unroll
        for (int r = 0; r < 16; ++r) { const float fr = wsf[crow(r, hi)]; o0[r] *= fr; o1[r] *= fr; }
        asm volatile("s_waitcnt lgkmcnt(0)" ::: "memory");
      }
    }
  }
#pragma unroll
  for (int r = 0; r < 16; ++r) { p0[r] = __builtin_amdgcn_exp2f(p0[r]); p1[r] = __builtin_amdgcn_exp2f(p1[r]); }
  if (PASS == 2) {
#pragma unroll
    for (int r = 0; r < 16; ++r) { p0[r] *= invl; p1[r] *= invl; }
    if (impq) {
#pragma unroll
      for (int a = 0; a < 4; ++a) {
        { const int n = nbase + 2 * a + hi; const float gs = (p0[4 * a] + p0[4 * a + 1]) + (p0[4 * a + 2] + p0[4 * a + 3]);
          lds_add(impq + n, (unsigned)(gs * 1048576.f + 0.5f)); if (n + 1 < 128) lds_add(impq + n + 1, (unsigned)(p0[4 * a + 3] * 1048576.f + 0.5f)); }
        { const int n = nbase + 8 + 2 * a + hi; const float gs = (p1[4 * a] + p1[4 * a + 1]) + (p1[4 * a + 2] + p1[4 * a + 3]);
          lds_add(impq + n, (unsigned)(gs * 1048576.f + 0.5f)); if (n + 1 < 128) lds_add(impq + n + 1, (unsigned)(p1[4 * a + 3] * 1048576.f + 0.5f)); }
      }
    }
  } else {
    float s = 0.f;
#pragma unroll
    for (int r = 0; r < 16; ++r) s += p0[r] + p1[r];
    lsum += s;
  }
  if (PASS != 1) {
    u32x4 pw[4];
#pragma unroll
    for (int k = 0; k < 4; ++k) { pw[0][k] = cvtpk(p0[2 * k], p0[2 * k + 1]); pw[1][k] = cvtpk(p0[8 + 2 * k], p0[8 + 2 * k + 1]); pw[2][k] = cvtpk(p1[2 * k], p1[2 * k + 1]); pw[3][k] = cvtpk(p1[8 + 2 * k], p1[8 + 2 * k + 1]); }
    const NLAS unsigned char* vp = lds + L_V + slot * 8192 + ((lane >> 4) & 1) * 32 + (lane & 3) * 8 + (4 * hi + ((lane & 15) >> 2)) * 64;
#pragma unroll
    for (int ks = 0; ks < 4; ++ks) {
      const bf16x8 pa = __builtin_bit_cast(bf16x8, pw[ks]);
      { const s16x4 lo = vtr(vp + ks * 1024), hh = vtr(vp + ks * 1024 + 512); const bf16x8 vf = {lo[0], lo[1], lo[2], lo[3], hh[0], hh[1], hh[2], hh[3]};
        o0 = __builtin_amdgcn_mfma_f32_32x32x16_bf16(pa, vf, o0, 0, 0, 0); }
      { const s16x4 lo = vtr(vp + 4096 + ks * 1024), hh = vtr(vp + 4096 + ks * 1024 + 512); const bf16x8 vf = {lo[0], lo[1], lo[2], lo[3], hh[0], hh[1], hh[2], hh[3]};
        o1 = __builtin_amdgcn_mfma_f32_32x32x16_bf16(pa, vf, o1, 0, 0, 0); }
    }
  }
}

template <bool FIRST>
__device__ __forceinline__ void add_scaled(NLAS float* stg, const f32x16& o0, const f32x16& o1, float fac, NLAS float* wsf, int lane) {
  const int r32 = lane & 31, hi = lane >> 5;
  if (hi == 0) wsf[r32] = fac;
  asm volatile("s_waitcnt lgkmcnt(0)" ::: "memory");
#pragma unroll
  for (int r = 0; r < 16; ++r) { const int orow = crow(r, hi); const float f = wsf[orow];
    if (FIRST) { stg[orow * 64 + r32] = o0[r] * f; stg[orow * 64 + 32 + r32] = o1[r] * f; }
    else { stg[orow * 64 + r32] += o0[r] * f; stg[orow * 64 + 32 + r32] += o1[r] * f; } }
  asm volatile("s_waitcnt lgkmcnt(0)" ::: "memory");
}
__device__ __forceinline__ float merge_halves_sum(float v) { auto rr = __builtin_amdgcn_permlane32_swap(__float_as_uint(v), __float_as_uint(v), false, false); return __uint_as_float(rr[0]) + __uint_as_float(rr[1]); }

__device__ __forceinline__ void unit(const Tensors& T, int b, int g, int qb, NLAS unsigned char* lds) {
  int tid_ = threadIdx.x; asm volatile("" : "+v"(tid_));
  const int tid = tid_, lane = tid & 63, wid = __builtin_amdgcn_readfirstlane(tid >> 6), r32 = lane & 31, hi = lane >> 5;
  const int hr = wid >> 1, qh = wid & 1, h = 4 * g + hr, slab = b * 2 + g, t0 = 64 * qb, qq = 32 * qh + r32, t = t0 + qq;
  const size_t tok = (size_t)b * 8192 + t;
  NLAS unsigned* imp = (NLAS unsigned*)(lds + L_IMP); NLAS unsigned* selm = (NLAS unsigned*)(lds + L_SELM); NLAS float* tab = (NLAS float*)(lds + L_TAB);
  NLAS float* wsf = (NLAS float*)(lds + L_WSF) + wid * 64; const NLAS float* tabr = tab + hr * 132;
  const bool dotopk = qb >= TOPN;
  for (int i = tid; i < 4 * 129; i += 512) { const int rr = i / 129, d = i % 129; tab[rr * 132 + d] = T.rel_bias[t5bucket(d) * 8 + 4 * g + rr] * LOG2E; }
  if (dotopk) for (int i = tid; i < 64 * 128; i += 512) imp[i] = 0u;
  bf16x8 qr[4];
#pragma unroll
  for (int d0 = 0; d0 < 4; ++d0) qr[d0] = *(const bf16x8*)(T.Q + tok * 512 + h * 64 + d0 * 16 + hi * 8);
  const float* gp = T.gates + tok * 32 + h * 3; const float g_c = gp[0], g_s = gp[1], g_w = gp[2];
  NLAS float* stg = (NLAS float*)(lds + L_OST) + wid * 2048;
  const bf16* KC = T.KC + (size_t)slab * 512 * 64; const bf16* VC = T.VC + (size_t)slab * 512 * 64;
  const bf16* KS = T.KS + (size_t)slab * 8192 * 64; const bf16* VS = T.VS + (size_t)slab * 8192 * 64;
  const bf16* KW = T.KW + (size_t)slab * 8192 * 64; const bf16* VW = T.VW + (size_t)slab * 8192 * 64;
  issue_tile(lds, 0, KC, VC, 0, wid, lane, false);
  NSA_WAITBAR();
  const float b31 = tabr[128];
  const int nct = ((4 * qb + 2) >> 6) + 1;
  float mhat = 0.f, lsum = 0.f; f32x16 o0, o1;
#pragma unroll
  for (int r = 0; r < 16; ++r) { o0[r] = 0.f; o1[r] = 0.f; }
  for (int ct = 0; ct < nct; ++ct) {
    if (ct + 1 < nct) issue_tile(lds, (ct + 1) & 1, KC, VC, 64 * (ct + 1), wid, lane, false);
    const bool near = ct + 2 >= nct;
    tile_compute<1>(lds, ct & 1, qr, o0, o1, mhat, lsum, near ? 0.f : b31, true, near, t - 31 - 1024 * ct, 16, 1 << 30, tabr, 0.f, nullptr, 0, wsf, lane);
    NSA_WAITBAR();
  }
  lsum = merge_halves_sum(lsum);
  const float invl_c = lsum > 0.f ? 1.f / lsum : 0.f;
  issue_tile(lds, 0, KC, VC, 0, wid, lane, true);
  NSA_WAITBAR();
  for (int ct = 0; ct < nct; ++ct) {
    if (ct + 1 < nct) issue_tile(lds, (ct + 1) & 1, KC, VC, 64 * (ct + 1), wid, lane, true);
    const bool near = ct + 2 >= nct;
    tile_compute<2>(lds, ct & 1, qr, o0, o1, mhat, lsum, near ? 0.f : b31, true, near, t - 31 - 1024 * ct, 16, 1 << 30, tabr, invl_c, dotopk ? imp + qq * 128 : nullptr, 16 * ct, wsf, lane);
    NSA_WAITBAR();
  }
  add_scaled<true>(stg, o0, o1, g_c, wsf, lane);
  {
    const int q = tid >> 3, part = tid & 7; unsigned bits = 0u;
    if (dotopk) {
      unsigned key[16];
#pragma unroll
      for (int i = 0; i < 16; ++i) { const int n = 16 * part + i; const unsigned v = imp[q * 128 + n]; key[i] = (n >= 1 && n <= qb - 2) ? ((v << 7) | (unsigned)(127 - n)) : 0u; }
      unsigned thr = 0u;
      for (int bit = 31; bit >= 0; --bit) { const unsigned cand = thr | (1u << bit); int cnt = 0;
#pragma unroll
        for (int i = 0; i < 16; ++i) cnt += (key[i] >= cand) ? 1 : 0;
        cnt += __shfl_xor(cnt, 1); cnt += __shfl_xor(cnt, 2); cnt += __shfl_xor(cnt, 4);
        if (cnt >= TOPN - 3) thr = cand; }
#pragma unroll
      for (int i = 0; i < 16; ++i) { const int n = 16 * part + i; if ((key[i] >= thr && key[i] != 0u) || n == 0 || n == qb || n == qb - 1) bits |= 1u << i; }
    } else {
#pragma unroll
      for (int i = 0; i < 16; ++i) if (16 * part + i <= qb) bits |= 1u << i;
    }
    ((NLAS unsigned short*)selm)[q * 8 + part] = (unsigned short)bits;
  }
  issue_tile(lds, 0, KS, VS, 0, wid, lane, true);
  NSA_WAITBAR();
  const unsigned long long mlo = (unsigned long long)selm[qq * 4 + 0] | ((unsigned long long)selm[qq * 4 + 1] << 32), mhi = (unsigned long long)selm[qq * 4 + 2] | ((unsigned long long)selm[qq * 4 + 3] << 32);
  mhat = 0.f; lsum = 0.f;
#pragma unroll
  for (int r = 0; r < 16; ++r) { o0[r] = 0.f; o1[r] = 0.f; }
  for (int j = 0; j <= qb; ++j) {
    if (j < qb) issue_tile(lds, (j + 1) & 1, KS, VS, 64 * (j + 1), wid, lane, true);
    const bool near = j + 2 >= qb; const bool sel = (((j < 64 ? mlo : mhi) >> (j & 63)) & 1ull) != 0ull;
    tile_compute<0>(lds, j & 1, qr, o0, o1, mhat, lsum, near ? 0.f : b31, sel, near, t - 64 * j, 1, 1 << 30, tabr, 0.f, nullptr, 0, wsf, lane);
    NSA_WAITBAR();
  }
  lsum = merge_halves_sum(lsum);
  add_scaled<false>(stg, o0, o1, lsum > 0.f ? g_s / lsum : 0.f, wsf, lane);
  const int jw0 = qb >= 8 ? qb - 8 : 0;
  issue_tile(lds, jw0 & 1, KW, VW, 64 * jw0, wid, lane, true);
  NSA_WAITBAR();
  mhat = 0.f; lsum = 0.f;
#pragma unroll
  for (int r = 0; r < 16; ++r) { o0[r] = 0.f; o1[r] = 0.f; }
  for (int j = jw0; j <= qb; ++j) {
    if (j < qb) issue_tile(lds, (j + 1) & 1, KW, VW, 64 * (j + 1), wid, lane, true);
    const bool near = (j + 2 >= qb) || (j + 8 == qb);
    tile_compute<0>(lds, j & 1, qr, o0, o1, mhat, lsum, near ? 0.f : b31, true, near, t - 64 * j, 1, 512, tabr, 0.f, nullptr, 0, wsf, lane);
    NSA_WAITBAR();
  }
  lsum = merge_halves_sum(lsum);
  add_scaled<false>(stg, o0, o1, lsum > 0.f ? g_w / lsum : 0.f, wsf, lane);
  {
    bf16* Ow = T.MIX + ((size_t)b * 8192 + t0 + 32 * qh) * 1024 + h * 64;
#pragma unroll
    for (int i = 0; i < 4; ++i) { const int row = i * 8 + (lane >> 3), ch = lane & 7; const NLAS float* sp = stg + row * 64 + ch * 8;
      u32x4 v; v.x = cvtpk(sp[0], sp[1]); v.y = cvtpk(sp[2], sp[3]); v.z = cvtpk(sp[4], sp[5]); v.w = cvtpk(sp[6], sp[7]); *(u32x4*)(Ow + (size_t)row * 1024 + ch * 8) = v; }
  }
  NSA_WAITBAR();
}
}
namespace rwkv {
#define RLAS __attribute__((address_space(3)))
typedef unsigned short bf16;
typedef short bf16x8 __attribute__((ext_vector_type(8)));
typedef short bf16x4 __attribute__((ext_vector_type(4)));
typedef float f32x4 __attribute__((ext_vector_type(4)));
typedef unsigned u32x2 __attribute__((ext_vector_type(2)));
typedef unsigned u32x4 __attribute__((ext_vector_type(4)));
typedef float f32x2_t __attribute__((ext_vector_type(2))); typedef __bf16 bf16x2_t __attribute__((ext_vector_type(2)));
constexpr int LD = 72, MATB = 64 * LD * 2;
constexpr int M_AT = 0, M_ATT = MATB, M_BT = 2 * MATB, M_BTT = 3 * MATB, M_KT = 4 * MATB, M_KTT = 5 * MATB, M_RT = 6 * MATB, M_VT = 7 * MATB;
constexpr int A_AB = 8 * MATB, A_AK = 9 * MATB, A_RB = 10 * MATB, A_RK = 11 * MATB, L_DIAG = 12 * MATB, L_TII = L_DIAG + 4096, L_E = L_TII + 2048, L_SEG = L_E + 16384, L_PC = L_SEG + 2048, L_BYTES = L_PC + 256;
struct Tensors {
  const bf16* RW; const bf16* LORA;
  const float *mu, *w0, *a0, *k_k, *k_a, *r_k, *ln_w, *ln_b;
  bf16 *G, *HADD, *RWM, *Y0, *HT; float* PC;
  bf16* MIX;
};
__device__ __forceinline__ int opq(int x) { asm volatile("" : "+s"(x)); return x; }
__device__ __forceinline__ float bf2f(bf16 v) { return __uint_as_float((unsigned)v << 16); }
__device__ __forceinline__ unsigned cvtpk(float lo, float hi) { f32x2_t v = {lo, hi}; bf16x2_t b = __builtin_convertvector(v, bf16x2_t); return __builtin_bit_cast(unsigned, b); }
__device__ __forceinline__ bf16x4 pack4(const f32x4& v) { u32x2 r; r.x = cvtpk(v[0], v[1]); r.y = cvtpk(v[2], v[3]); return __builtin_bit_cast(bf16x4, r); }
__device__ __forceinline__ f32x4 mfma16(bf16x4 a, bf16x4 b, f32x4 c) { return __builtin_amdgcn_mfma_f32_16x16x16bf16_1k(a, b, c, 0, 0, 0); }
__device__ __forceinline__ f32x4 mfma32(bf16x8 a, bf16x8 b, f32x4 c) { return __builtin_amdgcn_mfma_f32_16x16x32_bf16(a, b, c, 0, 0, 0); }
__device__ __forceinline__ float sigm(float x) { return 1.f / (1.f + expf(-x)); }
__device__ __forceinline__ void unpack8(const u32x4& w, float (&o)[8]) {
  o[0] = __uint_as_float(w.x << 16); o[1] = __uint_as_float(w.x & 0xffff0000u); o[2] = __uint_as_float(w.y << 16); o[3] = __uint_as_float(w.y & 0xffff0000u);
  o[4] = __uint_as_float(w.z << 16); o[5] = __uint_as_float(w.z & 0xffff0000u); o[6] = __uint_as_float(w.w << 16); o[7] = __uint_as_float(w.w & 0xffff0000u);
}
struct Prep8 { float r[8], kp[8], v[8], e[8], a[8], kk[8]; };
__device__ __forceinline__ void prep8(const Tensors& T, size_t m, int t, int h, int c0, Prep8& o, bool need_w) {
  const bf16* rw = T.RW + m * 1792 + h * 64 + c0; const bf16* lo = T.LORA + m * 1536 + h * 64 + c0; const int c = h * 64 + c0;
  float rc[8], kc[8], vc[8], rp[8], kp[8], vp[8], al[8], wl[8];
  unpack8(*(const u32x4*)rw, rc); unpack8(*(const u32x4*)(rw + 512), kc); unpack8(*(const u32x4*)(rw + 1024), vc);
  if (t > 0) { unpack8(*(const u32x4*)(rw - 1792), rp); unpack8(*(const u32x4*)(rw + 512 - 1792), kp); unpack8(*(const u32x4*)(rw + 1024 - 1792), vp); }
  else {
#pragma unroll
    for (int j = 0; j < 8; ++j) { rp[j] = 0.f; kp[j] = 0.f; vp[j] = 0.f; } }
  unpack8(*(const u32x4*)(lo + 512), al);
  if (need_w) unpack8(*(const u32x4*)lo, wl);
#pragma unroll
  for (int j = 0; j < 8; ++j) {
    const float rm = rc[j] + (rp[j] - rc[j]) * T.mu[c + j], km = kc[j] + (kp[j] - kc[j]) * T.mu[512 + c + j], vm = vc[j] + (vp[j] - vc[j]) * T.mu[1024 + c + j];
    const float a = sigm(T.a0[c + j] + al[j]);
    o.r[j] = rm; o.v[j] = vm; o.a[j] = a; o.kk[j] = km * T.k_k[c + j]; o.kp[j] = km * (1.f + (a - 1.f) * T.k_a[c + j]);
    if (need_w) { const float wr = T.w0[c + j] + wl[j]; const float sp = (-wr > 20.f) ? -wr : log1pf(expf(-wr)); o.e[j] = expf(-sp - 0.5f); } else o.e[j] = 0.f;
  }
}

__device__ __forceinline__ void p1_item(const Tensors& T, int bh, int ch, RLAS unsigned char* lds) {
  int tid_ = threadIdx.x; asm volatile("" : "+v"(tid_));
  const int tid = tid_, lane = tid & 63, wid = __builtin_amdgcn_readfirstlane(tid >> 6), col = lane & 15, q = lane >> 4;
  const int b = bh >> 3, h = bh & 7; const size_t item = (size_t)bh * 128 + ch;
  const int MVT = opq(M_VT);
  RLAS float* E = (RLAS float*)(lds + L_E); RLAS float* SEG = (RLAS float*)(lds + L_SEG); RLAS float* PCL = (RLAS float*)(lds + L_PC);
  const int i = tid >> 3, c0 = (tid & 7) * 8; const int t = ch * 64 + i; const size_t m = (size_t)b * 8192 + t;
  Prep8 P; prep8(T, m, t, h, c0, P, true);
  float ss = 0.f;
#pragma unroll
  for (int j = 0; j < 8; ++j) ss += P.kk[j] * P.kk[j];
  ss += __shfl_xor(ss, 1); ss += __shfl_xor(ss, 2); ss += __shfl_xor(ss, 4);
  const float kinv = 1.f / fmaxf(sqrtf(ss), 1e-12f);
#pragma unroll
  for (int j = 0; j < 8; ++j) E[i * 64 + c0 + j] = P.e[j];
  __syncthreads();
  { const int k = tid & 63, sg = tid >> 6; float run = 0.f;
#pragma unroll
    for (int ii = 0; ii < 8; ++ii) { run += E[(sg * 8 + ii) * 64 + k]; E[(sg * 8 + ii) * 64 + k] = run; }
    SEG[sg * 64 + k] = run; }
  __syncthreads();
  {
    float av[8], bv[8], kv[8], rv[8];
#pragma unroll
    for (int j = 0; j < 8; ++j) {
      float off = 0.f;
#pragma unroll
      for (int s = 0; s < 7; ++s) off += (s < (i >> 3)) ? SEG[s * 64 + c0 + j] : 0.f;
      const float cum = E[i * 64 + c0 + j] + off;
      const float pinc = expf(-cum), pexc = expf(-(cum - P.e[j])), pinv = expf(cum);
      const float kk = P.kk[j] * kinv;
      av[j] = -kk * pexc; bv[j] = kk * P.a[j] * pinv; kv[j] = P.kp[j] * pinv; rv[j] = P.r[j] * pinc;
      if (i == 63) { PCL[c0 + j] = pinc; T.PC[item * 64 + c0 + j] = pinc; }
    }
    u32x4 w;
    w.x = cvtpk(av[0], av[1]); w.y = cvtpk(av[2], av[3]); w.z = cvtpk(av[4], av[5]); w.w = cvtpk(av[6], av[7]); *(RLAS u32x4*)(lds + M_AT + (i * LD + c0) * 2) = w;
    w.x = cvtpk(bv[0], bv[1]); w.y = cvtpk(bv[2], bv[3]); w.z = cvtpk(bv[4], bv[5]); w.w = cvtpk(bv[6], bv[7]); *(RLAS u32x4*)(lds + M_BT + (i * LD + c0) * 2) = w;
    w.x = cvtpk(kv[0], kv[1]); w.y = cvtpk(kv[2], kv[3]); w.z = cvtpk(kv[4], kv[5]); w.w = cvtpk(kv[6], kv[7]); *(RLAS u32x4*)(lds + M_KT + (i * LD + c0) * 2) = w;
    w.x = cvtpk(rv[0], rv[1]); w.y = cvtpk(rv[2], rv[3]); w.z = cvtpk(rv[4], rv[5]); w.w = cvtpk(rv[6], rv[7]); *(RLAS u32x4*)(lds + M_RT + (i * LD + c0) * 2) = w;
#pragma unroll
    for (int j = 0; j < 8; ++j) {
      *(RLAS bf16*)(lds + M_ATT + ((c0 + j) * LD + i) * 2) = (bf16)(cvtpk(av[j], 0.f) & 0xffffu);
      *(RLAS bf16*)(lds + M_BTT + ((c0 + j) * LD + i) * 2) = (bf16)(cvtpk(bv[j], 0.f) & 0xffffu);
      *(RLAS bf16*)(lds + M_KTT + ((c0 + j) * LD + i) * 2) = (bf16)(cvtpk(kv[j], 0.f) & 0xffffu);
      *(RLAS bf16*)(lds + MVT + ((c0 + j) * LD + i) * 2) = (bf16)(cvtpk(P.v[j], 0.f) & 0xffffu);
    }
  }
  __syncthreads();
  {
    const int it = wid & 3, src = wid >> 2;
    const RLAS unsigned char* SRC = lds + (src ? M_RT : M_AT) + ((16 * it + col) * LD + 8 * q) * 2;
    const bf16x8 b0 = *(const RLAS bf16x8*)SRC, b1 = *(const RLAS bf16x8*)(SRC + 64);
    const int gi = 16 * it + col;
#pragma unroll
    for (int jt = 0; jt < 4; ++jt)
#pragma unroll
      for (int which = 0; which < 2; ++which) {
        const RLAS unsigned char* AM = lds + (which ? M_KT : M_BT) + ((16 * jt + col) * LD + 8 * q) * 2;
        f32x4 acc = {0.f, 0.f, 0.f, 0.f};
        acc = mfma32(*(const RLAS bf16x8*)AM, b0, acc); acc = mfma32(*(const RLAS bf16x8*)(AM + 64), b1, acc);
#pragma unroll
        for (int r = 0; r < 4; ++r) { const int gj = 16 * jt + 4 * q + r; const bool keep = src ? (gj <= gi) : (gj < gi); acc[r] = keep ? acc[r] : 0.f; }
        const int dst = src ? (which ? A_RK : A_RB) : (which ? A_AK : A_AB);
        *(RLAS bf16x4*)(lds + dst + (gi * LD + 16 * jt + 4 * q) * 2) = pack4(acc);
        if (src == 0 && which == 0 && jt == it) {
#pragma unroll
          for (int r = 0; r < 4; ++r) *(RLAS float*)(lds + L_DIAG + ((it * 16 + col) * 16 + 4 * q + r) * 4) = acc[r];
        }
      }
  }
  __syncthreads();
  if (wid == 0) {
    const int blk = lane >> 4, c = lane & 15; const RLAS float* L = (const RLAS float*)(lds + L_DIAG) + blk * 256;
    float x[16];
#pragma unroll
    for (int ii = 0; ii < 16; ++ii) { float s = (ii == c) ? 1.f : 0.f;
#pragma unroll
      for (int mm = 0; mm < ii; ++mm) s += L[ii * 16 + mm] * x[mm];
      x[ii] = s; }
#pragma unroll
    for (int ii = 0; ii < 16; ++ii) *(RLAS bf16*)(lds + L_TII + ((blk * 16 + ii) * 16 + c) * 2) = (bf16)(cvtpk(x[ii], 0.f) & 0xffffu);
  }
  __syncthreads();
  {
    const bool isU = wid >= 4; const int ct = wid & 3;
    bf16x4 Xb[4];
#pragma unroll
    for (int ib = 0; ib < 4; ++ib) {
      f32x4 tmp;
      if (!isU) { const bf16x4 a4 = *(const RLAS bf16x4*)(lds + M_ATT + ((16 * ct + col) * LD + 16 * ib + 4 * q) * 2);
#pragma unroll
        for (int r = 0; r < 4; ++r) tmp[r] = bf2f((bf16)a4[r]); }
      else { tmp = (f32x4){0.f, 0.f, 0.f, 0.f};
#pragma unroll
        for (int ks = 0; ks < 2; ++ks) tmp = mfma32(*(const RLAS bf16x8*)(lds + A_AK + ((16 * ib + col) * LD + 32 * ks + 8 * q) * 2), *(const RLAS bf16x8*)(lds + MVT + ((16 * ct + col) * LD + 32 * ks + 8 * q) * 2), tmp); }
      const f32x4 zero = {0.f, 0.f, 0.f, 0.f};
      f32x4 t16 = zero;
#pragma unroll
      for (int mb = 0; mb < 4; ++mb) if (mb < ib) t16 = mfma16(*(const RLAS bf16x4*)(lds + A_AB + ((16 * ib + col) * LD + 16 * mb + 4 * q) * 2), Xb[mb], t16);
      tmp = tmp + t16;
      const f32x4 X = mfma16(*(const RLAS bf16x4*)(lds + L_TII + ((ib * 16 + col) * 16 + 4 * q) * 2), pack4(tmp), zero);
      Xb[ib] = pack4(X);
    }
    if (!isU) {
#pragma unroll
      for (int ib = 0; ib < 4; ++ib) { const int gi = 16 * ib + col;
        const bf16x4 r4 = *(const RLAS bf16x4*)(lds + M_RT + (gi * LD + 16 * ct + 4 * q) * 2); f32x4 acc;
#pragma unroll
        for (int r = 0; r < 4; ++r) acc[r] = bf2f((bf16)r4[r]);
#pragma unroll
        for (int mb = 0; mb < 4; ++mb) if (mb <= ib) acc = mfma16(Xb[mb], *(const RLAS bf16x4*)(lds + A_RB + (gi * LD + 16 * mb + 4 * q) * 2), acc);
        *(bf16x4*)(T.RWM + item * 4096 + gi * 64 + 16 * ct + 4 * q) = pack4(acc); }
#pragma unroll
      for (int kb = 0; kb < 4; ++kb) { const int gk = 16 * kb + col; f32x4 acc = {0.f, 0.f, 0.f, 0.f};
#pragma unroll
        for (int mb = 0; mb < 4; ++mb) acc = mfma16(Xb[mb], *(const RLAS bf16x4*)(lds + M_BTT + (gk * LD + 16 * mb + 4 * q) * 2), acc);
        const float pc = PCL[gk];
#pragma unroll
        for (int r = 0; r < 4; ++r) acc[r] *= pc;
        *(bf16x4*)(T.G + item * 4096 + gk * 64 + 16 * ct + 4 * q) = pack4(acc); }
    } else {
#pragma unroll
      for (int ib = 0; ib < 4; ++ib) { const int gi = 16 * ib + col; f32x4 acc = {0.f, 0.f, 0.f, 0.f}, acc2 = {0.f, 0.f, 0.f, 0.f};
#pragma unroll
        for (int mb = 0; mb < 4; ++mb) if (mb <= ib) acc = mfma16(Xb[mb], *(const RLAS bf16x4*)(lds + A_RB + (gi * LD + 16 * mb + 4 * q) * 2), acc);
#pragma unroll
        for (int ks = 0; ks < 2; ++ks) acc2 = mfma32(*(const RLAS bf16x8*)(lds + MVT + ((16 * ct + col) * LD + 32 * ks + 8 * q) * 2), *(const RLAS bf16x8*)(lds + A_RK + (gi * LD + 32 * ks + 8 * q) * 2), acc2);
        acc = acc + acc2;
        *(bf16x4*)(T.Y0 + item * 4096 + gi * 64 + 16 * ct + 4 * q) = pack4(acc); }
#pragma unroll
      for (int kb = 0; kb < 4; ++kb) { f32x4 acc = {0.f, 0.f, 0.f, 0.f}, acc2 = {0.f, 0.f, 0.f, 0.f};
#pragma unroll
        for (int mb = 0; mb < 4; ++mb) acc = mfma16(*(const RLAS bf16x4*)(lds + M_BTT + ((16 * kb + col) * LD + 16 * mb + 4 * q) * 2), Xb[mb], acc);
#pragma unroll
        for (int ks = 0; ks < 2; ++ks) acc2 = mfma32(*(const RLAS bf16x8*)(lds + M_KTT + ((16 * kb + col) * LD + 32 * ks + 8 * q) * 2), *(const RLAS bf16x8*)(lds + MVT + ((16 * ct + col) * LD + 32 * ks + 8 * q) * 2), acc2);
        const f32x4 pc = *(const RLAS f32x4*)(PCL + 16 * kb + 4 * q);
        acc = (acc + acc2) * pc;
        *(bf16x4*)(T.HADD + item * 4096 + (16 * ct + col) * 64 + 16 * kb + 4 * q) = pack4(acc); }
    }
  }
  __syncthreads();
}

__device__ __forceinline__ void scan_head(const Tensors& T, int bh, int wv, int lane) {
  const int col = lane & 15, q = lane >> 4, v = 16 * wv + col;
  f32x4 acc[4];
#pragma unroll
  for (int kb = 0; kb < 4; ++kb) acc[kb] = (f32x4){0.f, 0.f, 0.f, 0.f};
  for (int ch = 0; ch < 128; ++ch) {
    const size_t item = (size_t)bh * 128 + ch;
    const bf16* Gp = T.G + item * 4096; const bf16* Hp = T.HADD + item * 4096 + v * 64; const float* Pp = T.PC + item * 64;
    bf16x4 ga[4][4]; bf16x4 ha[4]; f32x4 pc[4];
#pragma unroll
    for (int kb = 0; kb < 4; ++kb) { ha[kb] = *(const bf16x4*)(Hp + 16 * kb + 4 * q); pc[kb] = *(const f32x4*)(Pp + 16 * kb + 4 * q);
#pragma unroll
      for (int mb = 0; mb < 4; ++mb) ga[kb][mb] = *(const bf16x4*)(Gp + (16 * kb + col) * 64 + 16 * mb + 4 * q); }
    bf16x4 hb[4];
#pragma unroll
    for (int kb = 0; kb < 4; ++kb) { hb[kb] = pack4(acc[kb]); *(bf16x4*)(T.HT + item * 4096 + v * 64 + 16 * kb + 4 * q) = hb[kb]; }
    f32x4 nw[4];
#pragma unroll
    for (int kb = 0; kb < 4; ++kb) {
#pragma unroll
      for (int r = 0; r < 4; ++r) nw[kb][r] = pc[kb][r] * acc[kb][r] + bf2f((bf16)ha[kb][r]);
#pragma unroll
      for (int mb = 0; mb < 4; ++mb) nw[kb] = mfma16(ga[kb][mb], hb[mb], nw[kb]);
    }
#pragma unroll
    for (int kb = 0; kb < 4; ++kb) acc[kb] = nw[kb];
  }
}

__device__ __forceinline__ void p2_item(const Tensors& T, int bh, int ch, int ib, int lane) {
  const int col = lane & 15, q = lane >> 4, b = bh >> 3, h = bh & 7; const size_t item = (size_t)bh * 128 + ch;
  const int i = 16 * ib + col, t = ch * 64 + i; const size_t m = (size_t)b * 8192 + t;
  const bf16* RWp = T.RWM + item * 4096 + i * 64 + 8 * q; const bf16* HTp = T.HT + item * 4096 + col * 64 + 8 * q;
  const bf16x8 rb0 = *(const bf16x8*)RWp, rb1 = *(const bf16x8*)(RWp + 32);
  f32x4 y[4];
#pragma unroll
  for (int vt = 0; vt < 4; ++vt) { const bf16x4 y0 = *(const bf16x4*)(T.Y0 + item * 4096 + i * 64 + 16 * vt + 4 * q);
#pragma unroll
    for (int r = 0; r < 4; ++r) y[vt][r] = bf2f((bf16)y0[r]);
    y[vt] = mfma32(*(const bf16x8*)(HTp + vt * 16 * 64), rb0, y[vt]); y[vt] = mfma32(*(const bf16x8*)(HTp + vt * 16 * 64 + 32), rb1, y[vt]); }
  float bo = 0.f; float vmix[4][4];
  {
    Prep8 P;
#pragma unroll
    for (int hf = 0; hf < 2; ++hf) { prep8(T, m, t, h, 16 * q + 8 * hf, P, false);
#pragma unroll
      for (int j = 0; j < 8; ++j) bo += P.r[j] * P.kp[j] * T.r_k[h * 64 + 16 * q + 8 * hf + j]; }
    bo += __shfl_xor(bo, 16); bo += __shfl_xor(bo, 32);
    const bf16* rw = T.RW + m * 1792 + 1024 + h * 64;
#pragma unroll
    for (int vt = 0; vt < 4; ++vt) { const bf16x4 vc = *(const bf16x4*)(rw + 16 * vt + 4 * q); bf16x4 vp = {0, 0, 0, 0}; if (t > 0) vp = *(const bf16x4*)(rw - 1792 + 16 * vt + 4 * q);
#pragma unroll
      for (int r = 0; r < 4; ++r) { const float c = bf2f((bf16)vc[r]), pv = bf2f((bf16)vp[r]); vmix[vt][r] = c + (pv - c) * T.mu[1024 + h * 64 + 16 * vt + 4 * q + r]; } }
  }
  float s = 0.f;
#pragma unroll
  for (int vt = 0; vt < 4; ++vt) s += (y[vt][0] + y[vt][1]) + (y[vt][2] + y[vt][3]);
  s += __shfl_xor(s, 16); s += __shfl_xor(s, 32);
  const float mean = s * (1.f / 64.f); float qq = 0.f;
#pragma unroll
  for (int vt = 0; vt < 4; ++vt)
#pragma unroll
    for (int r = 0; r < 4; ++r) { const float d = y[vt][r] - mean; qq += d * d; }
  qq += __shfl_xor(qq, 16); qq += __shfl_xor(qq, 32);
  const float rstd = rsqrtf(qq * (1.f / 64.f) + 64e-5f);
#pragma unroll
  for (int vt = 0; vt < 4; ++vt) { const int c = h * 64 + 16 * vt + 4 * q;
    const f32x4 lw = *(const f32x4*)(T.ln_w + c), lb = *(const f32x4*)(T.ln_b + c); const bf16x4 g4 = *(const bf16x4*)(T.LORA + m * 1536 + 1024 + c);
    f32x4 o;
#pragma unroll
    for (int r = 0; r < 4; ++r) o[r] = ((y[vt][r] - mean) * rstd * lw[r] + lb[r] + bo * vmix[vt][r]) * bf2f((bf16)g4[r]);
    *(bf16x4*)(T.MIX + m * 1024 + 512 + c) = pack4(o); }
}
}
namespace {
#define LAS __attribute__((address_space(3)))
typedef unsigned short bf16;
typedef unsigned v4u __attribute__((ext_vector_type(4)));
typedef float f32x4 __attribute__((ext_vector_type(4)));
constexpr int NWAVES = 8, NTHREADS = 512;
constexpr int B_ = 2, T_ = 8192, D_ = 1024, M_ = B_ * T_, DIN = 3096, DFF = 2816, NPROJ = 3328, NLORA = 1536, KLORA = 256, NUPH = 2816;
constexpr size_t MiB = 1u << 20;
constexpr size_t WS_CTL = 0, WS_WIN = 1 * MiB, WS_WOUT = 8 * MiB, WS_WUP = 10 * MiB, WS_WDN = 21 * MiB, WS_LORAW = 27 * MiB, WS_B1P = 28 * MiB;
constexpr size_t WS_XN = 32 * MiB;
constexpr size_t WS_HT = 32 * MiB, WS_PC = 48 * MiB;
constexpr size_t WS_Q = 64 * MiB;
constexpr size_t WS_SLAB = 80 * MiB;
constexpr size_t WS_GATES = 104 * MiB;
constexpr size_t WS_RW = 106 * MiB;
constexpr size_t WS_LORA = 162 * MiB;
constexpr size_t WS_ACT = 210 * MiB;
constexpr size_t WS_CMP = 218 * MiB;
constexpr size_t WS_MIX = 220 * MiB;
constexpr size_t WS_U = 64 * MiB;
constexpr size_t WS_ACT2 = 152 * MiB;
constexpr size_t WS_END = 256 * MiB;
constexpr int LDS_BYTES = 147456;

__device__ __forceinline__ float bf2f(bf16 v) { return __uint_as_float((unsigned)v << 16); }
__device__ __forceinline__ unsigned f2bf(float f) { unsigned u = __float_as_uint(f); return (u + 0x7fffu + ((u >> 16) & 1u)) >> 16; }
__device__ __forceinline__ unsigned pk2(float lo, float hi) { return f2bf(lo) | (f2bf(hi) << 16); }
__device__ __forceinline__ float wsum(float v) {
#pragma unroll
  for (int o = 32; o >= 1; o >>= 1) v += __shfl_xor(v, o);
  return v;
}
__device__ __forceinline__ float wmax(float v) {
#pragma unroll
  for (int o = 32; o >= 1; o >>= 1) v = fmaxf(v, __shfl_xor(v, o));
  return v;
}
__device__ __forceinline__ int t5b(int n) {
  if (n < 16) return n < 0 ? 0 : n;
  if (n >= 128) return 31;
  int v = 16 + (int)(logf((float)n / 16.f) / 2.0794415416798357f * 16.f);
  return v > 31 ? 31 : v;
}
__device__ __forceinline__ float sigm(float x) { return 1.f / (1.f + expf(-x)); }
__device__ __forceinline__ float gelu_tanh(float x) { return 0.5f * x * (1.f + tanhf(0.7978845608028654f * (x + 0.044715f * x * x * x))); }

struct Params {
  const float* in[28]; float* out; unsigned char* ws; int ph_lo, ph_hi;
};

__device__ __forceinline__ void tr_item(const float* W, int ldn, int k0, int nsrc0, int nvalid, bf16* WT, int K, int dstrow0, LAS float* scr, int lane) {
#pragma unroll 8
  for (int i = 0; i < 32; ++i) { const int kk = 2 * i + (lane >> 5), c = lane & 31; scr[kk * 33 + c] = (c < nvalid) ? W[(size_t)(k0 + kk) * ldn + nsrc0 + c] : 0.f; }
  asm volatile("s_waitcnt lgkmcnt(0)" ::: "memory");
  const int c = lane & 7;
#pragma unroll
  for (int j = 0; j < 4; ++j) { const int n = (lane >> 3) + 8 * j; const LAS float* s = scr + (8 * c) * 33 + n;
    v4u o; o.x = pk2(s[0 * 33], s[1 * 33]); o.y = pk2(s[2 * 33], s[3 * 33]); o.z = pk2(s[4 * 33], s[5 * 33]); o.w = pk2(s[6 * 33], s[7 * 33]);
    *(v4u*)(WT + (size_t)(dstrow0 + n) * K + k0 + 8 * c) = o; }
  asm volatile("s_waitcnt lgkmcnt(0)" ::: "memory");
}
__device__ __forceinline__ void proj_src(int c, int& src, int& nv) {
  const int pn = c >> 8, bj = (c >> 7) & 1, wc = (c >> 5) & 3, grp = 4 * pn + wc, dim0 = 32 * bj;
  if (grp < 20) { src = grp * 64 + dim0; nv = 32; } else if (grp == 20) { src = 1280 + dim0; nv = bj == 0 ? 24 : 0; } else if (grp < 49) { src = 1304 + (grp - 21) * 64 + dim0; nv = 32; } else { src = 0; nv = 0; }
}
__device__ __forceinline__ void rms_row_to_bf16(const float* xrow, const float* g, bf16* orow, int lane) {
  const f32x4* xr = (const f32x4*)xrow + lane; const f32x4* gr = (const f32x4*)g + lane;
  f32x4 v[4]; float s = 0.f;
#pragma unroll
  for (int j = 0; j < 4; ++j) { v[j] = xr[64 * j]; s += (v[j].x * v[j].x + v[j].y * v[j].y) + (v[j].z * v[j].z + v[j].w * v[j].w); }
  const float r = rsqrtf(wsum(s) * (1.f / D_) + 1e-6f);
  unsigned long long* o8 = (unsigned long long*)orow + lane;
#pragma unroll
  for (int j = 0; j < 4; ++j) { const f32x4 gg = gr[64 * j]; o8[64 * j] = (unsigned long long)pk2(v[j].x * r * gg.x, v[j].y * r * gg.y) | ((unsigned long long)pk2(v[j].z * r * gg.z, v[j].w * r * gg.w) << 32); }
}

__device__ __forceinline__ void phase_prologue(const Params& p, LAS unsigned char* lds, int wave, int lane) {
  if (blockIdx.x == 0 && threadIdx.x < 64) ((unsigned*)(p.ws + WS_CTL))[threadIdx.x] = 0u;
  LAS float* scr = (LAS float*)(lds + wave * 16384);
  const int gw = blockIdx.x * NWAVES + wave, NGW = gridDim.x * NWAVES;
  const float* w_in = p.in[2]; const float* w_out = p.in[22]; const float* ffn_up = p.in[24]; const float* ffn_down = p.in[27];
  bf16* WIN = (bf16*)(p.ws + WS_WIN); bf16* WOUT = (bf16*)(p.ws + WS_WOUT); bf16* WUP = (bf16*)(p.ws + WS_WUP); bf16* WDN = (bf16*)(p.ws + WS_WDN);
  constexpr int I_IN = 16 * (NPROJ / 32), I_OUT = 16 * 32, I_UP = 16 * (2 * DFF / 32), I_DN = 44 * 32, NITEMS = I_IN + I_OUT + I_UP + I_DN;
  for (int it = gw; it < NITEMS; it += NGW) {
    int r = it;
    if (r < I_IN) { const int nr = NPROJ / 32, kb = r / nr, run = r % nr; int src, nv; proj_src(32 * run, src, nv); tr_item(w_in, DIN, 64 * kb, src, nv, WIN, D_, 32 * run, scr, lane); continue; } r -= I_IN;
    if (r < I_OUT) { const int kb = r / 32, run = r % 32; tr_item(w_out, D_, 64 * kb, 32 * run, 32, WOUT, D_, 32 * run, scr, lane); continue; } r -= I_OUT;
    if (r < I_UP) { const int nr = 2 * DFF / 32, kb = r / nr, run = r % nr; const int c = 32 * run, hh = c / NUPH, w = c % NUPH; const int src = (w < 1408) ? hh * 1408 + w : DFF + hh * 1408 + (w - 1408);
      tr_item(ffn_up, 2 * DFF, 64 * kb, src, 32, WUP, D_, c, scr, lane); continue; } r -= I_UP;
    { const int kb = r / 32, run = r % 32; tr_item(ffn_down, D_, 64 * kb, 32 * run, 32, WDN, DFF, 32 * run, scr, lane); }
  }
  { bf16* LW = (bf16*)(p.ws + WS_LORAW); const float* w2 = p.in[13]; const float* a2 = p.in[15]; const float* g2 = p.in[16];
    for (int i = blockIdx.x * NTHREADS + threadIdx.x; i < NLORA * KLORA; i += gridDim.x * NTHREADS) { const int n = i >> 8, k = i & 255; float v = 0.f;
      if (n < 512) { if (k < 64) v = w2[k * 512 + n]; } else if (n < 1024) { if (k >= 64 && k < 128) v = a2[(k - 64) * 512 + n - 512]; } else { if (k >= 128) v = g2[(k - 128) * 512 + n - 1024]; }
      LW[i] = (bf16)f2bf(v); } }
  { float* b1p = (float*)(p.ws + WS_B1P); const float* pos = p.in[5]; const float* w1 = p.in[6]; const float* b1 = p.in[7];
    for (int o = gw; o < 256; o += NGW) { const int kv = o >> 7, j = o & 127; float s = 0.f;
      for (int k = lane; k < 2048; k += 64) s += pos[kv * 2048 + k] * w1[((size_t)kv * 2048 + k) * 128 + j];
      s = wsum(s); if (lane == 0) b1p[o] = s + b1[o]; } }
  { const float* x = p.in[0]; const float* g = p.in[1]; bf16* XN = (bf16*)(p.ws + WS_XN);
    for (int m = gw; m < M_; m += NGW) rms_row_to_bf16(x + (size_t)m * D_, g, XN + (size_t)m * D_, lane); }
}

__device__ __forceinline__ void phase_mid(const Params& p, LAS unsigned char* lds, int wave, int lane) {
  const int tid = threadIdx.x;
  {
    LAS bf16* blk = (LAS bf16*)lds;
    LAS float* part = (LAS float*)(lds + 36864);
    LAS float* hid = (LAS float*)(lds + 36864 + 32768);
    const float* w1 = p.in[6]; const float* w2 = p.in[8]; const float* b2 = p.in[9]; const float* kg0 = p.in[4]; const float* b1p = (const float*)(p.ws + WS_B1P);
    bf16* CMP = (bf16*)(p.ws + WS_CMP);
    for (int it = blockIdx.x; it < 256; it += gridDim.x) {
      const int kv = it >> 7, slab = (it >> 5) & 3, ct = it & 31, c0 = ct * 16;
      const bf16* src = (const bf16*)(p.ws + WS_SLAB) + ((size_t)kv * 4 + slab) * (8192 * 64) + (size_t)c0 * 16 * 64;
      const int ntok = (c0 * 16 + 272 <= 8192) ? 272 : 8192 - c0 * 16;
      for (int i = tid; i < 272 * 8; i += NTHREADS) { v4u v = {0u, 0u, 0u, 0u}; if ((i >> 3) < ntok) v = *(const v4u*)(src + (size_t)i * 8); *(LAS v4u*)(blk + i * 8) = v; }
      __syncthreads();
      { const int j = tid & 127, kq = tid >> 7; float acc[16];
#pragma unroll
        for (int c = 0; c < 16; ++c) acc[c] = 0.f;
        const float* w = w1 + ((size_t)kv * 2048 + kq * 512) * 128 + j;
        for (int k = 0; k < 512; ++k) { const float wv = w[(size_t)k * 128];
#pragma unroll
          for (int c = 0; c < 16; ++c) acc[c] += bf2f(blk[c * 1024 + kq * 512 + k]) * wv; }
#pragma unroll
        for (int c = 0; c < 16; ++c) part[(kq * 16 + c) * 128 + j] = acc[c]; }
      __syncthreads();
      for (int i = tid; i < 16 * 128; i += NTHREADS) { const int j = i & 127; const float s = b1p[kv * 128 + j] + ((part[i] + part[2048 + i]) + (part[4096 + i] + part[6144 + i])); hid[i] = gelu_tanh(s); }
      __syncthreads();
#pragma unroll
      for (int cc = 0; cc < 2; ++cc) { const int c = wave * 2 + cc; float o = b2[kv * 64 + lane];
        for (int k = 0; k < 128; ++k) o += hid[c * 128 + k] * w2[((size_t)kv * 128 + k) * 64 + lane];
        if (kv == 0) { const float ss = wsum(o * o); o = o * rsqrtf(ss * (1.f / 64.f) + 1e-6f) * kg0[lane]; }
        CMP[(((size_t)kv * 4 + slab) * 512 + c0 + c) * 64 + lane] = (c0 + c < 511) ? (bf16)f2bf(o) : (bf16)0; }
      __syncthreads();
    }
  }
  {
    const bf16* RW = (const bf16*)(p.ws + WS_RW); bf16* ACT = (bf16*)(p.ws + WS_ACT); const float* mu = p.in[11];
    const int gw = blockIdx.x * NWAVES + wave, NGW = gridDim.x * NWAVES;
    for (int m = gw; m < M_; m += NGW) {
      const int t = m & (T_ - 1); const bf16* cur = RW + (size_t)m * 1792 + 1536 + lane * 4; float o[4];
#pragma unroll
      for (int i = 0; i < 4; ++i) { const float c = bf2f(cur[i]); const float pv = t > 0 ? bf2f(cur[i - 1792]) : 0.f; const float v = c + (pv - c) * mu[1536 + lane * 4 + i];
        o[i] = (lane < 16) ? tanhf(v) : (lane < 32) ? v : sigm(v); }
      *(unsigned long long*)(ACT + (size_t)m * 256 + lane * 4) = (unsigned long long)pk2(o[0], o[1]) | ((unsigned long long)pk2(o[2], o[3]) << 32);
    }
  }
}

__device__ __forceinline__ rwkv::Tensors rwkv_tensors(const Params& p) {
  const size_t CB = (size_t)16 * 128 * 4096; bf16* CH = (bf16*)p.out;
  rwkv::Tensors T{(const bf16*)(p.ws + WS_RW), (const bf16*)(p.ws + WS_LORA), p.in[11], p.in[12], p.in[14], p.in[17], p.in[18], p.in[19], p.in[20], p.in[21],
                  CH, CH + CB, CH + 2 * CB, CH + 3 * CB, (bf16*)(p.ws + WS_HT), (float*)(p.ws + WS_PC), (bf16*)(p.ws + WS_MIX)};
  return T;
}
__device__ __forceinline__ void phase_p1(const Params& p, LAS unsigned char* lds) {
  const rwkv::Tensors T = rwkv_tensors(p);
  for (int it = blockIdx.x; it < 16 * 128; it += gridDim.x) rwkv::p1_item(T, it >> 7, it & 127, lds);
}
__device__ __forceinline__ void phase_attn(const Params& p, LAS unsigned char* lds, int wave, int lane) {
  if (blockIdx.x < 16) {
    if (wave < 4) { const rwkv::Tensors T = rwkv_tensors(p); rwkv::scan_head(T, blockIdx.x, wave, lane); }
    __syncthreads();
  }
  const bf16* SL = (const bf16*)(p.ws + WS_SLAB); const size_t SS = (size_t)4 * 8192 * 64;
  nsa::Tensors T{(const bf16*)(p.ws + WS_Q), SL + 2 * SS, SL + 3 * SS, SL + 4 * SS, SL + 5 * SS, (const bf16*)(p.ws + WS_CMP), (const bf16*)(p.ws + WS_CMP) + (size_t)4 * 512 * 64,
                 (const float*)(p.ws + WS_GATES), p.in[10], (bf16*)(p.ws + WS_MIX)};
  unsigned* ctr = (unsigned*)(p.ws + WS_CTL);
  LAS unsigned* nxt = (LAS unsigned*)(lds + nsa::L_BYTES);
  for (;;) {
    if (threadIdx.x == 0) *nxt = atomicAdd(ctr, 1u);
    __syncthreads();
    const unsigned i = (unsigned)__builtin_amdgcn_readfirstlane((int)*nxt);
    __syncthreads();
    if (i >= 512u) break;
    nsa::unit(T, (int)(i & 1u), (int)((i >> 1) & 1u), 127 - (int)(i >> 2), lds);
  }
}
__device__ __forceinline__ void phase_p2(const Params& p, int wave, int lane) {
  const rwkv::Tensors T = rwkv_tensors(p);
  const int gw = blockIdx.x * NWAVES + wave, NGW = gridDim.x * NWAVES;
  for (int w = gw; w < 16 * 128 * 4; w += NGW) rwkv::p2_item(T, w >> 9, (w >> 2) & 127, w & 3, lane);
}

__device__ __forceinline__ void phase_rms2(const Params& p, int wave, int lane) {
  const int gw = blockIdx.x * NWAVES + wave, NGW = gridDim.x * NWAVES; bf16* XN = (bf16*)(p.ws + WS_XN);
  for (int m = gw; m < M_; m += NGW) rms_row_to_bf16(p.out + (size_t)m * D_, p.in[23], XN + (size_t)m * D_, lane);
}
__device__ __forceinline__ void phase_convgate(const Params& p, int hh) {
  const bf16* U = (const bf16*)(p.ws + WS_U); bf16* ACT2 = (bf16*)(p.ws + WS_ACT2); const float* cw = p.in[25]; const float* cb = p.in[26];
  const long total = (long)M_ * 176;
  for (long it = (long)blockIdx.x * NTHREADS + threadIdx.x; it < total; it += (long)gridDim.x * NTHREADS) {
    const int m = (int)(it / 176), i0 = (int)(it % 176) * 8, t = m & (T_ - 1), j0 = hh * 1408 + i0;
    float uv[8], ug[8];
#pragma unroll
    for (int i = 0; i < 8; ++i) { uv[i] = cb[j0 + i]; ug[i] = cb[DFF + j0 + i]; }
#pragma unroll
    for (int k = 0; k < 3; ++k) { if (t - 2 + k < 0) continue;
      const bf16* ur = U + (size_t)(m - 2 + k) * NUPH + i0; const v4u a = *(const v4u*)ur, g = *(const v4u*)(ur + 1408);
      const unsigned aw[4] = {a.x, a.y, a.z, a.w}, gw[4] = {g.x, g.y, g.z, g.w};
#pragma unroll
      for (int i = 0; i < 8; ++i) { const float av = __uint_as_float((i & 1) ? (aw[i >> 1] & 0xffff0000u) : (aw[i >> 1] << 16)); const float gv = __uint_as_float((i & 1) ? (gw[i >> 1] & 0xffff0000u) : (gw[i >> 1] << 16));
        uv[i] += av * cw[k * 2 * DFF + j0 + i]; ug[i] += gv * cw[k * 2 * DFF + DFF + j0 + i]; } }
    v4u o; float r[8];
#pragma unroll
    for (int i = 0; i < 8; ++i) r[i] = ug[i] * sigm(ug[i]) * uv[i];
    o.x = pk2(r[0], r[1]); o.y = pk2(r[2], r[3]); o.z = pk2(r[4], r[5]); o.w = pk2(r[6], r[7]);
    *(v4u*)(ACT2 + (size_t)m * DFF + j0) = o;
  }
}

constexpr int NPHASE = 14;
__global__ void __launch_bounds__(NTHREADS, 2) mk_fwd(Params p) {
  extern __shared__ __attribute__((aligned(16))) unsigned char lds_raw[];
  LAS unsigned char* lds = (LAS unsigned char*)lds_raw;
  const int tid = threadIdx.x, lane = tid & 63, wave = __builtin_amdgcn_readfirstlane(tid >> 6);
  cg::grid_group grid = cg::this_grid();
  const int lo = p.ph_lo, hi = p.ph_hi;
#define IN(k) (lo <= (k) && (k) < hi)
#define SEAM(k) do { if (IN(k) && IN((k) + 1)) grid.sync(); } while (0)
  unsigned char* ws = p.ws;
  if (IN(0)) { phase_prologue(p, lds, wave, lane); } SEAM(0);
  if (IN(1)) { pg8::Gemm g{(const pg8::bf16_t*)(ws + WS_XN), (const pg8::bf16_t*)(ws + WS_WIN), M_, NPROJ, D_}; pg8::StaticOrder S; S.init(M_, NPROJ, gridDim.x, blockIdx.x);
    pg8::EpiProj E{(pg8::bf16_t*)(ws + WS_Q), (pg8::bf16_t*)(ws + WS_SLAB), (pg8::bf16_t*)(ws + WS_RW), (float*)(ws + WS_GATES), p.in[3], p.in[4]};
    pg8::gemm_phase<pg8::EpiProj, pg8::StaticOrder, true, true>(lds, g, S, E); } SEAM(1);
  if (IN(2)) { phase_mid(p, lds, wave, lane); } SEAM(2);
  if (IN(3)) { pg8::Gemm g{(const pg8::bf16_t*)(ws + WS_ACT), (const pg8::bf16_t*)(ws + WS_LORAW), M_, NLORA, KLORA}; pg8::StaticOrder S; S.init(M_, NLORA, gridDim.x, blockIdx.x);
    pg8::EpiBf16<0> E{(pg8::bf16_t*)(ws + WS_LORA), NLORA, nullptr, 0, 0, 1.f};
    pg8::gemm_phase<pg8::EpiBf16<0>, pg8::StaticOrder, true, true>(lds, g, S, E); } SEAM(3);
  if (IN(4)) { phase_p1(p, lds); } SEAM(4);
  if (IN(5)) { phase_attn(p, lds, wave, lane); } SEAM(5);
  if (IN(6)) { phase_p2(p, wave, lane); } SEAM(6);
  if (IN(7)) { pg8::Gemm g{(const pg8::bf16_t*)(ws + WS_MIX), (const pg8::bf16_t*)(ws + WS_WOUT), M_, D_, D_}; pg8::StaticOrder S; S.init(M_, D_, gridDim.x, blockIdx.x);
    pg8::EpiResF32 E{p.in[0], p.out, D_};
    pg8::gemm_phase<pg8::EpiResF32, pg8::StaticOrder, true, true>(lds, g, S, E); } SEAM(7);
  if (IN(8)) { phase_rms2(p, wave, lane); } SEAM(8);
#pragma unroll 1
  for (int hh = 0; hh < 2; ++hh) {
    if (IN(9 + 2 * hh)) { pg8::Gemm g{(const pg8::bf16_t*)(ws + WS_XN), (const pg8::bf16_t*)(ws + WS_WUP) + (size_t)hh * NUPH * D_, M_, NUPH, D_}; pg8::StaticOrder S; S.init(M_, NUPH, gridDim.x, blockIdx.x);
      pg8::EpiBf16<0> E{(pg8::bf16_t*)(ws + WS_U), NUPH, nullptr, 0, 0, 1.f};
      pg8::gemm_phase<pg8::EpiBf16<0>, pg8::StaticOrder, true, true>(lds, g, S, E); } SEAM(9 + 2 * hh);
    if (IN(10 + 2 * hh)) { phase_convgate(p, hh); } SEAM(10 + 2 * hh);
  }
  if (IN(13)) { pg8::Gemm g{(const pg8::bf16_t*)(ws + WS_ACT2), (const pg8::bf16_t*)(ws + WS_WDN), M_, D_, DFF}; pg8::StaticOrder S; S.init(M_, D_, gridDim.x, blockIdx.x);
    pg8::EpiResF32 E{p.out, p.out, D_};
    pg8::gemm_phase<pg8::EpiResF32, pg8::StaticOrder, true, true>(lds, g, S, E); }
#undef IN
#undef SEAM
}
}

#ifndef MK_N_LAUNCHES
#define MK_N_LAUNCHES 1
#endif
extern "C" void kernel_launch(void* const* d_in, const int* in_sizes, int n_in, void* d_out, int out_size, void* d_ws, size_t ws_size, hipStream_t stream) {
  static int grid = 0;
  if (grid == 0) {
    if (n_in != 28 || out_size != M_ * D_ || ws_size < WS_END) { fprintf(stderr, "kernel_launch: unexpected shapes (n_in %d out %d ws %zu)\n", n_in, out_size, ws_size); grid = -1; return; }
    int dev = 0, cus = 0, per_cu = 0; hipGetDevice(&dev); hipDeviceGetAttribute(&cus, hipDeviceAttributeMultiprocessorCount, dev);
    if (hipFuncSetAttribute((const void*)mk_fwd, hipFuncAttributeMaxDynamicSharedMemorySize, LDS_BYTES) != hipSuccess) { fprintf(stderr, "kernel_launch: hipFuncSetAttribute failed\n"); grid = -1; return; }
    if (hipOccupancyMaxActiveBlocksPerMultiprocessor(&per_cu, (const void*)mk_fwd, NTHREADS, LDS_BYTES) != hipSuccess || per_cu < 1) { fprintf(stderr, "kernel_launch: occupancy query says %d\n", per_cu); (void)hipGetLastError(); per_cu = 1; }
    grid = cus;
    fprintf(stderr, "kernel_launch: cus %d per_cu %d grid %d\n", cus, per_cu, grid);
  }
  if (grid < 0) return;
  Params p{};
  for (int i = 0; i < 28; ++i) p.in[i] = (const float*)d_in[i];
  p.out = (float*)d_out; p.ws = (unsigned char*)d_ws;
  for (int li = 0; li < MK_N_LAUNCHES; ++li) {
    p.ph_lo = (MK_N_LAUNCHES == 1) ? 0 : li; p.ph_hi = (MK_N_LAUNCHES == 1) ? NPHASE : li + 1;
    void* args[] = {&p};
    hipError_t e = hipLaunchCooperativeKernel((const void*)mk_fwd, dim3(grid), dim3(NTHREADS), args, LDS_BYTES, stream);
    if (e != hipSuccess) { fprintf(stderr, "kernel_launch: cooperative launch %d failed: %s\n", li, hipGetErrorString(e)); break; }
  }
}
```

```cpp
#include <hip/hip_runtime.h>
#include <hip/hip_cooperative_groups.h>
#include <cstdio>
#include <cstdint>
namespace cg = cooperative_groups;
namespace pg8 {
#define PG8_LAS __attribute__((address_space(3)))
typedef unsigned short bf16_t;
typedef short bf16x8 __attribute__((ext_vector_type(8)));
typedef float f32x4 __attribute__((ext_vector_type(4)));
typedef unsigned u32x4 __attribute__((ext_vector_type(4)));
constexpr int BM = 256, BK = 64, HALF = 128, HTB = HALF * BK * 2  , STAGE_BYTES = 8 * HTB, NXCD = 8, WGM = 8;

__host__ __device__ __forceinline__ int lds_byte(int r, int c) { const int st = (r >> 4) * 2 + (c >> 5), rr = r & 15, cc = c & 31, ob = rr * 64 + cc * 2; return st * 1024 + (ob ^ (((ob >> 9) & 1) << 5)); }
__host__ __device__ __forceinline__ void stage_rc(int b, int& R, int& C) { const int st = b / 1024, sb = b % 1024, swz = sb ^ (((sb >> 9) & 1) << 5); R = (st >> 1) * 16 + swz / 64; C = (st & 1) * 32 + (swz % 64) / 2; }
__host__ __device__ __forceinline__ int perm32(int rho) { const int n = rho >> 4, i = rho & 15; return 8 * (i >> 2) + 4 * n + (i & 3); }

struct Unit { int pm, pn; };
struct Gemm { const bf16_t* A; const bf16_t* Bt; int M, N, K; };

struct StaticOrder {
    int nM, nN, nwg, G, c;
    __host__ __device__ void init(int M, int N, int G_, int c_) { nM = M / BM; nN = N / BM; nwg = nM * nN; G = G_; c = c_; }
    __host__ __device__ bool next(int i, Unit& u) const {
        const long L = (long)i * G + c; if (L >= nwg) return false;
        int wgid = (int)L; { const int q = nwg / NXCD, r = nwg % NXCD, xcd = wgid % NXCD, off = wgid / NXCD; wgid = (xcd < r ? xcd * (q + 1) : r * (q + 1) + (xcd - r) * q) + off; }
        const int nig = WGM * nN, gid = wgid / nig, fm = gid * WGM, gsz = (nM - fm) < WGM ? (nM - fm) : WGM;
        u.pm = fm + ((wgid % nig) % gsz); u.pn = (wgid % nig) / gsz; return true;
    }
    __device__ __forceinline__ void a_ready(const Unit&) const {}
    __device__ __forceinline__ void done(const Unit&) const {}
};

__device__ __forceinline__ unsigned cvt_pk_bf16(float lo, float hi) { unsigned r; asm volatile("v_cvt_pk_bf16_f32 %0, %1, %2" : "=v"(r) : "v"(lo), "v"(hi)); return r; }
typedef float f32x2 __attribute__((ext_vector_type(2)));
__device__ __forceinline__ f32x2 gelu_pk(f32x2 v) {
    const f32x2 av = __builtin_elementwise_abs(v), d = av * 0.2316418882f + 1.0f;
    f32x2 t; t.x = __builtin_amdgcn_rcpf(d.x); t.y = __builtin_amdgcn_rcpf(d.y);
    f32x2 q = t * 0.5307027145f + (-0.7265760135f); q = q * t + 0.7107068705f; q = q * t + (-0.142248368f); q = q * t + 0.127414796f; q = q * t;
    const f32x2 s = (v * v) * (-0.72134752044f);
    f32x2 e; e.x = __builtin_amdgcn_exp2f(s.x); e.y = __builtin_amdgcn_exp2f(s.y);
    const f32x2 m = v * (q * e), r = v - m;
    f32x2 o; o.x = v.x < 0.f ? m.x : r.x; o.y = v.y < 0.f ? m.y : r.y; return o;
}

template <int ACT  > struct EpiBf16 {
    static constexpr bool PERM = true, AFTER_DRAIN = false; static_assert(ACT == 0 || ACT == 1, "EpiBf16: ACT is 0 (none) or 1 (gelu_pk)");
    bf16_t* O; int ldc; const float* bias; int split_cols; size_t split_stride; float scale0;
    __device__ __forceinline__ void operator()(const f32x4 (&acc)[2][2][4][2], const Unit& u, int wr, int wc, int fr, int fq) const {
        const int row0 = u.pm * BM + wr * 64 + fr; int colt = u.pn * BM; bf16_t* base = O;
        float sc = 1.f; if (split_cols) { const int t = colt / split_cols; base += (size_t)t * split_stride; colt -= t * split_cols; if (t == 0) sc = scale0; }
        const int col0 = colt + wc * 32 + 8 * fq, bcol0 = u.pn * BM + wc * 32 + 8 * fq;
        f32x4 bv[2][2];
#pragma unroll
        for (int bj = 0; bj < 2; ++bj)
#pragma unroll
            for (int n = 0; n < 2; ++n) bv[bj][n] = bias ? *(const f32x4*)(bias + bcol0 + bj * HALF + 4 * n) : (f32x4){0.f, 0.f, 0.f, 0.f};
#pragma unroll
        for (int ai = 0; ai < 2; ++ai)
#pragma unroll
            for (int m = 0; m < 4; ++m) { bf16_t* rowp = base + (size_t)(row0 + ai * HALF + m * 16) * ldc + col0;
#pragma unroll
                for (int bj = 0; bj < 2; ++bj) { f32x4 v0 = acc[ai][bj][m][0] + bv[bj][0], v1 = acc[ai][bj][m][1] + bv[bj][1];
                    if (ACT == 1) { f32x2 a = gelu_pk((f32x2){v0[0], v0[1]}), b = gelu_pk((f32x2){v0[2], v0[3]}), c = gelu_pk((f32x2){v1[0], v1[1]}), d = gelu_pk((f32x2){v1[2], v1[3]});
                        v0 = (f32x4){a.x, a.y, b.x, b.y}; v1 = (f32x4){c.x, c.y, d.x, d.y}; }
                    v0 = v0 * sc; v1 = v1 * sc; u32x4 w; w.x = cvt_pk_bf16(v0[0], v0[1]); w.y = cvt_pk_bf16(v0[2], v0[3]); w.z = cvt_pk_bf16(v1[0], v1[1]); w.w = cvt_pk_bf16(v1[2], v1[3]);
                    *(u32x4*)(rowp + bj * HALF) = w; } }
    }
};
struct EpiResF32 {
    static constexpr bool PERM = false, AFTER_DRAIN = false;
    const float* base; float* out; int ldc;
    __device__ __forceinline__ void operator()(const f32x4 (&acc)[2][2][4][2], const Unit& u, int wr, int wc, int fr, int fq) const {
        const int row0 = u.pm * BM + wr * 64 + fr, col0 = u.pn * BM + wc * 32 + 4 * fq;
#pragma unroll
        for (int ai = 0; ai < 2; ++ai)
#pragma unroll
            for (int m = 0; m < 4; ++m) { const size_t off = (size_t)(row0 + ai * HALF + m * 16) * ldc + col0;
#pragma unroll
                for (int bj = 0; bj < 2; ++bj)
#pragma unroll
                    for (int n = 0; n < 2; ++n) { const f32x4 b = *(const f32x4*)(base + off + bj * HALF + n * 16); *(f32x4*)(out + off + bj * HALF + n * 16) = b + acc[ai][bj][m][n]; } }
    }
};
struct EpiProj {
    static constexpr bool PERM = true, AFTER_DRAIN = false; static constexpr float QS = 0.125f * 1.4426950408889634f;
    bf16_t* Q; bf16_t* SLAB;   bf16_t* RW; float* GATES; const float* qg; const float* kg;
    __device__ __forceinline__ void operator()(const f32x4 (&acc)[2][2][4][2], const Unit& u, int wr, int wc, int fr, int fq) const {
        const int grp = 4 * u.pn + wc;
        if (grp >= 49) return;
        const int row0 = u.pm * BM + wr * 64 + fr, d0 = 8 * fq;
        int kind; const float* g = nullptr;
        if (grp < 8) { kind = 1; g = qg; } else if (grp < 20) { const int which = (grp - 8) >> 1; kind = (which == 2 || which == 4) ? 1 : 0; g = kg + (which == 2 ? 64 : 128); } else if (grp == 20) kind = 2; else kind = 0;
        float gv[16];
        if (kind == 1) {
#pragma unroll
            for (int i = 0; i < 8; ++i) { gv[i] = g[d0 + i]; gv[8 + i] = g[32 + d0 + i]; }
        }
#pragma unroll
        for (int ai = 0; ai < 2; ++ai)
#pragma unroll
            for (int m = 0; m < 4; ++m) {
                const int row = row0 + ai * HALF + m * 16;
                f32x4 v0 = acc[ai][0][m][0], v1 = acc[ai][0][m][1], v2 = acc[ai][1][m][0], v3 = acc[ai][1][m][1];
                if (kind == 2) {
                    if (fq < 3) { float* gp = GATES + (size_t)row * 32 + d0;
                        f32x4 a, b;
#pragma unroll
                        for (int i = 0; i < 4; ++i) { a[i] = 1.f / (1.f + __expf(-v0[i])); b[i] = 1.f / (1.f + __expf(-v1[i])); }
                        *(f32x4*)gp = a; *(f32x4*)(gp + 4) = b; }
                    continue;
                }
                if (kind == 1) {
                    float ss = 0.f;
#pragma unroll
                    for (int i = 0; i < 4; ++i) ss += v0[i] * v0[i] + v1[i] * v1[i] + v2[i] * v2[i] + v3[i] * v3[i];
                    ss += __shfl_xor(ss, 16); ss += __shfl_xor(ss, 32);
                    const float s = rsqrtf(ss * (1.f / 64.f) + 1e-6f);
#pragma unroll
                    for (int i = 0; i < 4; ++i) { v0[i] *= s * gv[i]; v1[i] *= s * gv[4 + i]; v2[i] *= s * gv[8 + i]; v3[i] *= s * gv[12 + i]; }
                    if (grp < 8) { v0 = v0 * QS; v1 = v1 * QS; v2 = v2 * QS; v3 = v3 * QS; }
                }
                bf16_t* p;
                if (grp < 8) p = Q + (size_t)row * 512 + grp * 64;
                else if (grp < 20) { const int sl = grp - 8; p = SLAB + ((size_t)(sl >> 1) * 4 + (size_t)((row >> 13) * 2 + (sl & 1))) * (8192 * 64) + (size_t)(row & 8191) * 64; }
                else p = RW + (size_t)row * 1792 + (grp - 21) * 64;
                u32x4 w0, w1; w0.x = cvt_pk_bf16(v0[0], v0[1]); w0.y = cvt_pk_bf16(v0[2], v0[3]); w0.z = cvt_pk_bf16(v1[0], v1[1]); w0.w = cvt_pk_bf16(v1[2], v1[3]);
                w1.x = cvt_pk_bf16(v2[0], v2[1]); w1.y = cvt_pk_bf16(v2[2], v2[3]); w1.z = cvt_pk_bf16(v3[0], v3[1]); w1.w = cvt_pk_bf16(v3[2], v3[3]);
                *(u32x4*)(p + d0) = w0; *(u32x4*)(p + 32 + d0) = w1;
            }
    }
};
template <class Epi, class Sched, bool ALIGN_EPI = false, bool SP2 = false>
__device__ __forceinline__ void gemm_phase(PG8_LAS unsigned char* lds, const Gemm g, const Sched& S, const Epi& E) {
    const int tid = threadIdx.x, wid = __builtin_amdgcn_readfirstlane(tid >> 6), lane = tid & 63, wr = wid >> 2, wc = wid & 3, fr = lane & 15, fq = lane >> 4;
    const int K = g.K, nt = K / BK;
    unsigned voffA[2], voffB[2];
#pragma unroll
    for (int i = 0; i < 2; ++i) { int R, C; stage_rc(tid * 16 + i * 8192, R, C); const int Rb = Epi::PERM ? ((R & ~31) + perm32(R & 31)) : R;
        voffA[i] = (unsigned)(R * K + C) * 2u; voffB[i] = (unsigned)(Rb * K + C) * 2u; }
    const size_t kstep = (size_t)(BK * 2);
    const size_t hstep = (size_t)HALF * K * 2;
    const size_t tstep = 2 * hstep;
    const unsigned ldsw = (unsigned)wid * 1024u;
    const int aoff = lds_byte(wr * 64 + fr, fq * 8), boff = lds_byte(wc * 32 + fr, fq * 8);
#define PG8_SA(b, h) (((b) * 2 + (h)) * HTB)
#define PG8_SB(b, h) ((4 + (b) * 2 + (h)) * HTB)
#define PG8_STAGE(bufoff, gbase, voff) do { _Pragma("unroll") for (int _i = 0; _i < 2; ++_i) \
        __builtin_amdgcn_global_load_lds((const unsigned*)((const char*)(gbase) + (voff)[_i]), (PG8_LAS unsigned*)(lds + (bufoff) + ldsw + _i * 8192), 16, 0, 0); } while (0)
#define PG8_LDA(dst, b, h) do { _Pragma("unroll") for (int m = 0; m < 4; ++m) _Pragma("unroll") for (int k = 0; k < 2; ++k) dst[m][k] = *(const PG8_LAS bf16x8*)(lds + PG8_SA(b, h) + aoff + m * 2048 + k * 1024); } while (0)
#define PG8_LDB(dst, b, h) do { _Pragma("unroll") for (int n = 0; n < 2; ++n) _Pragma("unroll") for (int k = 0; k < 2; ++k) dst[n][k] = *(const PG8_LAS bf16x8*)(lds + PG8_SB(b, h) + boff + n * 2048 + k * 1024); } while (0)
#define PG8_MMA(ai, bj, At, Bt) do { __builtin_amdgcn_s_setprio(1); _Pragma("unroll") for (int m = 0; m < 4; ++m) _Pragma("unroll") for (int n = 0; n < 2; ++n) _Pragma("unroll") for (int k = 0; k < 2; ++k) \
        acc[ai][bj][m][n] = __builtin_amdgcn_mfma_f32_16x16x32_bf16(Bt[n][k], At[m][k], acc[ai][bj][m][n], 0, 0, 0); __builtin_amdgcn_s_setprio(0); } while (0)
#define PG8_WAIT_V(n) asm volatile("s_waitcnt vmcnt(" #n ")" ::: "memory")
#define PG8_WAIT_L(n) asm volatile("s_waitcnt lgkmcnt(" #n ")" ::: "memory")
#define PG8_BAR __builtin_amdgcn_s_barrier()
#define PG8_SCHED __builtin_amdgcn_sched_barrier(0)
    Unit cur, nxt; int ui = 0;
    if (!S.next(0, cur)) return;
    f32x4 acc[2][2][4][2];
#pragma unroll
    for (int a = 0; a < 2; ++a)
#pragma unroll
        for (int b = 0; b < 2; ++b)
#pragma unroll
            for (int m = 0; m < 4; ++m)
#pragma unroll
                for (int n = 0; n < 2; ++n) acc[a][b][m][n] = (f32x4){0.f, 0.f, 0.f, 0.f};
    bf16x8 At[4][2], B0[2][2], B1[2][2];
    const char* cA = (const char*)g.A + (size_t)cur.pm * tstep; const char* cB = (const char*)g.Bt + (size_t)cur.pn * tstep;
    S.a_ready(cur);
    if constexpr (SP2) {
        PG8_STAGE(PG8_SB(0, 0), cB, voffB); PG8_STAGE(PG8_SB(0, 1), cB + hstep, voffB); PG8_STAGE(PG8_SA(0, 0), cA, voffA); PG8_STAGE(PG8_SA(0, 1), cA + hstep, voffA);
        if (wr == 1) PG8_BAR;
        PG8_WAIT_V(2); PG8_BAR;
        PG8_STAGE(PG8_SB(1, 0), cB + kstep, voffB); PG8_STAGE(PG8_SA(1, 0), cA + kstep, voffA); PG8_STAGE(PG8_SB(1, 1), cB + hstep + kstep, voffB);
        PG8_WAIT_V(6); PG8_BAR;
    } else {
        PG8_STAGE(PG8_SB(0, 0), cB, voffB); PG8_STAGE(PG8_SA(0, 0), cA, voffA); PG8_STAGE(PG8_SB(0, 1), cB + hstep, voffB); PG8_STAGE(PG8_SA(0, 1), cA + hstep, voffA);
        if (wr == 1) PG8_BAR;
        PG8_WAIT_V(4); PG8_BAR;
        PG8_STAGE(PG8_SB(1, 0), cB + kstep, voffB); PG8_STAGE(PG8_SA(1, 0), cA + kstep, voffA); PG8_STAGE(PG8_SB(1, 1), cB + hstep + kstep, voffB);
        PG8_WAIT_V(6); PG8_BAR;
    }
    for (;;) {
        const bool has_next = S.next(ui + 1, nxt);
        const char* nA = has_next ? (const char*)g.A + (size_t)nxt.pm * tstep : cA; const char* nB = has_next ? (const char*)g.Bt + (size_t)nxt.pn * tstep : cB;
        for (int t = 0; t < nt; t += 2) {
            const bool last = (t == nt - 2);
            const char* a1 = cA + (size_t)(t + 1) * kstep;
            const char* a2 = last ? nA : cA + (size_t)(t + 2) * kstep; const char* b2 = last ? nB : cB + (size_t)(t + 2) * kstep;
            const char* a3 = a2 + kstep; const char* b3 = b2 + kstep;
            if (last && has_next) S.a_ready(nxt);
            if constexpr (SP2) {
            PG8_LDB(B0, 0, 0); PG8_LDB(B1, 0, 1); PG8_SCHED; PG8_LDA(At, 0, 0); PG8_STAGE(PG8_SA(1, 1), a1 + hstep, voffA);
            PG8_WAIT_V(8); PG8_WAIT_L(0); PG8_BAR; PG8_MMA(0, 0, At, B0); PG8_MMA(0, 1, At, B1); PG8_BAR; PG8_SCHED;
            PG8_LDA(At, 0, 1); PG8_STAGE(PG8_SB(0, 0), b2, voffB); PG8_STAGE(PG8_SB(0, 1), b2 + hstep, voffB); PG8_STAGE(PG8_SA(0, 0), a2, voffA);
            PG8_WAIT_V(8); PG8_WAIT_L(0); PG8_BAR; PG8_MMA(1, 0, At, B0); PG8_MMA(1, 1, At, B1); PG8_BAR; PG8_SCHED;
            PG8_LDB(B0, 1, 0); PG8_LDB(B1, 1, 1); PG8_SCHED; PG8_LDA(At, 1, 0); PG8_STAGE(PG8_SA(0, 1), a2 + hstep, voffA);
            PG8_WAIT_V(8); PG8_WAIT_L(0); PG8_BAR; PG8_MMA(0, 0, At, B0); PG8_MMA(0, 1, At, B1); PG8_BAR; PG8_SCHED;
            PG8_LDA(At, 1, 1); PG8_STAGE(PG8_SB(1, 0), b3, voffB); PG8_STAGE(PG8_SB(1, 1), b3 + hstep, voffB); PG8_STAGE(PG8_SA(1, 0), a3, voffA);
            PG8_WAIT_V(8); PG8_WAIT_L(0); PG8_BAR; PG8_MMA(1, 0, At, B0); PG8_MMA(1, 1, At, B1); PG8_BAR; PG8_SCHED;
            } else {
            PG8_LDB(B0, 0, 0); PG8_SCHED; PG8_LDA(At, 0, 0); PG8_STAGE(PG8_SA(1, 1), a1 + hstep, voffA);
            PG8_WAIT_L(8); PG8_BAR; PG8_WAIT_L(0); PG8_MMA(0, 0, At, B0); PG8_BAR; PG8_SCHED;
            PG8_LDB(B1, 0, 1); PG8_STAGE(PG8_SB(0, 0), b2, voffB);
            PG8_BAR; PG8_WAIT_L(0); PG8_MMA(0, 1, At, B1); PG8_BAR;
            PG8_LDA(At, 0, 1); PG8_STAGE(PG8_SA(0, 0), a2, voffA);
            PG8_BAR; PG8_WAIT_L(0); PG8_MMA(1, 0, At, B0); PG8_BAR; PG8_SCHED;
            PG8_STAGE(PG8_SB(0, 1), b2 + hstep, voffB);
            PG8_WAIT_V(6); PG8_BAR; PG8_MMA(1, 1, At, B1); PG8_BAR;
            PG8_LDB(B0, 1, 0); PG8_SCHED; PG8_LDA(At, 1, 0); PG8_STAGE(PG8_SA(0, 1), a2 + hstep, voffA);
            PG8_WAIT_L(8); PG8_BAR; PG8_WAIT_L(0); PG8_MMA(0, 0, At, B0); PG8_BAR; PG8_SCHED;
            PG8_LDB(B1, 1, 1); PG8_STAGE(PG8_SB(1, 0), b3, voffB);
            PG8_BAR; PG8_WAIT_L(0); PG8_MMA(0, 1, At, B1); PG8_BAR;
            PG8_LDA(At, 1, 1); PG8_STAGE(PG8_SA(1, 0), a3, voffA);
            PG8_BAR; PG8_WAIT_L(0); PG8_MMA(1, 0, At, B0); PG8_BAR; PG8_SCHED;
            PG8_STAGE(PG8_SB(1, 1), b3 + hstep, voffB);
            PG8_WAIT_V(6); PG8_BAR; PG8_MMA(1, 1, At, B1); PG8_BAR;
            }
        }
        if constexpr (ALIGN_EPI) { if (wr == 0) PG8_BAR; }
        if constexpr (!Epi::AFTER_DRAIN) { E(acc, cur, wr, wc, fr, fq); S.done(cur); }
        if (!has_next) break;
#pragma unroll
        for (int a = 0; a < 2; ++a)
#pragma unroll
            for (int b = 0; b < 2; ++b)
#pragma unroll
                for (int m = 0; m < 4; ++m)
#pragma unroll
                    for (int n = 0; n < 2; ++n) acc[a][b][m][n] = (f32x4){0.f, 0.f, 0.f, 0.f};
        cur = nxt; cA = nA; cB = nB; ++ui;
        if constexpr (ALIGN_EPI) { if (wr == 1) PG8_BAR; }
    }
    PG8_WAIT_V(0);
    if constexpr (!ALIGN_EPI) { if (wr == 0) PG8_BAR; }
    PG8_BAR;
    if constexpr (Epi::AFTER_DRAIN) { E.fused(acc, cur, wr, wc, fr, fq, lds, wid, lane); S.done(cur); }
#undef PG8_SA
#undef PG8_SB
#undef PG8_STAGE
#undef PG8_LDA
#undef PG8_LDB
#undef PG8_MMA
#undef PG8_WAIT_V
#undef PG8_WAIT_L
#undef PG8_BAR
#undef PG8_SCHED
}
}

namespace nsa {
#define NLAS __attribute__((address_space(3)))
typedef short bf16x8 __attribute__((ext_vector_type(8)));
typedef short s16x4 __attribute__((ext_vector_type(4)));
typedef float f32x16 __attribute__((ext_vector_type(16)));
typedef unsigned u32x4 __attribute__((ext_vector_type(4)));
typedef short v4i16_t __attribute__((ext_vector_type(4)));
typedef unsigned short bf16;
typedef float f32x2_t __attribute__((ext_vector_type(2))); typedef __bf16 bf16x2_t __attribute__((ext_vector_type(2)));

constexpr float LOG2E = 1.4426950408889634f;
constexpr float QSCALE = 0.125f * LOG2E;
constexpr float NEGBIG = -1e30f;
constexpr int L_K = 0, L_V = 16384, L_IMP = 32768, L_SELM = 65536, L_TAB = 66560, L_WSF = 69120, L_OST = 71168, L_BYTES = 136704;
constexpr int TOPN = 16;

struct Tensors { const bf16* Q; const bf16* KS; const bf16* VS; const bf16* KW; const bf16* VW; const bf16* KC; const bf16* VC; const float* gates; const float* rel_bias; bf16* MIX; };

__device__ __forceinline__ int crow(int r, int hi) { return (r & 3) + 8 * (r >> 2) + 4 * hi; }
__device__ __forceinline__ int t5bucket(int n) {
  if (n < 16) return n < 0 ? 0 : n;
  if (n >= 128) return 31;
  int v = 16 + (int)(logf((float)n / 16.f) / 2.0794415416798357f * 16.f);
  return v > 31 ? 31 : v;
}
__device__ __forceinline__ unsigned cvtpk(float lo, float hi) { f32x2_t v = {lo, hi}; bf16x2_t b = __builtin_convertvector(v, bf16x2_t); return __builtin_bit_cast(unsigned, b); }
__device__ __forceinline__ void dma16(const void* g, NLAS unsigned char* l) { __builtin_amdgcn_global_load_lds((const unsigned*)g, (NLAS unsigned*)l, 16, 0, 0); }
__device__ __forceinline__ s16x4 vtr(const NLAS unsigned char* p) { return __builtin_bit_cast(s16x4, __builtin_amdgcn_ds_read_tr16_b64_v4i16((NLAS v4i16_t*)p)); }
__device__ __forceinline__ void lds_add(NLAS unsigned* p, unsigned v) { (void)__hip_atomic_fetch_add(p, v, __ATOMIC_RELAXED, __HIP_MEMORY_SCOPE_WORKGROUP); }
#define NSA_WAITBAR() asm volatile("s_waitcnt vmcnt(0) lgkmcnt(0)\n\ts_barrier" ::: "memory")

__device__ __forceinline__ void issue_tile(NLAS unsigned char* lds, int slot, const bf16* Kb, const bf16* Vb, int row0, int wid, int lane, bool withV) {
  dma16(Kb + (size_t)(row0 + lane) * 64 + wid * 8, lds + L_K + slot * 8192 + wid * 1024);
  if (withV) dma16(Vb + (size_t)(row0 + 16 * (wid & 3) + (lane >> 2)) * 64 + (wid >> 2) * 32 + (lane & 3) * 8, lds + L_V + slot * 8192 + wid * 1024);
}

template <int PASS>
__device__ __forceinline__ void tile_compute(NLAS unsigned char* lds, int slot, const bf16x8 (&qr)[4], f32x16& o0, f32x16& o1, float& mhat, float& lsum,
                                             float cbase, bool lanesel, bool near, int dq, int step, int dmax, const NLAS float* tabr,
                                             float invl, NLAS unsigned* impq, int nbase, NLAS float* wsf, int lane) {
  const int r32 = lane & 31, hi = lane >> 5;
  const float cinit = lanesel ? (cbase - mhat) : NEGBIG;
  f32x16 p0, p1;
#pragma unroll
  for (int r = 0; r < 16; ++r) { p0[r] = cinit; p1[r] = cinit; }
  {
    const NLAS unsigned char* kb = lds + L_K + slot * 8192 + hi * 1024 + r32 * 16;
#pragma unroll
    for (int d0 = 0; d0 < 4; ++d0) {
      const bf16x8 b0 = *(const NLAS bf16x8*)(kb + d0 * 2048), b1 = *(const NLAS bf16x8*)(kb + d0 * 2048 + 512);
      p0 = __builtin_amdgcn_mfma_f32_32x32x16_bf16(b0, qr[d0], p0, 0, 0, 0);
      p1 = __builtin_amdgcn_mfma_f32_32x32x16_bf16(b1, qr[d0], p1, 0, 0, 0);
    }
  }
  if (near) {
#pragma unroll
    for (int r = 0; r < 16; ++r) {
      const int kk = crow(r, hi);
      { const int d = dq - step * kk; const bool vis = (d >= 0) && (d < dmax); const int idx = d < 0 ? 0 : (d > 128 ? 128 : d); const float v = p0[r] + tabr[idx]; p0[r] = vis ? v : NEGBIG; }
      { const int d = dq - step * (kk + 32); const bool vis = (d >= 0) && (d < dmax); const int idx = d < 0 ? 0 : (d > 128 ? 128 : d); const float v = p1[r] + tabr[idx]; p1[r] = vis ? v : NEGBIG; }
    }
  }
  if (PASS != 2) {
    float a = fmaxf(fmaxf(p0[0], p0[1]), p1[0]), b = fmaxf(fmaxf(p0[2], p0[3]), p1[1]); a = fmaxf(fmaxf(a, p1[2]), p1[3]);
#pragma unroll
    for (int r = 4; r < 16; r += 4) { a = fmaxf(fmaxf(a, p0[r]), p0[r + 1]); b = fmaxf(fmaxf(b, p0[r + 2]), p0[r + 3]); a = fmaxf(fmaxf(a, p1[r]), p1[r + 1]); b = fmaxf(fmaxf(b, p1[r + 2]), p1[r + 3]); }
    float rm = fmaxf(a, b);
    { auto rr = __builtin_amdgcn_permlane32_swap(__float_as_uint(rm), __float_as_uint(rm), false, false); rm = fmaxf(__uint_as_float(rr[0]), __uint_as_float(rr[1])); }
    if (__any(rm > 8.f)) {
      const float dl = fmaxf(rm, 0.f); mhat += dl;
#pragma unroll
      for (int r = 0; r < 16; ++r) { p0[r] -= dl; p1[r] -= dl; }
      const float f = __builtin_amdgcn_exp2f(-dl); lsum *= f;
      if (PASS == 0) {
        if (hi == 0) wsf[r32] = f;
        asm volatile("s_waitcnt lgkmcnt(0)" ::: "memory");
#pragma unroll
        for (int r = 0; r < 16; ++r) { const float fr = wsf[crow(r, hi)]; o0[r] *= fr; o1[r] *= fr; }
        asm volatile("s_waitcnt lgkmcnt(0)" ::: "memory");
      }
    }
  }
#pragma unroll
  for (int r = 0; r < 16; ++r) { p0[r] = __builtin_amdgcn_exp2f(p0[r]); p1[r] = __builtin_amdgcn_exp2f(p1[r]); }
  if (PASS == 2) {
#pragma unroll
    for (int r = 0; r < 16; ++r) { p0[r] *= invl; p1[r] *= invl; }
    if (impq) {
#pragma unroll
      for (int a = 0; a < 4; ++a) {
        { const int n = nbase + 2 * a + hi; const float gs = (p0[4 * a] + p0[4 * a + 1]) + (p0[4 * a + 2] + p0[4 * a + 3]);
          lds_add(impq + n, (unsigned)(gs * 1048576.f + 0.5f)); if (n + 1 < 128) lds_add(impq + n + 1, (unsigned)(p0[4 * a + 3] * 1048576.f + 0.5f)); }
        { const int n = nbase + 8 + 2 * a + hi; const float gs = (p1[4 * a] + p1[4 * a + 1]) + (p1[4 * a + 2] + p1[4 * a + 3]);
          lds_add(impq + n, (unsigned)(gs * 1048576.f + 0.5f)); if (n + 1 < 128) lds_add(impq + n + 1, (unsigned)(p1[4 * a + 3] * 1048576.f + 0.5f)); }
      }
    }
  } else {
    float s = 0.f;
#pragma unroll
    for (int r = 0; r < 16; ++r) s += p0[r] + p1[r];
    lsum += s;
  }
  if (PASS != 1) {
    u32x4 pw[4];
#pragma unroll
    for (int k = 0; k < 4; ++k) { pw[0][k] = cvtpk(p0[2 * k], p0[2 * k + 1]); pw[1][k] = cvtpk(p0[8 + 2 * k], p0[8 + 2 * k + 1]); pw[2][k] = cvtpk(p1[2 * k], p1[2 * k + 1]); pw[3][k] = cvtpk(p1[8 + 2 * k], p1[8 + 2 * k + 1]); }
    const NLAS unsigned char* vp = lds + L_V + slot * 8192 + ((lane >> 4) & 1) * 32 + (lane & 3) * 8 + (4 * hi + ((lane & 15) >> 2)) * 64;
#pragma unroll
    for (int ks = 0; ks < 4; ++ks) {
      const bf16x8 pa = __builtin_bit_cast(bf16x8, pw[ks]);
      { const s16x4 lo = vtr(vp + ks * 1024), hh = vtr(vp + ks * 1024 + 512); const bf16x8 vf = {lo[0], lo[1], lo[2], lo[3], hh[0], hh[1], hh[2], hh[3]};
        o0 = __builtin_amdgcn_mfma_f32_32x32x16_bf16(pa, vf, o0, 0, 0, 0); }
      { const s16x4 lo = vtr(vp + 4096 + ks * 1024), hh = vtr(vp + 4096 + ks * 1024 + 512); const bf16x8 vf = {lo[0], lo[1], lo[2], lo[3], hh[0], hh[1], hh[2], hh[3]};
        o1 = __builtin_amdgcn_mfma_f32_32x32x16_bf16(pa, vf, o1, 0, 0, 0); }
    }
  }
}

template <bool FIRST>
__device__ __forceinline__ void add_scaled(NLAS float* stg, const f32x16& o0, const f32x16& o1, float fac, NLAS float* wsf, int lane) {
  const int r32 = lane & 31, hi = lane >> 5;
  if (hi == 0) wsf[r32] = fac;
  asm volatile("s_waitcnt lgkmcnt(0)" ::: "memory");
#pragma unroll
  for (int r = 0; r < 16; ++r) { const int orow = crow(r, hi); const float f = wsf[orow];
    if (FIRST) { stg[orow * 64 + r32] = o0[r] * f; stg[orow * 64 + 32 + r32] = o1[r] * f; }
    else { stg[orow * 64 + r32] += o0[r] * f; stg[orow * 64 + 32 + r32] += o1[r] * f; } }
  asm volatile("s_waitcnt lgkmcnt(0)" ::: "memory");
}
__device__ __forceinline__ float merge_halves_sum(float v) { auto rr = __builtin_amdgcn_permlane32_swap(__float_as_uint(v), __float_as_uint(v), false, false); return __uint_as_float(rr[0]) + __uint_as_float(rr[1]); }

__device__ __forceinline__ void unit(const Tensors& T, int b, int g, int qb, NLAS unsigned char* lds) {
  int tid_ = threadIdx.x; asm volatile("" : "+v"(tid_));
  const int tid = tid_, lane = tid & 63, wid = __builtin_amdgcn_readfirstlane(tid >> 6), r32 = lane & 31, hi = lane >> 5;
  const int hr = wid >> 1, qh = wid & 1, h = 4 * g + hr, slab = b * 2 + g, t0 = 64 * qb, qq = 32 * qh + r32, t = t0 + qq;
  const size_t tok = (size_t)b * 8192 + t;
  NLAS unsigned* imp = (NLAS unsigned*)(lds + L_IMP); NLAS unsigned* selm = (NLAS unsigned*)(lds + L_SELM); NLAS float* tab = (NLAS float*)(lds + L_TAB);
  NLAS float* wsf = (NLAS float*)(lds + L_WSF) + wid * 64; const NLAS float* tabr = tab + hr * 132;
  const bool dotopk = qb >= TOPN;
  for (int i = tid; i < 4 * 129; i += 512) { const int rr = i / 129, d = i % 129; tab[rr * 132 + d] = T.rel_bias[t5bucket(d) * 8 + 4 * g + rr] * LOG2E; }
  if (dotopk) for (int i = tid; i < 64 * 128; i += 512) imp[i] = 0u;
  bf16x8 qr[4];
#pragma unroll
  for (int d0 = 0; d0 < 4; ++d0) qr[d0] = *(const bf16x8*)(T.Q + tok * 512 + h * 64 + d0 * 16 + hi * 8);
  const float* gp = T.gates + tok * 32 + h * 3; const float g_c = gp[0], g_s = gp[1], g_w = gp[2];
  NLAS float* stg = (NLAS float*)(lds + L_OST) + wid * 2048;
  const bf16* KC = T.KC + (size_t)slab * 512 * 64; const bf16* VC = T.VC + (size_t)slab * 512 * 64;
  const bf16* KS = T.KS + (size_t)slab * 8192 * 64; const bf16* VS = T.VS + (size_t)slab * 8192 * 64;
  const bf16* KW = T.KW + (size_t)slab * 8192 * 64; const bf16* VW = T.VW + (size_t)slab * 8192 * 64;
  issue_tile(lds, 0, KC, VC, 0, wid, lane, false);
  NSA_WAITBAR();
  const float b31 = tabr[128];
  const int nct = ((4 * qb + 2) >> 6) + 1;
  float mhat = 0.f, lsum = 0.f; f32x16 o0, o1;
#pragma unroll
  for (int r = 0; r < 16; ++r) { o0[r] = 0.f; o1[r] = 0.f; }
  for (int ct = 0; ct < nct; ++ct) {
    if (ct + 1 < nct) issue_tile(lds, (ct + 1) & 1, KC, VC, 64 * (ct + 1), wid, lane, false);
    const bool near = ct + 2 >= nct;
    tile_compute<1>(lds, ct & 1, qr, o0, o1, mhat, lsum, near ? 0.f : b31, true, near, t - 31 - 1024 * ct, 16, 1 << 30, tabr, 0.f, nullptr, 0, wsf, lane);
    NSA_WAITBAR();
  }
  lsum = merge_halves_sum(lsum);
  const float invl_c = lsum > 0.f ? 1.f / lsum : 0.f;
  issue_tile(lds, 0, KC, VC, 0, wid, lane, true);
  NSA_WAITBAR();
  for (int ct = 0; ct < nct; ++ct) {
    if (ct + 1 < nct) issue_tile(lds, (ct + 1) & 1, KC, VC, 64 * (ct + 1), wid, lane, true);
    const bool near = ct + 2 >= nct;
    tile_compute<2>(lds, ct & 1, qr, o0, o1, mhat, lsum, near ? 0.f : b31, true, near, t - 31 - 1024 * ct, 16, 1 << 30, tabr, invl_c, dotopk ? imp + qq * 128 : nullptr, 16 * ct, wsf, lane);
    NSA_WAITBAR();
  }
  add_scaled<true>(stg, o0, o1, g_c, wsf, lane);
  {
    const int q = tid >> 3, part = tid & 7; unsigned bits = 0u;
    if (dotopk) {
      unsigned key[16];
#pragma unroll
      for (int i = 0; i < 16; ++i) { const int n = 16 * part + i; const unsigned v = imp[q * 128 + n]; key[i] = (n >= 1 && n <= qb - 2) ? ((v << 7) | (unsigned)(127 - n)) : 0u; }
      unsigned thr = 0u;
      for (int bit = 31; bit >= 0; --bit) { const unsigned cand = thr | (1u << bit); int cnt = 0;
#pragma unroll
        for (int i = 0; i < 16; ++i) cnt += (key[i] >= cand) ? 1 : 0;
        cnt += __shfl_xor(cnt, 1); cnt += __shfl_xor(cnt, 2); cnt += __shfl_xor(cnt, 4);
        if (cnt >= TOPN - 3) thr = cand; }
#pragma unroll
      for (int i = 0; i < 16; ++i) { const int n = 16 * part + i; if ((key[i] >= thr && key[i] != 0u) || n == 0 || n == qb || n == qb - 1) bits |= 1u << i; }
    } else {
#pragma unroll
      for (int i = 0; i < 16; ++i) if (16 * part + i <= qb) bits |= 1u << i;
    }
    ((NLAS unsigned short*)selm)[q * 8 + part] = (unsigned short)bits;
  }
  issue_tile(lds, 0, KS, VS, 0, wid, lane, true);
  NSA_WAITBAR();
  const unsigned long long mlo = (unsigned long long)selm[qq * 4 + 0] | ((unsigned long long)selm[qq * 4 + 1] << 32), mhi = (unsigned long long)selm[qq * 4 + 2] | ((unsigned long long)selm[qq * 4 + 3] << 32);
  mhat = 0.f; lsum = 0.f;
#pragma unroll
  for (int r = 0; r < 16; ++r) { o0[r] = 0.f; o1[r] = 0.f; }
  for (int j = 0; j <= qb; ++j) {
    if (j < qb) issue_tile(lds, (j + 1) & 1, KS, VS, 64 * (j + 1), wid, lane, true);
    const bool near = j + 2 >= qb; const bool sel = (((j < 64 ? mlo : mhi) >> (j & 63)) & 1ull) != 0ull;
    tile_compute<0>(lds, j & 1, qr, o0, o1, mhat, lsum, near ? 0.f : b31, sel, near, t - 64 * j, 1, 1 << 30, tabr, 0.f, nullptr, 0, wsf, lane);
    NSA_WAITBAR();
  }
  lsum = merge_halves_sum(lsum);
  add_scaled<false>(stg, o0, o1, lsum > 0.f ? g_s / lsum : 0.f, wsf, lane);
  const int jw0 = qb >= 8 ? qb - 8 : 0;
  issue_tile(lds, jw0 & 1, KW, VW, 64 * jw0, wid, lane, true);
  NSA_WAITBAR();
  mhat = 0.f; lsum = 0.f;
#pragma unroll
  for (int r = 0; r < 16; ++r) { o0[r] = 0.f; o1[r] = 0.f; }
  for (int j = jw0; j <= qb; ++j) {
    if (j < qb) issue_tile(lds, (j + 1) & 1, KW, VW, 64 * (j + 1), wid, lane, true);
    const bool near = (j + 2 >= qb) || (j + 8 == qb);
    tile_compute<0>(lds, j & 1, qr, o0, o1, mhat, lsum, near ? 0.f : b31, true, near, t - 64 * j, 1, 512, tabr, 0.f, nullptr, 0, wsf, lane);
    NSA_WAITBAR();
  }
  lsum = merge_halves_sum(lsum);
  add_scaled<false>(stg, o0, o1, lsum > 0.f ? g_w / lsum : 0.f, wsf, lane);
  {
    bf16* Ow = T.MIX + ((size_t)b * 8192 + t0 + 32 * qh) * 1024 + h * 64;
#pragma unroll
    for (int i = 0; i < 4; ++i) { const int row = i * 8 + (lane >> 3), ch = lane & 7; const NLAS float* sp = stg + row * 64 + ch * 8;
      u32x4 v; v.x = cvtpk(sp[0], sp[1]); v.y = cvtpk(sp[2], sp[3]); v.z = cvtpk(sp[4], sp[5]); v.w = cvtpk(sp[6], sp[7]); *(u32x4*)(Ow + (size_t)row * 1024 + ch * 8) = v; }
  }
  NSA_WAITBAR();
}
}
namespace rwkv {
#define RLAS __attribute__((address_space(3)))
typedef unsigned short bf16;
typedef short bf16x8 __attribute__((ext_vector_type(8)));
typedef short bf16x4 __attribute__((ext_vector_type(4)));
typedef float f32x4 __attribute__((ext_vector_type(4)));
typedef unsigned u32x2 __attribute__((ext_vector_type(2)));
typedef unsigned u32x4 __attribute__((ext_vector_type(4)));
typedef float f32x2_t __attribute__((ext_vector_type(2))); typedef __bf16 bf16x2_t __attribute__((ext_vector_type(2)));
constexpr int LD = 72, MATB = 64 * LD * 2;
constexpr int M_AT = 0, M_ATT = MATB, M_BT = 2 * MATB, M_BTT = 3 * MATB, M_KT = 4 * MATB, M_KTT = 5 * MATB, M_RT = 6 * MATB, M_VT = 7 * MATB;
constexpr int A_AB = 8 * MATB, A_AK = 9 * MATB, A_RB = 10 * MATB, A_RK = 11 * MATB, L_DIAG = 12 * MATB, L_TII = L_DIAG + 4096, L_E = L_TII + 2048, L_SEG = L_E + 16384, L_PC = L_SEG + 2048, L_BYTES = L_PC + 256;
struct Tensors {
  const bf16* RW; const bf16* LORA;
  const float *mu, *w0, *a0, *k_k, *k_a, *r_k, *ln_w, *ln_b;
  bf16 *G, *HADD, *RWM, *Y0, *HT; float* PC;
  bf16* MIX;
};
__device__ __forceinline__ int opq(int x) { asm volatile("" : "+s"(x)); return x; }
__device__ __forceinline__ float bf2f(bf16 v) { return __uint_as_float((unsigned)v << 16); }
__device__ __forceinline__ unsigned cvtpk(float lo, float hi) { f32x2_t v = {lo, hi}; bf16x2_t b = __builtin_convertvector(v, bf16x2_t); return __builtin_bit_cast(unsigned, b); }
__device__ __forceinline__ bf16x4 pack4(const f32x4& v) { u32x2 r; r.x = cvtpk(v[0], v[1]); r.y = cvtpk(v[2], v[3]); return __builtin_bit_cast(bf16x4, r); }
__device__ __forceinline__ f32x4 mfma16(bf16x4 a, bf16x4 b, f32x4 c) { return __builtin_amdgcn_mfma_f32_16x16x16bf16_1k(a, b, c, 0, 0, 0); }
__device__ __forceinline__ f32x4 mfma32(bf16x8 a, bf16x8 b, f32x4 c) { return __builtin_amdgcn_mfma_f32_16x16x32_bf16(a, b, c, 0, 0, 0); }
__device__ __forceinline__ float sigm(float x) { return 1.f / (1.f + expf(-x)); }
__device__ __forceinline__ void unpack8(const u32x4& w, float (&o)[8]) {
  o[0] = __uint_as_float(w.x << 16); o[1] = __uint_as_float(w.x & 0xffff0000u); o[2] = __uint_as_float(w.y << 16); o[3] = __uint_as_float(w.y & 0xffff0000u);
  o[4] = __uint_as_float(w.z << 16); o[5] = __uint_as_float(w.z & 0xffff0000u); o[6] = __uint_as_float(w.w << 16); o[7] = __uint_as_float(w.w & 0xffff0000u);
}
struct Prep8 { float r[8], kp[8], v[8], e[8], a[8], kk[8]; };
__device__ __forceinline__ void prep8(const Tensors& T, size_t m, int t, int h, int c0, Prep8& o, bool need_w) {
  const bf16* rw = T.RW + m * 1792 + h * 64 + c0; const bf16* lo = T.LORA + m * 1536 + h * 64 + c0; const int c = h * 64 + c0;
  float rc[8], kc[8], vc[8], rp[8], kp[8], vp[8], al[8], wl[8];
  unpack8(*(const u32x4*)rw, rc); unpack8(*(const u32x4*)(rw + 512), kc); unpack8(*(const u32x4*)(rw + 1024), vc);
  if (t > 0) { unpack8(*(const u32x4*)(rw - 1792), rp); unpack8(*(const u32x4*)(rw + 512 - 1792), kp); unpack8(*(const u32x4*)(rw + 1024 - 1792), vp); }
  else {
#pragma unroll
    for (int j = 0; j < 8; ++j) { rp[j] = 0.f; kp[j] = 0.f; vp[j] = 0.f; } }
  unpack8(*(const u32x4*)(lo + 512), al);
  if (need_w) unpack8(*(const u32x4*)lo, wl);
#pragma unroll
  for (int j = 0; j < 8; ++j) {
    const float rm = rc[j] + (rp[j] - rc[j]) * T.mu[c + j], km = kc[j] + (kp[j] - kc[j]) * T.mu[512 + c + j], vm = vc[j] + (vp[j] - vc[j]) * T.mu[1024 + c + j];
    const float a = sigm(T.a0[c + j] + al[j]);
    o.r[j] = rm; o.v[j] = vm; o.a[j] = a; o.kk[j] = km * T.k_k[c + j]; o.kp[j] = km * (1.f + (a - 1.f) * T.k_a[c + j]);
    if (need_w) { const float wr = T.w0[c + j] + wl[j]; const float sp = (-wr > 20.f) ? -wr : log1pf(expf(-wr)); o.e[j] = expf(-sp - 0.5f); } else o.e[j] = 0.f;
  }
}

__device__ __forceinline__ void p1_item(const Tensors& T, int bh, int ch, RLAS unsigned char* lds) {
  int tid_ = threadIdx.x; asm volatile("" : "+v"(tid_));
  const int tid = tid_, lane = tid & 63, wid = __builtin_amdgcn_readfirstlane(tid >> 6), col = lane & 15, q = lane >> 4;
  const int b = bh >> 3, h = bh & 7; const size_t item = (size_t)bh * 128 + ch;
  const int MVT = opq(M_VT);
  RLAS float* E = (RLAS float*)(lds + L_E); RLAS float* SEG = (RLAS float*)(lds + L_SEG); RLAS float* PCL = (RLAS float*)(lds + L_PC);
  const int i = tid >> 3, c0 = (tid & 7) * 8; const int t = ch * 64 + i; const size_t m = (size_t)b * 8192 + t;
  Prep8 P; prep8(T, m, t, h, c0, P, true);
  float ss = 0.f;
#pragma unroll
  for (int j = 0; j < 8; ++j) ss += P.kk[j] * P.kk[j];
  ss += __shfl_xor(ss, 1); ss += __shfl_xor(ss, 2); ss += __shfl_xor(ss, 4);
  const float kinv = 1.f / fmaxf(sqrtf(ss), 1e-12f);
#pragma unroll
  for (int j = 0; j < 8; ++j) E[i * 64 + c0 + j] = P.e[j];
  __syncthreads();
  { const int k = tid & 63, sg = tid >> 6; float run = 0.f;
#pragma unroll
    for (int ii = 0; ii < 8; ++ii) { run += E[(sg * 8 + ii) * 64 + k]; E[(sg * 8 + ii) * 64 + k] = run; }
    SEG[sg * 64 + k] = run; }
  __syncthreads();
  {
    float av[8], bv[8], kv[8], rv[8];
#pragma unroll
    for (int j = 0; j < 8; ++j) {
      float off = 0.f;
#pragma unroll
      for (int s = 0; s < 7; ++s) off += (s < (i >> 3)) ? SEG[s * 64 + c0 + j] : 0.f;
      const float cum = E[i * 64 + c0 + j] + off;
      const float pinc = expf(-cum), pexc = expf(-(cum - P.e[j])), pinv = expf(cum);
      const float kk = P.kk[j] * kinv;
      av[j] = -kk * pexc; bv[j] = kk * P.a[j] * pinv; kv[j] = P.kp[j] * pinv; rv[j] = P.r[j] * pinc;
      if (i == 63) { PCL[c0 + j] = pinc; T.PC[item * 64 + c0 + j] = pinc; }
    }
    u32x4 w;
    w.x = cvtpk(av[0], av[1]); w.y = cvtpk(av[2], av[3]); w.z = cvtpk(av[4], av[5]); w.w = cvtpk(av[6], av[7]); *(RLAS u32x4*)(lds + M_AT + (i * LD + c0) * 2) = w;
    w.x = cvtpk(bv[0], bv[1]); w.y = cvtpk(bv[2], bv[3]); w.z = cvtpk(bv[4], bv[5]); w.w = cvtpk(bv[6], bv[7]); *(RLAS u32x4*)(lds + M_BT + (i * LD + c0) * 2) = w;
    w.x = cvtpk(kv[0], kv[1]); w.y = cvtpk(kv[2], kv[3]); w.z = cvtpk(kv[4], kv[5]); w.w = cvtpk(kv[6], kv[7]); *(RLAS u32x4*)(lds + M_KT + (i * LD + c0) * 2) = w;
    w.x = cvtpk(rv[0], rv[1]); w.y = cvtpk(rv[2], rv[3]); w.z = cvtpk(rv[4], rv[5]); w.w = cvtpk(rv[6], rv[7]); *(RLAS u32x4*)(lds + M_RT + (i * LD + c0) * 2) = w;
#pragma unroll
    for (int j = 0; j < 8; ++j) {
      *(RLAS bf16*)(lds + M_ATT + ((c0 + j) * LD + i) * 2) = (bf16)(cvtpk(av[j], 0.f) & 0xffffu);
      *(RLAS bf16*)(lds + M_BTT + ((c0 + j) * LD + i) * 2) = (bf16)(cvtpk(bv[j], 0.f) & 0xffffu);
      *(RLAS bf16*)(lds + M_KTT + ((c0 + j) * LD + i) * 2) = (bf16)(cvtpk(kv[j], 0.f) & 0xffffu);
      *(RLAS bf16*)(lds + MVT + ((c0 + j) * LD + i) * 2) = (bf16)(cvtpk(P.v[j], 0.f) & 0xffffu);
    }
  }
  __syncthreads();
  {
    const int it = wid & 3, src = wid >> 2;
    const RLAS unsigned char* SRC = lds + (src ? M_RT : M_AT) + ((16 * it + col) * LD + 8 * q) * 2;
    const bf16x8 b0 = *(const RLAS bf16x8*)SRC, b1 = *(const RLAS bf16x8*)(SRC + 64);
    const int gi = 16 * it + col;
#pragma unroll
    for (int jt = 0; jt < 4; ++jt)
#pragma unroll
      for (int which = 0; which < 2; ++which) {
        const RLAS unsigned char* AM = lds + (which ? M_KT : M_BT) + ((16 * jt + col) * LD + 8 * q) * 2;
        f32x4 acc = {0.f, 0.f, 0.f, 0.f};
        acc = mfma32(*(const RLAS bf16x8*)AM, b0, acc); acc = mfma32(*(const RLAS bf16x8*)(AM + 64), b1, acc);
#pragma unroll
        for (int r = 0; r < 4; ++r) { const int gj = 16 * jt + 4 * q + r; const bool keep = src ? (gj <= gi) : (gj < gi); acc[r] = keep ? acc[r] : 0.f; }
        const int dst = src ? (which ? A_RK : A_RB) : (which ? A_AK : A_AB);
        *(RLAS bf16x4*)(lds + dst + (gi * LD + 16 * jt + 4 * q) * 2) = pack4(acc);
        if (src == 0 && which == 0 && jt == it) {
#pragma unroll
          for (int r = 0; r < 4; ++r) *(RLAS float*)(lds + L_DIAG + ((it * 16 + col) * 16 + 4 * q + r) * 4) = acc[r];
        }
      }
  }
  __syncthreads();
  if (wid == 0) {
    const int blk = lane >> 4, c = lane & 15; const RLAS float* L = (const RLAS float*)(lds + L_DIAG) + blk * 256;
    float x[16];
#pragma unroll
    for (int ii = 0; ii < 16; ++ii) { float s = (ii == c) ? 1.f : 0.f;
#pragma unroll
      for (int mm = 0; mm < ii; ++mm) s += L[ii * 16 + mm] * x[mm];
      x[ii] = s; }
#pragma unroll
    for (int ii = 0; ii < 16; ++ii) *(RLAS bf16*)(lds + L_TII + ((blk * 16 + ii) * 16 + c) * 2) = (bf16)(cvtpk(x[ii], 0.f) & 0xffffu);
  }
  __syncthreads();
  {
    const bool isU = wid >= 4; const int ct = wid & 3;
    bf16x4 Xb[4];
#pragma unroll
    for (int ib = 0; ib < 4; ++ib) {
      f32x4 tmp;
      if (!isU) { const bf16x4 a4 = *(const RLAS bf16x4*)(lds + M_ATT + ((16 * ct + col) * LD + 16 * ib + 4 * q) * 2);
#pragma unroll
        for (int r = 0; r < 4; ++r) tmp[r] = bf2f((bf16)a4[r]); }
      else { tmp = (f32x4){0.f, 0.f, 0.f, 0.f};
#pragma unroll
        for (int ks = 0; ks < 2; ++ks) tmp = mfma32(*(const RLAS bf16x8*)(lds + A_AK + ((16 * ib + col) * LD + 32 * ks + 8 * q) * 2), *(const RLAS bf16x8*)(lds + MVT + ((16 * ct + col) * LD + 32 * ks + 8 * q) * 2), tmp); }
      const f32x4 zero = {0.f, 0.f, 0.f, 0.f};
      f32x4 t16 = zero;
#pragma unroll
      for (int mb = 0; mb < 4; ++mb) if (mb < ib) t16 = mfma16(*(const RLAS bf16x4*)(lds + A_AB + ((16 * ib + col) * LD + 16 * mb + 4 * q) * 2), Xb[mb], t16);
      tmp = tmp + t16;
      const f32x4 X = mfma16(*(const RLAS bf16x4*)(lds + L_TII + ((ib * 16 + col) * 16 + 4 * q) * 2), pack4(tmp), zero);
      Xb[ib] = pack4(X);
    }
    if (!isU) {
#pragma unroll
      for (int ib = 0; ib < 4; ++ib) { const int gi = 16 * ib + col;
        const bf16x4 r4 = *(const RLAS bf16x4*)(lds + M_RT + (gi * LD + 16 * ct + 4 * q) * 2); f32x4 acc;
#pragma unroll
        for (int r = 0; r < 4; ++r) acc[r] = bf2f((bf16)r4[r]);
#pragma unroll
        for (int mb = 0; mb < 4; ++mb) if (mb <= ib) acc = mfma16(Xb[mb], *(const RLAS bf16x4*)(lds + A_RB + (gi * LD + 16 * mb + 4 * q) * 2), acc);
        *(bf16x4*)(T.RWM + item * 4096 + gi * 64 + 16 * ct + 4 * q) = pack4(acc); }
#pragma unroll
      for (int kb = 0; kb < 4; ++kb) { const int gk = 16 * kb + col; f32x4 acc = {0.f, 0.f, 0.f, 0.f};
#pragma unroll
        for (int mb = 0; mb < 4; ++mb) acc = mfma16(Xb[mb], *(const RLAS bf16x4*)(lds + M_BTT + (gk * LD + 16 * mb + 4 * q) * 2), acc);
        const float pc = PCL[gk];
#pragma unroll
        for (int r = 0; r < 4; ++r) acc[r] *= pc;
        *(bf16x4*)(T.G + item * 4096 + gk * 64 + 16 * ct + 4 * q) = pack4(acc); }
    } else {
#pragma unroll
      for (int ib = 0; ib < 4; ++ib) { const int gi = 16 * ib + col; f32x4 acc = {0.f, 0.f, 0.f, 0.f}, acc2 = {0.f, 0.f, 0.f, 0.f};
#pragma unroll
        for (int mb = 0; mb < 4; ++mb) if (mb <= ib) acc = mfma16(Xb[mb], *(const RLAS bf16x4*)(lds + A_RB + (gi * LD + 16 * mb + 4 * q) * 2), acc);
#pragma unroll
        for (int ks = 0; ks < 2; ++ks) acc2 = mfma32(*(const RLAS bf16x8*)(lds + MVT + ((16 * ct + col) * LD + 32 * ks + 8 * q) * 2), *(const RLAS bf16x8*)(lds + A_RK + (gi * LD + 32 * ks + 8 * q) * 2), acc2);
        acc = acc + acc2;
        *(bf16x4*)(T.Y0 + item * 4096 + gi * 64 + 16 * ct + 4 * q) = pack4(acc); }
#pragma unroll
      for (int kb = 0; kb < 4; ++kb) { f32x4 acc = {0.f, 0.f, 0.f, 0.f}, acc2 = {0.f, 0.f, 0.f, 0.f};
#pragma unroll
        for (int mb = 0; mb < 4; ++mb) acc = mfma16(*(const RLAS bf16x4*)(lds + M_BTT + ((16 * kb + col) * LD + 16 * mb + 4 * q) * 2), Xb[mb], acc);
#pragma unroll
        for (int ks = 0; ks < 2; ++ks) acc2 = mfma32(*(const RLAS bf16x8*)(lds + M_KTT + ((16 * kb + col) * LD + 32 * ks + 8 * q) * 2), *(const RLAS bf16x8*)(lds + MVT + ((16 * ct + col) * LD + 32 * ks + 8 * q) * 2), acc2);
        const f32x4 pc = *(const RLAS f32x4*)(PCL + 16 * kb + 4 * q);
        acc = (acc + acc2) * pc;
        *(bf16x4*)(T.HADD + item * 4096 + (16 * ct + col) * 64 + 16 * kb + 4 * q) = pack4(acc); }
    }
  }
  __syncthreads();
}

__device__ __forceinline__ void scan_head(const Tensors& T, int bh, int wv, int lane) {
  const int col = lane & 15, q = lane >> 4, v = 16 * wv + col;
  f32x4 acc[4];
#pragma unroll
  for (int kb = 0; kb < 4; ++kb) acc[kb] = (f32x4){0.f, 0.f, 0.f, 0.f};
  for (int ch = 0; ch < 128; ++ch) {
    const size_t item = (size_t)bh * 128 + ch;
    const bf16* Gp = T.G + item * 4096; const bf16* Hp = T.HADD + item * 4096 + v * 64; const float* Pp = T.PC + item * 64;
    bf16x4 ga[4][4]; bf16x4 ha[4]; f32x4 pc[4];
#pragma unroll
    for (int kb = 0; kb < 4; ++kb) { ha[kb] = *(const bf16x4*)(Hp + 16 * kb + 4 * q); pc[kb] = *(const f32x4*)(Pp + 16 * kb + 4 * q);
#pragma unroll
      for (int mb = 0; mb < 4; ++mb) ga[kb][mb] = *(const bf16x4*)(Gp + (16 * kb + col) * 64 + 16 * mb + 4 * q); }
    bf16x4 hb[4];
#pragma unroll
    for (int kb = 0; kb < 4; ++kb) { hb[kb] = pack4(acc[kb]); *(bf16x4*)(T.HT + item * 4096 + v * 64 + 16 * kb + 4 * q) = hb[kb]; }
    f32x4 nw[4];
#pragma unroll
    for (int kb = 0; kb < 4; ++kb) {
#pragma unroll
      for (int r = 0; r < 4; ++r) nw[kb][r] = pc[kb][r] * acc[kb][r] + bf2f((bf16)ha[kb][r]);
#pragma unroll
      for (int mb = 0; mb < 4; ++mb) nw[kb] = mfma16(ga[kb][mb], hb[mb], nw[kb]);
    }
#pragma unroll
    for (int kb = 0; kb < 4; ++kb) acc[kb] = nw[kb];
  }
}

__device__ __forceinline__ void p2_item(const Tensors& T, int bh, int ch, int ib, int lane) {
  const int col = lane & 15, q = lane >> 4, b = bh >> 3, h = bh & 7; const size_t item = (size_t)bh * 128 + ch;
  const int i = 16 * ib + col, t = ch * 64 + i; const size_t m = (size_t)b * 8192 + t;
  const bf16* RWp = T.RWM + item * 4096 + i * 64 + 8 * q; const bf16* HTp = T.HT + item * 4096 + col * 64 + 8 * q;
  const bf16x8 rb0 = *(const bf16x8*)RWp, rb1 = *(const bf16x8*)(RWp + 32);
  f32x4 y[4];
#pragma unroll
  for (int vt = 0; vt < 4; ++vt) { const bf16x4 y0 = *(const bf16x4*)(T.Y0 + item * 4096 + i * 64 + 16 * vt + 4 * q);
#pragma unroll
    for (int r = 0; r < 4; ++r) y[vt][r] = bf2f((bf16)y0[r]);
    y[vt] = mfma32(*(const bf16x8*)(HTp + vt * 16 * 64), rb0, y[vt]); y[vt] = mfma32(*(const bf16x8*)(HTp + vt * 16 * 64 + 32), rb1, y[vt]); }
  float bo = 0.f; float vmix[4][4];
  {
    Prep8 P;
#pragma unroll
    for (int hf = 0; hf < 2; ++hf) { prep8(T, m, t, h, 16 * q + 8 * hf, P, false);
#pragma unroll
      for (int j = 0; j < 8; ++j) bo += P.r[j] * P.kp[j] * T.r_k[h * 64 + 16 * q + 8 * hf + j]; }
    bo += __shfl_xor(bo, 16); bo += __shfl_xor(bo, 32);
    const bf16* rw = T.RW + m * 1792 + 1024 + h * 64;
#pragma unroll
    for (int vt = 0; vt < 4; ++vt) { const bf16x4 vc = *(const bf16x4*)(rw + 16 * vt + 4 * q); bf16x4 vp = {0, 0, 0, 0}; if (t > 0) vp = *(const bf16x4*)(rw - 1792 + 16 * vt + 4 * q);
#pragma unroll
      for (int r = 0; r < 4; ++r) { const float c = bf2f((bf16)vc[r]), pv = bf2f((bf16)vp[r]); vmix[vt][r] = c + (pv - c) * T.mu[1024 + h * 64 + 16 * vt + 4 * q + r]; } }
  }
  float s = 0.f;
#pragma unroll
  for (int vt = 0; vt < 4; ++vt) s += (y[vt][0] + y[vt][1]) + (y[vt][2] + y[vt][3]);
  s += __shfl_xor(s, 16); s += __shfl_xor(s, 32);
  const float mean = s * (1.f / 64.f); float qq = 0.f;
#pragma unroll
  for (int vt = 0; vt < 4; ++vt)
#pragma unroll
    for (int r = 0; r < 4; ++r) { const float d = y[vt][r] - mean; qq += d * d; }
  qq += __shfl_xor(qq, 16); qq += __shfl_xor(qq, 32);
  const float rstd = rsqrtf(qq * (1.f / 64.f) + 64e-5f);
#pragma unroll
  for (int vt = 0; vt < 4; ++vt) { const int c = h * 64 + 16 * vt + 4 * q;
    const f32x4 lw = *(const f32x4*)(T.ln_w + c), lb = *(const f32x4*)(T.ln_b + c); const bf16x4 g4 = *(const bf16x4*)(T.LORA + m * 1536 + 1024 + c);
    f32x4 o;
#pragma unroll
    for (int r = 0; r < 4; ++r) o[r] = ((y[vt][r] - mean) * rstd * lw[r] + lb[r] + bo * vmix[vt][r]) * bf2f((bf16)g4[r]);
    *(bf16x4*)(T.MIX + m * 1024 + 512 + c) = pack4(o); }
}
}
namespace {
#define LAS __attribute__((address_space(3)))
typedef unsigned short bf16;
typedef unsigned v4u __attribute__((ext_vector_type(4)));
typedef float f32x4 __attribute__((ext_vector_type(4)));
constexpr int NWAVES = 8, NTHREADS = 512;
constexpr int B_ = 2, T_ = 8192, D_ = 1024, M_ = B_ * T_, DIN = 3096, DFF = 2816, NPROJ = 3328, NLORA = 1536, KLORA = 256, NUPH = 2816;
constexpr size_t MiB = 1u << 20;
constexpr size_t WS_CTL = 0, WS_WIN = 1 * MiB, WS_WOUT = 8 * MiB, WS_WUP = 10 * MiB, WS_WDN = 21 * MiB, WS_LORAW = 27 * MiB, WS_B1P = 28 * MiB;
constexpr size_t WS_XN = 32 * MiB;
constexpr size_t WS_HT = 32 * MiB, WS_PC = 48 * MiB;
constexpr size_t WS_Q = 64 * MiB;
constexpr size_t WS_SLAB = 80 * MiB;
constexpr size_t WS_GATES = 104 * MiB;
constexpr size_t WS_RW = 106 * MiB;
constexpr size_t WS_LORA = 162 * MiB;
constexpr size_t WS_ACT = 210 * MiB;
constexpr size_t WS_CMP = 218 * MiB;
constexpr size_t WS_MIX = 220 * MiB;
constexpr size_t WS_U = 64 * MiB;
constexpr size_t WS_ACT2 = 152 * MiB;
constexpr size_t WS_END = 256 * MiB;
constexpr int LDS_BYTES = 147456;

__device__ __forceinline__ float bf2f(bf16 v) { return __uint_as_float((unsigned)v << 16); }
__device__ __forceinline__ unsigned f2bf(float f) { unsigned u = __float_as_uint(f); return (u + 0x7fffu + ((u >> 16) & 1u)) >> 16; }
__device__ __forceinline__ unsigned pk2(float lo, float hi) { return f2bf(lo) | (f2bf(hi) << 16); }
__device__ __forceinline__ float wsum(float v) {
#pragma unroll
  for (int o = 32; o >= 1; o >>= 1) v += __shfl_xor(v, o);
  return v;
}
__device__ __forceinline__ float wmax(float v) {
#pragma unroll
  for (int o = 32; o >= 1; o >>= 1) v = fmaxf(v, __shfl_xor(v, o));
  return v;
}
__device__ __forceinline__ int t5b(int n) {
  if (n < 16) return n < 0 ? 0 : n;
  if (n >= 128) return 31;
  int v = 16 + (int)(logf((float)n / 16.f) / 2.0794415416798357f * 16.f);
  return v > 31 ? 31 : v;
}
__device__ __forceinline__ float sigm(float x) { return 1.f / (1.f + expf(-x)); }
__device__ __forceinline__ float gelu_tanh(float x) { return 0.5f * x * (1.f + tanhf(0.7978845608028654f * (x + 0.044715f * x * x * x))); }

#define XB_TMO      128
#define XB_XCNT(j)  (256  + 64 * (j))
#define XB_XSUB(j)  (1280 + 64 * (j))
#define XB_XGEN(j)  (2304 + 64 * (j))
#define XB_TOP      3328
#define XB_TOPGEN   3392
#define XCD_BAR_WORDS 3456
#define XB_SPIN_CAP (1u << 18)

__device__ __forceinline__ unsigned xb_ld(unsigned* p)              { return __hip_atomic_load(p, __ATOMIC_RELAXED, __HIP_MEMORY_SCOPE_AGENT); }
__device__ __forceinline__ unsigned xb_add(unsigned* p, unsigned v) { return __hip_atomic_fetch_add(p, v, __ATOMIC_RELAXED, __HIP_MEMORY_SCOPE_AGENT); }
__device__ __forceinline__ unsigned xb_xcc_id() { return (unsigned)__builtin_amdgcn_s_getreg((3 << 11) | 20) & 0xFu; }
#define XB_SPIN(cond, bar) do { unsigned _sp = 0; while (cond) { __builtin_amdgcn_s_sleep(1); \
    if ((++_sp & 255u) == 0u) { if (xb_ld(&(bar)[XB_TMO])) break; if (_sp > XB_SPIN_CAP) { atomicAdd(&(bar)[XB_TMO], 1u); break; } } } } while (0)

struct XcdBarrier {
    unsigned* bar; unsigned x;
    volatile LAS unsigned* st;
};

__device__ __forceinline__ XcdBarrier xcd_barrier_post(unsigned* bar, volatile LAS unsigned* st) {
    XcdBarrier b; b.bar = bar; b.x = xb_xcc_id(); b.st = st;
    if (threadIdx.x == 0) (void)xb_add(&bar[XB_XCNT(b.x)], 1u);
    return b;
}
__device__ __forceinline__ void xcd_barrier_complete(unsigned* bar, unsigned x, unsigned& nloc, unsigned& nx) {
    const unsigned G = gridDim.x * gridDim.y * gridDim.z;
    unsigned sum, cnt, mine, sp = 0u;
    for (;;) {
        sum = 0u; cnt = 0u; mine = 0u;
#pragma unroll
        for (unsigned j = 0; j < 16; ++j) { const unsigned c = xb_ld(&bar[XB_XCNT(j)]); sum += c; cnt += (c > 0u) ? 1u : 0u; mine = (j == x) ? c : mine; }
        if (sum == G) break;
        __builtin_amdgcn_s_sleep(1);
        if ((++sp & 255u) == 0u) { if (xb_ld(&bar[XB_TMO])) break; if (sp > XB_SPIN_CAP) { atomicAdd(&bar[XB_TMO], 1u); break; } }
    }
    nloc = mine > 0u ? mine : 1u; nx = cnt > 0u ? cnt : 1u;
}

__device__ __forceinline__ void xcd_barrier(const XcdBarrier& b) {
    asm volatile("s_waitcnt vmcnt(0)" ::: "memory");
    __syncthreads();
    if (threadIdx.x == 0) {
        unsigned* bar = b.bar;
        __builtin_amdgcn_s_waitcnt(0);
        unsigned nloc = b.st[0], nx = b.st[1];
        if (nloc == 0u) { xcd_barrier_complete(bar, b.x, nloc, nx); b.st[0] = nloc; b.st[1] = nx; }
        const unsigned old = xb_add(&bar[XB_XSUB(b.x)], 1u);
        const unsigned gen = old / nloc;
        if (old + 1u == (gen + 1u) * nloc) {
            __builtin_amdgcn_fence(__ATOMIC_RELEASE, "agent");
            asm volatile("s_waitcnt vmcnt(0)" ::: "memory");
            const unsigned og = xb_add(&bar[XB_TOP], 1u);
            const unsigned tg = og / nx;
            if (og + 1u == (tg + 1u) * nx) xb_add(&bar[XB_TOPGEN], 1u);
            else XB_SPIN(xb_ld(&bar[XB_TOPGEN]) == tg, bar);
            __builtin_amdgcn_fence(__ATOMIC_ACQUIRE, "agent");
            xb_add(&bar[XB_XGEN(b.x)], 1u);
            asm volatile("s_waitcnt vmcnt(0)" ::: "memory");
        } else {
            XB_SPIN(xb_ld(&bar[XB_XGEN(b.x)]) == gen, bar);
            __builtin_amdgcn_fence(__ATOMIC_ACQUIRE, "agent");
            asm volatile("s_waitcnt vmcnt(0)" ::: "memory");
        }
    }
    __syncthreads();
}

struct Params {
  const float* in[28]; float* out; unsigned char* ws; int ph_lo, ph_hi, li, pad;
};

__device__ __forceinline__ void tr_item(const float* W, int ldn, int k0, int nsrc0, int nvalid, bf16* WT, int K, int dstrow0, LAS float* scr, int lane) {
#pragma unroll 8
  for (int i = 0; i < 32; ++i) { const int kk = 2 * i + (lane >> 5), c = lane & 31; scr[kk * 33 + c] = (c < nvalid) ? W[(size_t)(k0 + kk) * ldn + nsrc0 + c] : 0.f; }
  asm volatile("s_waitcnt lgkmcnt(0)" ::: "memory");
  const int c = lane & 7;
#pragma unroll
  for (int j = 0; j < 4; ++j) { const int n = (lane >> 3) + 8 * j; const LAS float* s = scr + (8 * c) * 33 + n;
    v4u o; o.x = pk2(s[0 * 33], s[1 * 33]); o.y = pk2(s[2 * 33], s[3 * 33]); o.z = pk2(s[4 * 33], s[5 * 33]); o.w = pk2(s[6 * 33], s[7 * 33]);
    *(v4u*)(WT + (size_t)(dstrow0 + n) * K + k0 + 8 * c) = o; }
  asm volatile("s_waitcnt lgkmcnt(0)" ::: "memory");
}
__device__ __forceinline__ void proj_src(int c, int& src, int& nv) {
  const int pn = c >> 8, bj = (c >> 7) & 1, wc = (c >> 5) & 3, grp = 4 * pn + wc, dim0 = 32 * bj;
  if (grp < 20) { src = grp * 64 + dim0; nv = 32; } else if (grp == 20) { src = 1280 + dim0; nv = bj == 0 ? 24 : 0; } else if (grp < 49) { src = 1304 + (grp - 21) * 64 + dim0; nv = 32; } else { src = 0; nv = 0; }
}
__device__ __forceinline__ void rms_row_to_bf16(const float* xrow, const float* g, bf16* orow, int lane) {
  const f32x4* xr = (const f32x4*)xrow + lane; const f32x4* gr = (const f32x4*)g + lane;
  f32x4 v[4]; float s = 0.f;
#pragma unroll
  for (int j = 0; j < 4; ++j) { v[j] = xr[64 * j]; s += (v[j].x * v[j].x + v[j].y * v[j].y) + (v[j].z * v[j].z + v[j].w * v[j].w); }
  const float r = rsqrtf(wsum(s) * (1.f / D_) + 1e-6f);
  unsigned long long* o8 = (unsigned long long*)orow + lane;
#pragma unroll
  for (int j = 0; j < 4; ++j) { const f32x4 gg = gr[64 * j]; o8[64 * j] = (unsigned long long)pk2(v[j].x * r * gg.x, v[j].y * r * gg.y) | ((unsigned long long)pk2(v[j].z * r * gg.z, v[j].w * r * gg.w) << 32); }
}

__device__ __forceinline__ void phase_prologue(const Params& p, LAS unsigned char* lds, int wave, int lane) {
  LAS float* scr = (LAS float*)(lds + wave * 16384);
  const int gw = blockIdx.x * NWAVES + wave, NGW = gridDim.x * NWAVES;
  const float* w_in = p.in[2]; const float* w_out = p.in[22]; const float* ffn_up = p.in[24]; const float* ffn_down = p.in[27];
  bf16* WIN = (bf16*)(p.ws + WS_WIN); bf16* WOUT = (bf16*)(p.ws + WS_WOUT); bf16* WUP = (bf16*)(p.ws + WS_WUP); bf16* WDN = (bf16*)(p.ws + WS_WDN);
  constexpr int I_IN = 16 * (NPROJ / 32), I_OUT = 16 * 32, I_UP = 16 * (2 * DFF / 32), I_DN = 44 * 32, NITEMS = I_IN + I_OUT + I_UP + I_DN;
  for (int it = gw; it < NITEMS; it += NGW) {
    int r = it;
    if (r < I_IN) { const int nr = NPROJ / 32, kb = r / nr, run = r % nr; int src, nv; proj_src(32 * run, src, nv); tr_item(w_in, DIN, 64 * kb, src, nv, WIN, D_, 32 * run, scr, lane); continue; } r -= I_IN;
    if (r < I_OUT) { const int kb = r / 32, run = r % 32; tr_item(w_out, D_, 64 * kb, 32 * run, 32, WOUT, D_, 32 * run, scr, lane); continue; } r -= I_OUT;
    if (r < I_UP) { const int nr = 2 * DFF / 32, kb = r / nr, run = r % nr; const int c = 32 * run, hh = c / NUPH, w = c % NUPH; const int src = (w < 1408) ? hh * 1408 + w : DFF + hh * 1408 + (w - 1408);
      tr_item(ffn_up, 2 * DFF, 64 * kb, src, 32, WUP, D_, c, scr, lane); continue; } r -= I_UP;
    { const int kb = r / 32, run = r % 32; tr_item(ffn_down, D_, 64 * kb, 32 * run, 32, WDN, DFF, 32 * run, scr, lane); }
  }
  { bf16* LW = (bf16*)(p.ws + WS_LORAW); const float* w2 = p.in[13]; const float* a2 = p.in[15]; const float* g2 = p.in[16];
    for (int i = blockIdx.x * NTHREADS + threadIdx.x; i < NLORA * KLORA; i += gridDim.x * NTHREADS) { const int n = i >> 8, k = i & 255; float v = 0.f;
      if (n < 512) { if (k < 64) v = w2[k * 512 + n]; } else if (n < 1024) { if (k >= 64 && k < 128) v = a2[(k - 64) * 512 + n - 512]; } else { if (k >= 128) v = g2[(k - 128) * 512 + n - 1024]; }
      LW[i] = (bf16)f2bf(v); } }
  { float* b1p = (float*)(p.ws + WS_B1P); const float* pos = p.in[5]; const float* w1 = p.in[6]; const float* b1 = p.in[7];
    for (int o = gw; o < 256; o += NGW) { const int kv = o >> 7, j = o & 127; float s = 0.f;
      for (int k = lane; k < 2048; k += 64) s += pos[kv * 2048 + k] * w1[((size_t)kv * 2048 + k) * 128 + j];
      s = wsum(s); if (lane == 0) b1p[o] = s + b1[o]; } }
  { const float* x = p.in[0]; const float* g = p.in[1]; bf16* XN = (bf16*)(p.ws + WS_XN);
    for (int m = gw; m < M_; m += NGW) rms_row_to_bf16(x + (size_t)m * D_, g, XN + (size_t)m * D_, lane); }
}

__device__ __forceinline__ void phase_mid(const Params& p, LAS unsigned char* lds, int wave, int lane) {
  const int tid = threadIdx.x;
  {
    LAS bf16* blk = (LAS bf16*)lds;
    LAS float* part = (LAS float*)(lds + 36864);
    LAS float* hid = (LAS float*)(lds + 36864 + 32768);
    const float* w1 = p.in[6]; const float* w2 = p.in[8]; const float* b2 = p.in[9]; const float* kg0 = p.in[4]; const float* b1p = (const float*)(p.ws + WS_B1P);
    bf16* CMP = (bf16*)(p.ws + WS_CMP);
    for (int it = blockIdx.x; it < 256; it += gridDim.x) {
      const int kv = it >> 7, slab = (it >> 5) & 3, ct = it & 31, c0 = ct * 16;
      const bf16* src = (const bf16*)(p.ws + WS_SLAB) + ((size_t)kv * 4 + slab) * (8192 * 64) + (size_t)c0 * 16 * 64;
      const int ntok = (c0 * 16 + 272 <= 8192) ? 272 : 8192 - c0 * 16;
      for (int i = tid; i < 272 * 8; i += NTHREADS) { v4u v = {0u, 0u, 0u, 0u}; if ((i >> 3) < ntok) v = *(const v4u*)(src + (size_t)i * 8); *(LAS v4u*)(blk + i * 8) = v; }
      __syncthreads();
      { const int j = tid & 127, kq = tid >> 7; float acc[16];
#pragma unroll
        for (int c = 0; c < 16; ++c) acc[c] = 0.f;
        const float* w = w1 + ((size_t)kv * 2048 + kq * 512) * 128 + j;
        for (int k = 0; k < 512; ++k) { const float wv = w[(size_t)k * 128];
#pragma unroll
          for (int c = 0; c < 16; ++c) acc[c] += bf2f(blk[c * 1024 + kq * 512 + k]) * wv; }
#pragma unroll
        for (int c = 0; c < 16; ++c) part[(kq * 16 + c) * 128 + j] = acc[c]; }
      __syncthreads();
      for (int i = tid; i < 16 * 128; i += NTHREADS) { const int j = i & 127; const float s = b1p[kv * 128 + j] + ((part[i] + part[2048 + i]) + (part[4096 + i] + part[6144 + i])); hid[i] = gelu_tanh(s); }
      __syncthreads();
#pragma unroll
      for (int cc = 0; cc < 2; ++cc) { const int c = wave * 2 + cc; float o = b2[kv * 64 + lane];
        for (int k = 0; k < 128; ++k) o += hid[c * 128 + k] * w2[((size_t)kv * 128 + k) * 64 + lane];
        if (kv == 0) { const float ss = wsum(o * o); o = o * rsqrtf(ss * (1.f / 64.f) + 1e-6f) * kg0[lane]; }
        CMP[(((size_t)kv * 4 + slab) * 512 + c0 + c) * 64 + lane] = (c0 + c < 511) ? (bf16)f2bf(o) : (bf16)0; }
      __syncthreads();
    }
  }
  {
    const bf16* RW = (const bf16*)(p.ws + WS_RW); bf16* ACT = (bf16*)(p.ws + WS_ACT); const float* mu = p.in[11];
    const int gw = blockIdx.x * NWAVES + wave, NGW = gridDim.x * NWAVES;
    for (int m = gw; m < M_; m += NGW) {
      const int t = m & (T_ - 1); const bf16* cur = RW + (size_t)m * 1792 + 1536 + lane * 4; float o[4];
#pragma unroll
      for (int i = 0; i < 4; ++i) { const float c = bf2f(cur[i]); const float pv = t > 0 ? bf2f(cur[i - 1792]) : 0.f; const float v = c + (pv - c) * mu[1536 + lane * 4 + i];
        o[i] = (lane < 16) ? tanhf(v) : (lane < 32) ? v : sigm(v); }
      *(unsigned long long*)(ACT + (size_t)m * 256 + lane * 4) = (unsigned long long)pk2(o[0], o[1]) | ((unsigned long long)pk2(o[2], o[3]) << 32);
    }
  }
}

__device__ __forceinline__ rwkv::Tensors rwkv_tensors(const Params& p) {
  const size_t CB = (size_t)16 * 128 * 4096; bf16* CH = (bf16*)p.out;
  rwkv::Tensors T{(const bf16*)(p.ws + WS_RW), (const bf16*)(p.ws + WS_LORA), p.in[11], p.in[12], p.in[14], p.in[17], p.in[18], p.in[19], p.in[20], p.in[21],
                  CH, CH + CB, CH + 2 * CB, CH + 3 * CB, (bf16*)(p.ws + WS_HT), (float*)(p.ws + WS_PC), (bf16*)(p.ws + WS_MIX)};
  return T;
}
__device__ __forceinline__ void phase_p1(const Params& p, LAS unsigned char* lds) {
  const rwkv::Tensors T = rwkv_tensors(p);
  for (int it = blockIdx.x; it < 16 * 128; it += gridDim.x) rwkv::p1_item(T, it >> 7, it & 127, lds);
}
__device__ __forceinline__ void phase_attn(const Params& p, LAS unsigned char* lds, int wave, int lane, int rep) {
  if (blockIdx.x < 16) {
    if (wave < 4) { const rwkv::Tensors T = rwkv_tensors(p); rwkv::scan_head(T, blockIdx.x, wave, lane); }
    __syncthreads();
  }
  const bf16* SL = (const bf16*)(p.ws + WS_SLAB); const size_t SS = (size_t)4 * 8192 * 64;
  nsa::Tensors T{(const bf16*)(p.ws + WS_Q), SL + 2 * SS, SL + 3 * SS, SL + 4 * SS, SL + 5 * SS, (const bf16*)(p.ws + WS_CMP), (const bf16*)(p.ws + WS_CMP) + (size_t)4 * 512 * 64,
                 (const float*)(p.ws + WS_GATES), p.in[10], (bf16*)(p.ws + WS_MIX)};
  unsigned* ctr = (unsigned*)(p.ws + WS_CTL) + rep;
  LAS unsigned* nxt = (LAS unsigned*)(lds + nsa::L_BYTES);
  for (;;) {
    if (threadIdx.x == 0) *nxt = atomicAdd(ctr, 1u);
    __syncthreads();
    const unsigned i = (unsigned)__builtin_amdgcn_readfirstlane((int)*nxt);
    __syncthreads();
    if (i >= 512u) break;
    nsa::unit(T, (int)(i & 1u), (int)((i >> 1) & 1u), 127 - (int)(i >> 2), lds);
  }
}
__device__ __forceinline__ void phase_p2(const Params& p, int wave, int lane) {
  const rwkv::Tensors T = rwkv_tensors(p);
  const int gw = blockIdx.x * NWAVES + wave, NGW = gridDim.x * NWAVES;
  for (int w = gw; w < 16 * 128 * 4; w += NGW) rwkv::p2_item(T, w >> 9, (w >> 2) & 127, w & 3, lane);
}

__device__ __forceinline__ void phase_rms2(const Params& p, int wave, int lane) {
  const int gw = blockIdx.x * NWAVES + wave, NGW = gridDim.x * NWAVES; bf16* XN = (bf16*)(p.ws + WS_XN);
  for (int m = gw; m < M_; m += NGW) rms_row_to_bf16(p.out + (size_t)m * D_, p.in[23], XN + (size_t)m * D_, lane);
}
__device__ __forceinline__ void phase_convgate(const Params& p, int hh) {
  const bf16* U = (const bf16*)(p.ws + WS_U); bf16* ACT2 = (bf16*)(p.ws + WS_ACT2); const float* cw = p.in[25]; const float* cb = p.in[26];
  const long total = (long)M_ * 176;
  for (long it = (long)blockIdx.x * NTHREADS + threadIdx.x; it < total; it += (long)gridDim.x * NTHREADS) {
    const int m = (int)(it / 176), i0 = (int)(it % 176) * 8, t = m & (T_ - 1), j0 = hh * 1408 + i0;
    float uv[8], ug[8];
#pragma unroll
    for (int i = 0; i < 8; ++i) { uv[i] = cb[j0 + i]; ug[i] = cb[DFF + j0 + i]; }
#pragma unroll
    for (int k = 0; k < 3; ++k) { if (t - 2 + k < 0) continue;
      const bf16* ur = U + (size_t)(m - 2 + k) * NUPH + i0; const v4u a = *(const v4u*)ur, g = *(const v4u*)(ur + 1408);
      const unsigned aw[4] = {a.x, a.y, a.z, a.w}, gw[4] = {g.x, g.y, g.z, g.w};
#pragma unroll
      for (int i = 0; i < 8; ++i) { const float av = __uint_as_float((i & 1) ? (aw[i >> 1] & 0xffff0000u) : (aw[i >> 1] << 16)); const float gv = __uint_as_float((i & 1) ? (gw[i >> 1] & 0xffff0000u) : (gw[i >> 1] << 16));
        uv[i] += av * cw[k * 2 * DFF + j0 + i]; ug[i] += gv * cw[k * 2 * DFF + DFF + j0 + i]; } }
    v4u o; float r[8];
#pragma unroll
    for (int i = 0; i < 8; ++i) r[i] = ug[i] * sigm(ug[i]) * uv[i];
    o.x = pk2(r[0], r[1]); o.y = pk2(r[2], r[3]); o.z = pk2(r[4], r[5]); o.w = pk2(r[6], r[7]);
    *(v4u*)(ACT2 + (size_t)m * DFF + j0) = o;
  }
}

constexpr int NPHASE = 14;
#ifndef REP_MASK
#define REP_MASK 0u
#endif
__global__ void __launch_bounds__(NTHREADS, 2) mk_fwd(Params p) {
  extern __shared__ __attribute__((aligned(16))) unsigned char lds_raw[];
  LAS unsigned char* lds = (LAS unsigned char*)lds_raw;
  const int tid = threadIdx.x, lane = tid & 63, wave = __builtin_amdgcn_readfirstlane(tid >> 6);
  cg::grid_group grid = cg::this_grid();
  volatile LAS unsigned* bst = (volatile LAS unsigned*)(lds + LDS_BYTES - 64);
  if (tid < 16) bst[tid] = 0u;
  __syncthreads();
  XcdBarrier xbar = xcd_barrier_post((unsigned*)(p.ws + WS_CTL) + 1024 + p.li * XCD_BAR_WORDS, bst);
  const int lo = p.ph_lo, hi = p.ph_hi;
#define IN(k) (lo <= (k) && (k) < hi)
#define SEAM(k) do { if (IN(k) && IN((k) + 1)) { if ((k) == 0) grid.sync(); else xcd_barrier(xbar); } } while (0)
  unsigned char* ws = p.ws;
#define PH(k, ...) do { if (IN(k)) { _Pragma("unroll 1") for (int rep_ = 0; rep_ < 1 + (int)((REP_MASK >> (k)) & 1u); ++rep_) { if (rep_) grid.sync(); __VA_ARGS__ } } SEAM(k); } while (0)
  PH(0, { phase_prologue(p, lds, wave, lane); });
  PH(1, { pg8::Gemm g{(const pg8::bf16_t*)(ws + WS_XN), (const pg8::bf16_t*)(ws + WS_WIN), M_, NPROJ, D_}; pg8::StaticOrder S; S.init(M_, NPROJ, gridDim.x, blockIdx.x);
    pg8::EpiProj E{(pg8::bf16_t*)(ws + WS_Q), (pg8::bf16_t*)(ws + WS_SLAB), (pg8::bf16_t*)(ws + WS_RW), (float*)(ws + WS_GATES), p.in[3], p.in[4]};
    pg8::gemm_phase<pg8::EpiProj, pg8::StaticOrder, true, true>(lds, g, S, E); });
  PH(2, { phase_mid(p, lds, wave, lane); });
  PH(3, { pg8::Gemm g{(const pg8::bf16_t*)(ws + WS_ACT), (const pg8::bf16_t*)(ws + WS_LORAW), M_, NLORA, KLORA}; pg8::StaticOrder S; S.init(M_, NLORA, gridDim.x, blockIdx.x);
    pg8::EpiBf16<0> E{(pg8::bf16_t*)(ws + WS_LORA), NLORA, nullptr, 0, 0, 1.f};
    pg8::gemm_phase<pg8::EpiBf16<0>, pg8::StaticOrder, true, true>(lds, g, S, E); });
  PH(4, { phase_p1(p, lds); });
  PH(5, { phase_attn(p, lds, wave, lane, rep_); });
  PH(6, { phase_p2(p, wave, lane); });
  PH(7, { pg8::Gemm g{(const pg8::bf16_t*)(ws + WS_MIX), (const pg8::bf16_t*)(ws + WS_WOUT), M_, D_, D_}; pg8::StaticOrder S; S.init(M_, D_, gridDim.x, blockIdx.x);
    pg8::EpiResF32 E{p.in[0], p.out, D_};
    pg8::gemm_phase<pg8::EpiResF32, pg8::StaticOrder, true, true>(lds, g, S, E); });
  PH(8, { phase_rms2(p, wave, lane); });
#pragma unroll 1
  for (int hh = 0; hh < 2; ++hh) {
    PH(9 + 2 * hh, { pg8::Gemm g{(const pg8::bf16_t*)(ws + WS_XN), (const pg8::bf16_t*)(ws + WS_WUP) + (size_t)hh * NUPH * D_, M_, NUPH, D_}; pg8::StaticOrder S; S.init(M_, NUPH, gridDim.x, blockIdx.x);
      pg8::EpiBf16<0> E{(pg8::bf16_t*)(ws + WS_U), NUPH, nullptr, 0, 0, 1.f};
      pg8::gemm_phase<pg8::EpiBf16<0>, pg8::StaticOrder, true, true>(lds, g, S, E); });
    PH(10 + 2 * hh, { phase_convgate(p, hh); });
  }
  if (IN(13)) { pg8::Gemm g{(const pg8::bf16_t*)(ws + WS_ACT2), (const pg8::bf16_t*)(ws + WS_WDN), M_, D_, DFF}; pg8::StaticOrder S; S.init(M_, D_, gridDim.x, blockIdx.x);
    pg8::EpiResF32 E{p.out, p.out, D_};
    pg8::gemm_phase<pg8::EpiResF32, pg8::StaticOrder, true, true>(lds, g, S, E); }
#undef PH
#undef IN
#undef SEAM
}
}

#ifndef MK_N_LAUNCHES
#define MK_N_LAUNCHES 1
#endif
extern "C" void kernel_launch(void* const* d_in, const int* in_sizes, int n_in, void* d_out, int out_size, void* d_ws, size_t ws_size, hipStream_t stream) {
  static int grid = 0;
  if (grid == 0) {
    if (n_in != 28 || out_size != M_ * D_ || ws_size < WS_END) { fprintf(stderr, "kernel_launch: unexpected shapes (n_in %d out %d ws %zu)\n", n_in, out_size, ws_size); grid = -1; return; }
    int dev = 0, cus = 0, per_cu = 0; hipGetDevice(&dev); hipDeviceGetAttribute(&cus, hipDeviceAttributeMultiprocessorCount, dev);
    if (hipFuncSetAttribute((const void*)mk_fwd, hipFuncAttributeMaxDynamicSharedMemorySize, LDS_BYTES) != hipSuccess) { fprintf(stderr, "kernel_launch: hipFuncSetAttribute failed\n"); grid = -1; return; }
    if (hipOccupancyMaxActiveBlocksPerMultiprocessor(&per_cu, (const void*)mk_fwd, NTHREADS, LDS_BYTES) != hipSuccess || per_cu < 1) { fprintf(stderr, "kernel_launch: occupancy query says %d\n", per_cu); (void)hipGetLastError(); per_cu = 1; }
    grid = cus;
    fprintf(stderr, "kernel_launch: cus %d per_cu %d grid %d\n", cus, per_cu, grid);
  }
  if (grid < 0) return;
  Params p{};
  for (int i = 0; i < 28; ++i) p.in[i] = (const float*)d_in[i];
  p.out = (float*)d_out; p.ws = (unsigned char*)d_ws;
#ifndef PROBE_PHASE
#define PROBE_PHASE -1
#endif
  if (hipMemsetAsync((char*)d_ws + WS_CTL, 0, 65536, stream) != hipSuccess) { fprintf(stderr, "kernel_launch: memset failed\n"); return; }
  const int nl = (PROBE_PHASE >= 0) ? 3 : MK_N_LAUNCHES;
  for (int li = 0; li < nl; ++li) {
    if (PROBE_PHASE >= 0) { p.ph_lo = li == 0 ? 0 : (li == 1 ? PROBE_PHASE : PROBE_PHASE + 1); p.ph_hi = li == 0 ? PROBE_PHASE + 1 : (li == 1 ? PROBE_PHASE + 1 : NPHASE); if (p.ph_lo >= p.ph_hi) continue; }
    else { p.ph_lo = (MK_N_LAUNCHES == 1) ? 0 : li; p.ph_hi = (MK_N_LAUNCHES == 1) ? NPHASE : li + 1; }
    p.li = li; void* args[] = {&p};
    hipError_t e = hipLaunchCooperativeKernel((const void*)mk_fwd, dim3(grid), dim3(NTHREADS), args, LDS_BYTES, stream);
    if (e != hipSuccess) { fprintf(stderr, "kernel_launch: cooperative launch %d failed: %s\n", li, hipGetErrorString(e)); break; }
  }
}
```

```cpp
#include <hip/hip_runtime.h>
#include <hip/hip_cooperative_groups.h>
#include <cstdio>
#include <cstdint>
namespace cg = cooperative_groups;

#define MK_LAS __attribute__((address_space(3)))
constexpr int MK_TIDTAB = 147456 - 512;
__device__ __forceinline__ int mk_slot() { return (int)(__builtin_amdgcn_s_getreg((5 << 11) | 4) & 63u); }
__device__ __forceinline__ void mk_tid_init() { if ((threadIdx.x & 63u) == 0u) *(volatile MK_LAS int*)(MK_TIDTAB + 4 * mk_slot()) = (int)(threadIdx.x >> 6); }
__device__ __forceinline__ int mk_tid() { const int w = __builtin_amdgcn_readfirstlane(*(volatile MK_LAS int*)(MK_TIDTAB + 4 * mk_slot())); int l; asm volatile("v_mbcnt_lo_u32_b32 %0, -1, 0\n\tv_mbcnt_hi_u32_b32 %0, -1, %0" : "=v"(l)); return w * 64 + l; }
namespace pg8 {
#define PG8_LAS __attribute__((address_space(3)))
typedef unsigned short bf16_t;
typedef short bf16x8 __attribute__((ext_vector_type(8)));
typedef float f32x4 __attribute__((ext_vector_type(4)));
typedef unsigned u32x4 __attribute__((ext_vector_type(4)));
constexpr int BM = 256, BK = 64, HALF = 128, HTB = HALF * BK * 2  , STAGE_BYTES = 8 * HTB, NXCD = 8, WGM = 8;

__host__ __device__ __forceinline__ int lds_byte(int r, int c) { const int st = (r >> 4) * 2 + (c >> 5), rr = r & 15, cc = c & 31, ob = rr * 64 + cc * 2; return st * 1024 + (ob ^ (((ob >> 9) & 1) << 5)); }
__host__ __device__ __forceinline__ void stage_rc(int b, int& R, int& C) { const int st = b / 1024, sb = b % 1024, swz = sb ^ (((sb >> 9) & 1) << 5); R = (st >> 1) * 16 + swz / 64; C = (st & 1) * 32 + (swz % 64) / 2; }
__host__ __device__ __forceinline__ int perm32(int rho) { const int n = rho >> 4, i = rho & 15; return 8 * (i >> 2) + 4 * n + (i & 3); }

struct Unit { int pm, pn; };
struct Gemm { const bf16_t* A; const bf16_t* Bt; int M, N, K; };

struct StaticOrder {
    int nM, nN, nwg, G, c;
    __host__ __device__ void init(int M, int N, int G_, int c_) { nM = M / BM; nN = N / BM; nwg = nM * nN; G = G_; c = c_; }
    __host__ __device__ bool next(int i, Unit& u) const {
        const long L = (long)i * G + c; if (L >= nwg) return false;
        int wgid = (int)L; { const int q = nwg / NXCD, r = nwg % NXCD, xcd = wgid % NXCD, off = wgid / NXCD; wgid = (xcd < r ? xcd * (q + 1) : r * (q + 1) + (xcd - r) * q) + off; }
        const int nig = WGM * nN, gid = wgid / nig, fm = gid * WGM, gsz = (nM - fm) < WGM ? (nM - fm) : WGM;
        u.pm = fm + ((wgid % nig) % gsz); u.pn = (wgid % nig) / gsz; return true;
    }
    __device__ __forceinline__ void a_ready(const Unit&) const {}
    __device__ __forceinline__ void done(const Unit&) const {}
};

__device__ __forceinline__ unsigned cvt_pk_bf16(float lo, float hi) { unsigned r; asm volatile("v_cvt_pk_bf16_f32 %0, %1, %2" : "=v"(r) : "v"(lo), "v"(hi)); return r; }
typedef float f32x2 __attribute__((ext_vector_type(2)));
__device__ __forceinline__ f32x2 gelu_pk(f32x2 v) {
    const f32x2 av = __builtin_elementwise_abs(v), d = av * 0.2316418882f + 1.0f;
    f32x2 t; t.x = __builtin_amdgcn_rcpf(d.x); t.y = __builtin_amdgcn_rcpf(d.y);
    f32x2 q = t * 0.5307027145f + (-0.7265760135f); q = q * t + 0.7107068705f; q = q * t + (-0.142248368f); q = q * t + 0.127414796f; q = q * t;
    const f32x2 s = (v * v) * (-0.72134752044f);
    f32x2 e; e.x = __builtin_amdgcn_exp2f(s.x); e.y = __builtin_amdgcn_exp2f(s.y);
    const f32x2 m = v * (q * e), r = v - m;
    f32x2 o; o.x = v.x < 0.f ? m.x : r.x; o.y = v.y < 0.f ? m.y : r.y; return o;
}

template <int ACT  > struct EpiBf16 {
    static constexpr bool PERM = true, AFTER_DRAIN = false; static_assert(ACT == 0 || ACT == 1, "EpiBf16: ACT is 0 (none) or 1 (gelu_pk)");
    bf16_t* O; int ldc; const float* bias; int split_cols; size_t split_stride; float scale0;
    __device__ __forceinline__ void operator()(const f32x4 (&acc)[2][2][4][2], const Unit& u, int wr, int wc, int fr, int fq) const {
        const int row0 = u.pm * BM + wr * 64 + fr; int colt = u.pn * BM; bf16_t* base = O;
        float sc = 1.f; if (split_cols) { const int t = colt / split_cols; base += (size_t)t * split_stride; colt -= t * split_cols; if (t == 0) sc = scale0; }
        const int col0 = colt + wc * 32 + 8 * fq, bcol0 = u.pn * BM + wc * 32 + 8 * fq;
        f32x4 bv[2][2];
#pragma unroll
        for (int bj = 0; bj < 2; ++bj)
#pragma unroll
            for (int n = 0; n < 2; ++n) bv[bj][n] = bias ? *(const f32x4*)(bias + bcol0 + bj * HALF + 4 * n) : (f32x4){0.f, 0.f, 0.f, 0.f};
#pragma unroll
        for (int ai = 0; ai < 2; ++ai)
#pragma unroll
            for (int m = 0; m < 4; ++m) { bf16_t* rowp = base + (size_t)(row0 + ai * HALF + m * 16) * ldc + col0;
#pragma unroll
                for (int bj = 0; bj < 2; ++bj) { f32x4 v0 = acc[ai][bj][m][0] + bv[bj][0], v1 = acc[ai][bj][m][1] + bv[bj][1];
                    if (ACT == 1) { f32x2 a = gelu_pk((f32x2){v0[0], v0[1]}), b = gelu_pk((f32x2){v0[2], v0[3]}), c = gelu_pk((f32x2){v1[0], v1[1]}), d = gelu_pk((f32x2){v1[2], v1[3]});
                        v0 = (f32x4){a.x, a.y, b.x, b.y}; v1 = (f32x4){c.x, c.y, d.x, d.y}; }
                    v0 = v0 * sc; v1 = v1 * sc; u32x4 w; w.x = cvt_pk_bf16(v0[0], v0[1]); w.y = cvt_pk_bf16(v0[2], v0[3]); w.z = cvt_pk_bf16(v1[0], v1[1]); w.w = cvt_pk_bf16(v1[2], v1[3]);
                    *(u32x4*)(rowp + bj * HALF) = w; } }
    }
};
struct EpiResF32 {
    static constexpr bool PERM = false, AFTER_DRAIN = false;
    const float* base; float* out; int ldc;
    __device__ __forceinline__ void operator()(const f32x4 (&acc)[2][2][4][2], const Unit& u, int wr, int wc, int fr, int fq) const {
        const int row0 = u.pm * BM + wr * 64 + fr, col0 = u.pn * BM + wc * 32 + 4 * fq;
#pragma unroll
        for (int ai = 0; ai < 2; ++ai)
#pragma unroll
            for (int m = 0; m < 4; ++m) { const size_t off = (size_t)(row0 + ai * HALF + m * 16) * ldc + col0;
#pragma unroll
                for (int bj = 0; bj < 2; ++bj)
#pragma unroll
                    for (int n = 0; n < 2; ++n) { const f32x4 b = *(const f32x4*)(base + off + bj * HALF + n * 16); *(f32x4*)(out + off + bj * HALF + n * 16) = b + acc[ai][bj][m][n]; } }
    }
};
struct EpiConvGate {
    static constexpr bool PERM = true, AFTER_DRAIN = false;
    bf16_t* ACT2; const float* cw; const float* cb;
    __device__ __forceinline__ void operator()(f32x4 (&acc)[2][2][4][2], const Unit& u, int wr, int wc, int fr, int fq) const {
        const int b = u.pm / 33, it = u.pm % 33, tb = it * 252 - 2 + wr * 126 + fr * 8, j0 = 128 * u.pn + 32 * wc + 8 * fq;
        if (tb < 0) {
#pragma unroll
            for (int bj = 0; bj < 2; ++bj)
#pragma unroll
                for (int n = 0; n < 2; ++n) { acc[0][bj][0][n] = (f32x4){0.f, 0.f, 0.f, 0.f}; acc[0][bj][1][n] = (f32x4){0.f, 0.f, 0.f, 0.f}; } }
#pragma unroll
        for (int n = 0; n < 2; ++n) {
            const f32x4 bv = *(const f32x4*)(cb + j0 + 4 * n), bg = *(const f32x4*)(cb + 2816 + j0 + 4 * n);
            f32x4 wv[3], wg[3];
#pragma unroll
            for (int k = 0; k < 3; ++k) { wv[k] = *(const f32x4*)(cw + k * 5632 + j0 + 4 * n); wg[k] = *(const f32x4*)(cw + k * 5632 + 2816 + j0 + 4 * n); }
            f32x4 hv[2], hg[2];
#pragma unroll
            for (int e = 0; e < 4; ++e) {
                hv[0][e] = __int_as_float(__builtin_amdgcn_update_dpp(0, __float_as_int(acc[1][0][2][n][e]), 0x111, 0xf, 0xf, false));
                hv[1][e] = __int_as_float(__builtin_amdgcn_update_dpp(0, __float_as_int(acc[1][0][3][n][e]), 0x111, 0xf, 0xf, false));
                hg[0][e] = __int_as_float(__builtin_amdgcn_update_dpp(0, __float_as_int(acc[1][1][2][n][e]), 0x111, 0xf, 0xf, false));
                hg[1][e] = __int_as_float(__builtin_amdgcn_update_dpp(0, __float_as_int(acc[1][1][3][n][e]), 0x111, 0xf, 0xf, false)); }
#pragma unroll
            for (int o = 0; o < 8; ++o) {
                const int t = tb + o; const bool ok = (o >= 2 || fr > 0) && t >= 0 && t < 8192;
                const f32x4 v2 = (o >= 2) ? acc[(o - 2) >> 2][0][(o - 2) & 3][n] : hv[o & 1], v1 = (o >= 1) ? acc[(o - 1) >> 2][0][(o - 1) & 3][n] : hv[1], v0 = acc[o >> 2][0][o & 3][n];
                const f32x4 g2 = (o >= 2) ? acc[(o - 2) >> 2][1][(o - 2) & 3][n] : hg[o & 1], g1 = (o >= 1) ? acc[(o - 1) >> 2][1][(o - 1) & 3][n] : hg[1], g0 = acc[o >> 2][1][o & 3][n];
                const f32x4 uv = bv + wv[0] * v2 + wv[1] * v1 + wv[2] * v0, ug = bg + wg[0] * g2 + wg[1] * g1 + wg[2] * g0;
                float r[4];
#pragma unroll
                for (int e = 0; e < 4; ++e) r[e] = ug[e] * __builtin_amdgcn_rcpf(1.f + __expf(-ug[e])) * uv[e];
                unsigned long long w = (unsigned long long)cvt_pk_bf16(r[0], r[1]) | ((unsigned long long)cvt_pk_bf16(r[2], r[3]) << 32);
                if (ok) *(unsigned long long*)(ACT2 + ((size_t)b * 8192 + t) * 2816 + j0 + 4 * n) = w;
            }
        }
    }
};
struct EpiProj {
    static constexpr bool PERM = true, AFTER_DRAIN = false; static constexpr float QS = 0.125f * 1.4426950408889634f;
    bf16_t* Q; bf16_t* SLAB;   bf16_t* RW; float* GATES; const float* qg; const float* kg;
    __device__ __forceinline__ void operator()(const f32x4 (&acc)[2][2][4][2], const Unit& u, int wr, int wc, int fr, int fq) const {
        const int grp = 4 * u.pn + wc;
        if (grp >= 49) return;
        const int row0 = u.pm * BM + wr * 64 + fr, d0 = 8 * fq;
        int kind; const float* g = nullptr;
        if (grp < 8) { kind = 1; g = qg; } else if (grp < 20) { const int which = (grp - 8) >> 1; kind = (which == 2 || which == 4) ? 1 : 0; g = kg + (which == 2 ? 64 : 128); } else if (grp == 20) kind = 2; else kind = 0;
        float gv[16];
        if (kind == 1) {
#pragma unroll
            for (int i = 0; i < 8; ++i) { gv[i] = g[d0 + i]; gv[8 + i] = g[32 + d0 + i]; }
        }
#pragma unroll
        for (int ai = 0; ai < 2; ++ai)
#pragma unroll
            for (int m = 0; m < 4; ++m) {
                const int row = row0 + ai * HALF + m * 16;
                f32x4 v0 = acc[ai][0][m][0], v1 = acc[ai][0][m][1], v2 = acc[ai][1][m][0], v3 = acc[ai][1][m][1];
                if (kind == 2) {
                    if (fq < 3) { float* gp = GATES + (size_t)row * 32 + d0;
                        f32x4 a, b;
#pragma unroll
                        for (int i = 0; i < 4; ++i) { a[i] = 1.f / (1.f + __expf(-v0[i])); b[i] = 1.f / (1.f + __expf(-v1[i])); }
                        *(f32x4*)gp = a; *(f32x4*)(gp + 4) = b; }
                    continue;
                }
                if (kind == 1) {
                    float ss = 0.f;
#pragma unroll
                    for (int i = 0; i < 4; ++i) ss += v0[i] * v0[i] + v1[i] * v1[i] + v2[i] * v2[i] + v3[i] * v3[i];
                    ss += __shfl_xor(ss, 16); ss += __shfl_xor(ss, 32);
                    const float s = rsqrtf(ss * (1.f / 64.f) + 1e-6f);
#pragma unroll
                    for (int i = 0; i < 4; ++i) { v0[i] *= s * gv[i]; v1[i] *= s * gv[4 + i]; v2[i] *= s * gv[8 + i]; v3[i] *= s * gv[12 + i]; }
                    if (grp < 8) { v0 = v0 * QS; v1 = v1 * QS; v2 = v2 * QS; v3 = v3 * QS; }
                }
                bf16_t* p;
                if (grp < 8) p = Q + (size_t)row * 512 + grp * 64;
                else if (grp < 20) { const int sl = grp - 8; p = SLAB + ((size_t)(sl >> 1) * 4 + (size_t)((row >> 13) * 2 + (sl & 1))) * (8192 * 64) + (size_t)(row & 8191) * 64; }
                else p = RW + (size_t)row * 1792 + (grp - 21) * 64;
                u32x4 w0, w1; w0.x = cvt_pk_bf16(v0[0], v0[1]); w0.y = cvt_pk_bf16(v0[2], v0[3]); w0.z = cvt_pk_bf16(v1[0], v1[1]); w0.w = cvt_pk_bf16(v1[2], v1[3]);
                w1.x = cvt_pk_bf16(v2[0], v2[1]); w1.y = cvt_pk_bf16(v2[2], v2[3]); w1.z = cvt_pk_bf16(v3[0], v3[1]); w1.w = cvt_pk_bf16(v3[2], v3[3]);
                *(u32x4*)(p + d0) = w0; *(u32x4*)(p + 32 + d0) = w1;
            }
    }
};
template <class Epi, class Sched, bool ALIGN_EPI = false, bool SP2 = false, int ROWMAP = 0>
__device__ __forceinline__ void gemm_phase(PG8_LAS unsigned char* lds, const Gemm g, const Sched& S, const Epi& E) {
    const int tid = mk_tid(), wid = __builtin_amdgcn_readfirstlane(tid >> 6), lane = tid & 63, wr = wid >> 2, wc = wid & 3, fr = lane & 15, fq = lane >> 4;
    const int K = g.K, nt = K / BK;
    unsigned voffA[2], voffB[2];
#pragma unroll
    for (int i = 0; i < 2; ++i) { int R, C; stage_rc(tid * 16 + i * 8192, R, C); const int Rb = Epi::PERM ? ((R & ~31) + perm32(R & 31)) : R;
        const int Ra = ROWMAP ? ((R >> 6) * 126 + (R & 15) * 8 + ((R >> 4) & 3)) : R;
        voffA[i] = (unsigned)(Ra * K + C) * 2u; voffB[i] = (unsigned)(Rb * K + C) * 2u; }
    const size_t kstep = (size_t)(BK * 2);
    const size_t hstep = (size_t)HALF * K * 2;
    const size_t tstep = 2 * hstep;
    const size_t hstepA = ROWMAP ? (size_t)4 * K * 2 : hstep;
#define PG8_ABASE(pm) (ROWMAP ? ((long)(((pm) / 33) * 8192 + ((pm) % 33) * 252 - 2) * (long)K * 2) : (long)((size_t)(pm) * tstep))
    const unsigned ldsw = (unsigned)wid * 1024u;
    const int aoff = lds_byte(wr * 64 + fr, fq * 8), boff = lds_byte(wc * 32 + fr, fq * 8);
#define PG8_SA(b, h) (((b) * 2 + (h)) * HTB)
#define PG8_SB(b, h) ((4 + (b) * 2 + (h)) * HTB)
#define PG8_STAGE(bufoff, gbase, voff) do { _Pragma("unroll") for (int _i = 0; _i < 2; ++_i) \
        __builtin_amdgcn_global_load_lds((const unsigned*)((const char*)(gbase) + (voff)[_i]), (PG8_LAS unsigned*)(lds + (bufoff) + ldsw + _i * 8192), 16, 0, 0); } while (0)
#define PG8_LDA(dst, b, h) do { _Pragma("unroll") for (int m = 0; m < 4; ++m) _Pragma("unroll") for (int k = 0; k < 2; ++k) dst[m][k] = *(const PG8_LAS bf16x8*)(lds + PG8_SA(b, h) + aoff + m * 2048 + k * 1024); } while (0)
#define PG8_LDB(dst, b, h) do { _Pragma("unroll") for (int n = 0; n < 2; ++n) _Pragma("unroll") for (int k = 0; k < 2; ++k) dst[n][k] = *(const PG8_LAS bf16x8*)(lds + PG8_SB(b, h) + boff + n * 2048 + k * 1024); } while (0)
#define PG8_MMA(ai, bj, At, Bt) do { __builtin_amdgcn_s_setprio(1); _Pragma("unroll") for (int m = 0; m < 4; ++m) _Pragma("unroll") for (int n = 0; n < 2; ++n) _Pragma("unroll") for (int k = 0; k < 2; ++k) \
        acc[ai][bj][m][n] = __builtin_amdgcn_mfma_f32_16x16x32_bf16(Bt[n][k], At[m][k], acc[ai][bj][m][n], 0, 0, 0); __builtin_amdgcn_s_setprio(0); } while (0)
#define PG8_WAIT_V(n) asm volatile("s_waitcnt vmcnt(" #n ")" ::: "memory")
#define PG8_WAIT_L(n) asm volatile("s_waitcnt lgkmcnt(" #n ")" ::: "memory")
#define PG8_BAR __builtin_amdgcn_s_barrier()
#define PG8_SCHED __builtin_amdgcn_sched_barrier(0)
    Unit cur, nxt; int ui = 0;
    if (!S.next(0, cur)) return;
    f32x4 acc[2][2][4][2];
#pragma unroll
    for (int a = 0; a < 2; ++a)
#pragma unroll
        for (int b = 0; b < 2; ++b)
#pragma unroll
            for (int m = 0; m < 4; ++m)
#pragma unroll
                for (int n = 0; n < 2; ++n) acc[a][b][m][n] = (f32x4){0.f, 0.f, 0.f, 0.f};
    bf16x8 At[4][2], B0[2][2], B1[2][2];
    const char* cA = (const char*)g.A + PG8_ABASE(cur.pm); const char* cB = (const char*)g.Bt + (size_t)cur.pn * tstep;
    S.a_ready(cur);
    if constexpr (SP2) {
        PG8_STAGE(PG8_SB(0, 0), cB, voffB); PG8_STAGE(PG8_SB(0, 1), cB + hstep, voffB); PG8_STAGE(PG8_SA(0, 0), cA, voffA); PG8_STAGE(PG8_SA(0, 1), cA + hstepA, voffA);
        if (wr == 1) PG8_BAR;
        PG8_WAIT_V(2); PG8_BAR;
        PG8_STAGE(PG8_SB(1, 0), cB + kstep, voffB); PG8_STAGE(PG8_SA(1, 0), cA + kstep, voffA); PG8_STAGE(PG8_SB(1, 1), cB + hstep + kstep, voffB);
        PG8_WAIT_V(6); PG8_BAR;
    } else {
        PG8_STAGE(PG8_SB(0, 0), cB, voffB); PG8_STAGE(PG8_SA(0, 0), cA, voffA); PG8_STAGE(PG8_SB(0, 1), cB + hstep, voffB); PG8_STAGE(PG8_SA(0, 1), cA + hstepA, voffA);
        if (wr == 1) PG8_BAR;
        PG8_WAIT_V(4); PG8_BAR;
        PG8_STAGE(PG8_SB(1, 0), cB + kstep, voffB); PG8_STAGE(PG8_SA(1, 0), cA + kstep, voffA); PG8_STAGE(PG8_SB(1, 1), cB + hstep + kstep, voffB);
        PG8_WAIT_V(6); PG8_BAR;
    }
    for (;;) {
        const bool has_next = S.next(ui + 1, nxt);
        const char* nA = has_next ? (const char*)g.A + PG8_ABASE(nxt.pm) : cA; const char* nB = has_next ? (const char*)g.Bt + (size_t)nxt.pn * tstep : cB;
        for (int t = 0; t < nt; t += 2) {
            const bool last = (t == nt - 2);
            const char* a1 = cA + (size_t)(t + 1) * kstep;
            const char* a2 = last ? nA : cA + (size_t)(t + 2) * kstep; const char* b2 = last ? nB : cB + (size_t)(t + 2) * kstep;
            const char* a3 = a2 + kstep; const char* b3 = b2 + kstep;
            if (last && has_next) S.a_ready(nxt);
            if constexpr (SP2) {
            PG8_LDB(B0, 0, 0); PG8_LDB(B1, 0, 1); PG8_SCHED; PG8_LDA(At, 0, 0); PG8_STAGE(PG8_SA(1, 1), a1 + hstepA, voffA);
            PG8_WAIT_V(8); PG8_WAIT_L(0); PG8_BAR; PG8_MMA(0, 0, At, B0); PG8_MMA(0, 1, At, B1); PG8_BAR; PG8_SCHED;
            PG8_LDA(At, 0, 1); PG8_STAGE(PG8_SB(0, 0), b2, voffB); PG8_STAGE(PG8_SB(0, 1), b2 + hstep, voffB); PG8_STAGE(PG8_SA(0, 0), a2, voffA);
            PG8_WAIT_V(8); PG8_WAIT_L(0); PG8_BAR; PG8_MMA(1, 0, At, B0); PG8_MMA(1, 1, At, B1); PG8_BAR; PG8_SCHED;
            PG8_LDB(B0, 1, 0); PG8_LDB(B1, 1, 1); PG8_SCHED; PG8_LDA(At, 1, 0); PG8_STAGE(PG8_SA(0, 1), a2 + hstepA, voffA);
            PG8_WAIT_V(8); PG8_WAIT_L(0); PG8_BAR; PG8_MMA(0, 0, At, B0); PG8_MMA(0, 1, At, B1); PG8_BAR; PG8_SCHED;
            PG8_LDA(At, 1, 1); PG8_STAGE(PG8_SB(1, 0), b3, voffB); PG8_STAGE(PG8_SB(1, 1), b3 + hstep, voffB); PG8_STAGE(PG8_SA(1, 0), a3, voffA);
            PG8_WAIT_V(8); PG8_WAIT_L(0); PG8_BAR; PG8_MMA(1, 0, At, B0); PG8_MMA(1, 1, At, B1); PG8_BAR; PG8_SCHED;
            } else {
            PG8_LDB(B0, 0, 0); PG8_SCHED; PG8_LDA(At, 0, 0); PG8_STAGE(PG8_SA(1, 1), a1 + hstepA, voffA);
            PG8_WAIT_L(8); PG8_BAR; PG8_WAIT_L(0); PG8_MMA(0, 0, At, B0); PG8_BAR; PG8_SCHED;
            PG8_LDB(B1, 0, 1); PG8_STAGE(PG8_SB(0, 0), b2, voffB);
            PG8_BAR; PG8_WAIT_L(0); PG8_MMA(0, 1, At, B1); PG8_BAR;
            PG8_LDA(At, 0, 1); PG8_STAGE(PG8_SA(0, 0), a2, voffA);
            PG8_BAR; PG8_WAIT_L(0); PG8_MMA(1, 0, At, B0); PG8_BAR; PG8_SCHED;
            PG8_STAGE(PG8_SB(0, 1), b2 + hstep, voffB);
            PG8_WAIT_V(6); PG8_BAR; PG8_MMA(1, 1, At, B1); PG8_BAR;
            PG8_LDB(B0, 1, 0); PG8_SCHED; PG8_LDA(At, 1, 0); PG8_STAGE(PG8_SA(0, 1), a2 + hstepA, voffA);
            PG8_WAIT_L(8); PG8_BAR; PG8_WAIT_L(0); PG8_MMA(0, 0, At, B0); PG8_BAR; PG8_SCHED;
            PG8_LDB(B1, 1, 1); PG8_STAGE(PG8_SB(1, 0), b3, voffB);
            PG8_BAR; PG8_WAIT_L(0); PG8_MMA(0, 1, At, B1); PG8_BAR;
            PG8_LDA(At, 1, 1); PG8_STAGE(PG8_SA(1, 0), a3, voffA);
            PG8_BAR; PG8_WAIT_L(0); PG8_MMA(1, 0, At, B0); PG8_BAR; PG8_SCHED;
            PG8_STAGE(PG8_SB(1, 1), b3 + hstep, voffB);
            PG8_WAIT_V(6); PG8_BAR; PG8_MMA(1, 1, At, B1); PG8_BAR;
            }
        }
        if constexpr (ALIGN_EPI) { if (wr == 0) PG8_BAR; }
        if constexpr (!Epi::AFTER_DRAIN) { E(acc, cur, wr, wc, fr, fq); S.done(cur); }
        if (!has_next) break;
#pragma unroll
        for (int a = 0; a < 2; ++a)
#pragma unroll
            for (int b = 0; b < 2; ++b)
#pragma unroll
                for (int m = 0; m < 4; ++m)
#pragma unroll
                    for (int n = 0; n < 2; ++n) acc[a][b][m][n] = (f32x4){0.f, 0.f, 0.f, 0.f};
        cur = nxt; cA = nA; cB = nB; ++ui;
        if constexpr (ALIGN_EPI) { if (wr == 1) PG8_BAR; }
    }
    PG8_WAIT_V(0);
    if constexpr (!ALIGN_EPI) { if (wr == 0) PG8_BAR; }
    PG8_BAR;
    if constexpr (Epi::AFTER_DRAIN) { E.fused(acc, cur, wr, wc, fr, fq, lds, wid, lane); S.done(cur); }
#undef PG8_ABASE
#undef PG8_SA
#undef PG8_SB
#undef PG8_STAGE
#undef PG8_LDA
#undef PG8_LDB
#undef PG8_MMA
#undef PG8_WAIT_V
#undef PG8_WAIT_L
#undef PG8_BAR
#undef PG8_SCHED
}
}

namespace nsa {
#define NLAS __attribute__((address_space(3)))
typedef short bf16x8 __attribute__((ext_vector_type(8)));
typedef short s16x4 __attribute__((ext_vector_type(4)));
typedef float f32x16 __attribute__((ext_vector_type(16)));
typedef unsigned u32x4 __attribute__((ext_vector_type(4)));
typedef short v4i16_t __attribute__((ext_vector_type(4)));
typedef unsigned short bf16;
typedef float f32x2_t __attribute__((ext_vector_type(2))); typedef __bf16 bf16x2_t __attribute__((ext_vector_type(2)));

constexpr float LOG2E = 1.4426950408889634f;
constexpr float QSCALE = 0.125f * LOG2E;
constexpr float NEGBIG = -1e30f;
constexpr int L_K = 0, L_V = 16384, L_IMP = 32768, L_SELM = 65536, L_TAB = 66560, L_WSF = 69120, L_OST = 71168, L_BYTES = 136704;
constexpr int TOPN = 16;

struct Tensors { const bf16* Q; const bf16* KS; const bf16* VS; const bf16* KW; const bf16* VW; const bf16* KC; const bf16* VC; const float* gates; const float* rel_bias; bf16* MIX; };

__device__ __forceinline__ int crow(int r, int hi) { return (r & 3) + 8 * (r >> 2) + 4 * hi; }
__device__ __forceinline__ int t5bucket(int n) {
  if (n < 16) return n < 0 ? 0 : n;
  if (n >= 128) return 31;
  int v = 16 + (int)(logf((float)n / 16.f) / 2.0794415416798357f * 16.f);
  return v > 31 ? 31 : v;
}
__device__ __forceinline__ unsigned cvtpk(float lo, float hi) { f32x2_t v = {lo, hi}; bf16x2_t b = __builtin_convertvector(v, bf16x2_t); return __builtin_bit_cast(unsigned, b); }
__device__ __forceinline__ void dma16(const void* g, NLAS unsigned char* l) { __builtin_amdgcn_global_load_lds((const unsigned*)g, (NLAS unsigned*)l, 16, 0, 0); }
__device__ __forceinline__ s16x4 vtr(const NLAS unsigned char* p) { return __builtin_bit_cast(s16x4, __builtin_amdgcn_ds_read_tr16_b64_v4i16((NLAS v4i16_t*)p)); }
__device__ __forceinline__ void lds_add(NLAS unsigned* p, unsigned v) { (void)__hip_atomic_fetch_add(p, v, __ATOMIC_RELAXED, __HIP_MEMORY_SCOPE_WORKGROUP); }
#define NSA_WAITBAR() asm volatile("s_waitcnt vmcnt(0) lgkmcnt(0)\n\ts_barrier" ::: "memory")

__device__ __forceinline__ void issue_tile(NLAS unsigned char* lds, int slot, const bf16* Kb, const bf16* Vb, int row0, int wid, int lane, bool withV) {
  dma16(Kb + (size_t)(row0 + lane) * 64 + wid * 8, lds + L_K + slot * 8192 + wid * 1024);
  if (withV) dma16(Vb + (size_t)(row0 + 16 * (wid & 3) + (lane >> 2)) * 64 + (wid >> 2) * 32 + (lane & 3) * 8, lds + L_V + slot * 8192 + wid * 1024);
}

template <int PASS>
__device__ __forceinline__ void tile_compute(NLAS unsigned char* lds, int slot, const bf16x8 (&qr)[4], f32x16& o0, f32x16& o1, float& mhat, float& lsum,
                                             float cbase, bool lanesel, bool near, int dq, int step, int dmax, const NLAS float* tabr,
                                             float invl, NLAS unsigned* impq, int nbase, NLAS float* wsf, int lane) {
  const int r32 = lane & 31, hi = lane >> 5;
  const float cinit = lanesel ? (cbase - mhat) : NEGBIG;
  f32x16 p0, p1;
#pragma unroll
  for (int r = 0; r < 16; ++r) { p0[r] = cinit; p1[r] = cinit; }
  {
    const NLAS unsigned char* kb = lds + L_K + slot * 8192 + hi * 1024 + r32 * 16;
#pragma unroll
    for (int d0 = 0; d0 < 4; ++d0) {
      const bf16x8 b0 = *(const NLAS bf16x8*)(kb + d0 * 2048), b1 = *(const NLAS bf16x8*)(kb + d0 * 2048 + 512);
      p0 = __builtin_amdgcn_mfma_f32_32x32x16_bf16(b0, qr[d0], p0, 0, 0, 0);
      p1 = __builtin_amdgcn_mfma_f32_32x32x16_bf16(b1, qr[d0], p1, 0, 0, 0);
    }
  }
  if (near) {
#pragma unroll
    for (int r = 0; r < 16; ++r) {
      const int kk = crow(r, hi);
      { const int d = dq - step * kk; const bool vis = (d >= 0) && (d < dmax); const int idx = d < 0 ? 0 : (d > 128 ? 128 : d); const float v = p0[r] + tabr[idx]; p0[r] = vis ? v : NEGBIG; }
      { const int d = dq - step * (kk + 32); const bool vis = (d >= 0) && (d < dmax); const int idx = d < 0 ? 0 : (d > 128 ? 128 : d); const float v = p1[r] + tabr[idx]; p1[r] = vis ? v : NEGBIG; }
    }
  }
  if (PASS != 2) {
    float a = fmaxf(fmaxf(p0[0], p0[1]), p1[0]), b = fmaxf(fmaxf(p0[2], p0[3]), p1[1]); a = fmaxf(fmaxf(a, p1[2]), p1[3]);
#pragma unroll
    for (int r = 4; r < 16; r += 4) { a = fmaxf(fmaxf(a, p0[r]), p0[r + 1]); b = fmaxf(fmaxf(b, p0[r + 2]), p0[r + 3]); a = fmaxf(fmaxf(a, p1[r]), p1[r + 1]); b = fmaxf(fmaxf(b, p1[r + 2]), p1[r + 3]); }
    float rm = fmaxf(a, b);
    { auto rr = __builtin_amdgcn_permlane32_swap(__float_as_uint(rm), __float_as_uint(rm), false, false); rm = fmaxf(__uint_as_float(rr[0]), __uint_as_float(rr[1])); }
    if (__any(rm > 8.f)) {
      const float dl = fmaxf(rm, 0.f); mhat += dl;
#pragma unroll
      for (int r = 0; r < 16; ++r) { p0[r] -= dl; p1[r] -= dl; }
      const float f = __builtin_amdgcn_exp2f(-dl); lsum *= f;
      if (PASS == 0) {
        if (hi == 0) wsf[r32] = f;
        asm volatile("s_waitcnt lgkmcnt(0)" ::: "memory");
#pragma unroll
        for (int r = 0; r < 16; ++r) { const float fr = wsf[crow(r, hi)]; o0[r] *= fr; o1[r] *= fr; }
        asm volatile("s_waitcnt lgkmcnt(0)" ::: "memory");
      }
    }
  }
#pragma unroll
  for (int r = 0; r < 16; ++r) { p0[r] = __builtin_amdgcn_exp2f(p0[r]); p1[r] = __builtin_amdgcn_exp2f(p1[r]); }
  if (PASS == 2) {
#pragma unroll
    for (int r = 0; r < 16; ++r) { p0[r] *= invl; p1[r] *= invl; }
    if (impq) {
#pragma unroll
      for (int a = 0; a < 4; ++a) {
        { const int n = nbase + 2 * a + hi; const float gs = (p0[4 * a] + p0[4 * a + 1]) + (p0[4 * a + 2] + p0[4 * a + 3]);
          lds_add(impq + n, (unsigned)(gs * 1048576.f + 0.5f)); if (n + 1 < 128) lds_add(impq + n + 1, (unsigned)(p0[4 * a + 3] * 1048576.f + 0.5f)); }
        { const int n = nbase + 8 + 2 * a + hi; const float gs = (p1[4 * a] + p1[4 * a + 1]) + (p1[4 * a + 2] + p1[4 * a + 3]);
          lds_add(impq + n, (unsigned)(gs * 1048576.f + 0.5f)); if (n + 1 < 128) lds_add(impq + n + 1, (unsigned)(p1[4 * a + 3] * 1048576.f + 0.5f)); }
      }
    }
  } else {
    float s = 0.f;
#pragma unroll
    for (int r = 0; r < 16; ++r) s += p0[r] + p1[r];
    lsum += s;
  }
  if (PASS != 1) {
    u32x4 pw[4];
#pragma unroll
    for (int k = 0; k < 4; ++k) { pw[0][k] = cvtpk(p0[2 * k], p0[2 * k + 1]); pw[1][k] = cvtpk(p0[8 + 2 * k], p0[8 + 2 * k + 1]); pw[2][k] = cvtpk(p1[2 * k], p1[2 * k + 1]); pw[3][k] = cvtpk(p1[8 + 2 * k], p1[8 + 2 * k + 1]); }
    const NLAS unsigned char* vp = lds + L_V + slot * 8192 + ((lane >> 4) & 1) * 32 + (lane & 3) * 8 + (4 * hi + ((lane & 15) >> 2)) * 64;
#pragma unroll
    for (int ks = 0; ks < 4; ++ks) {
      const bf16x8 pa = __builtin_bit_cast(bf16x8, pw[ks]);
      { const s16x4 lo = vtr(vp + ks * 1024), hh = vtr(vp + ks * 1024 + 512); const bf16x8 vf = {lo[0], lo[1], lo[2], lo[3], hh[0], hh[1], hh[2], hh[3]};
        o0 = __builtin_amdgcn_mfma_f32_32x32x16_bf16(pa, vf, o0, 0, 0, 0); }
      { const s16x4 lo = vtr(vp + 4096 + ks * 1024), hh = vtr(vp + 4096 + ks * 1024 + 512); const bf16x8 vf = {lo[0], lo[1], lo[2], lo[3], hh[0], hh[1], hh[2], hh[3]};
        o1 = __builtin_amdgcn_mfma_f32_32x32x16_bf16(pa, vf, o1, 0, 0, 0); }
    }
  }
}

template <bool FIRST>
__device__ __forceinline__ void add_scaled(NLAS float* stg, const f32x16& o0, const f32x16& o1, float fac, NLAS float* wsf, int lane) {
  const int r32 = lane & 31, hi = lane >> 5;
  if (hi == 0) wsf[r32] = fac;
  asm volatile("s_waitcnt lgkmcnt(0)" ::: "memory");
#pragma unroll
  for (int r = 0; r < 16; ++r) { const int orow = crow(r, hi); const float f = wsf[orow];
    if (FIRST) { stg[orow * 64 + r32] = o0[r] * f; stg[orow * 64 + 32 + r32] = o1[r] * f; }
    else { stg[orow * 64 + r32] += o0[r] * f; stg[orow * 64 + 32 + r32] += o1[r] * f; } }
  asm volatile("s_waitcnt lgkmcnt(0)" ::: "memory");
}
__device__ __forceinline__ float merge_halves_sum(float v) { auto rr = __builtin_amdgcn_permlane32_swap(__float_as_uint(v), __float_as_uint(v), false, false); return __uint_as_float(rr[0]) + __uint_as_float(rr[1]); }

__device__ __forceinline__ void unit(const Tensors& T, int b, int g, int qb, NLAS unsigned char* lds) {
  int tid_ = mk_tid(); asm volatile("" : "+v"(tid_));
  const int tid = tid_, lane = tid & 63, wid = __builtin_amdgcn_readfirstlane(tid >> 6), r32 = lane & 31, hi = lane >> 5;
  const int hr = wid >> 1, qh = wid & 1, h = 4 * g + hr, slab = b * 2 + g, t0 = 64 * qb, qq = 32 * qh + r32, t = t0 + qq;
  const size_t tok = (size_t)b * 8192 + t;
  NLAS unsigned* imp = (NLAS unsigned*)(lds + L_IMP); NLAS unsigned* selm = (NLAS unsigned*)(lds + L_SELM); NLAS float* tab = (NLAS float*)(lds + L_TAB);
  NLAS float* wsf = (NLAS float*)(lds + L_WSF) + wid * 64; const NLAS float* tabr = tab + hr * 132;
  const bool dotopk = qb >= TOPN;
  for (int i = tid; i < 4 * 129; i += 512) { const int rr = i / 129, d = i % 129; tab[rr * 132 + d] = T.rel_bias[t5bucket(d) * 8 + 4 * g + rr] * LOG2E; }
  if (dotopk) for (int i = tid; i < 64 * 128; i += 512) imp[i] = 0u;
  bf16x8 qr[4];
#pragma unroll
  for (int d0 = 0; d0 < 4; ++d0) qr[d0] = *(const bf16x8*)(T.Q + tok * 512 + h * 64 + d0 * 16 + hi * 8);
  const float* gp = T.gates + tok * 32 + h * 3; const float g_c = gp[0], g_s = gp[1], g_w = gp[2];
  NLAS float* stg = (NLAS float*)(lds + L_OST) + wid * 2048;
  const bf16* KC = T.KC + (size_t)slab * 512 * 64; const bf16* VC = T.VC + (size_t)slab * 512 * 64;
  const bf16* KS = T.KS + (size_t)slab * 8192 * 64; const bf16* VS = T.VS + (size_t)slab * 8192 * 64;
  const bf16* KW = T.KW + (size_t)slab * 8192 * 64; const bf16* VW = T.VW + (size_t)slab * 8192 * 64;
  issue_tile(lds, 0, KC, VC, 0, wid, lane, false);
  NSA_WAITBAR();
  const float b31 = tabr[128];
  const int nct = ((4 * qb + 2) >> 6) + 1;
  float mhat = 0.f, lsum = 0.f; f32x16 o0, o1;
#pragma unroll
  for (int r = 0; r < 16; ++r) { o0[r] = 0.f; o1[r] = 0.f; }
  for (int ct = 0; ct < nct; ++ct) {
    if (ct + 1 < nct) issue_tile(lds, (ct + 1) & 1, KC, VC, 64 * (ct + 1), wid, lane, false);
    const bool near = ct + 2 >= nct;
    tile_compute<1>(lds, ct & 1, qr, o0, o1, mhat, lsum, near ? 0.f : b31, true, near, t - 31 - 1024 * ct, 16, 1 << 30, tabr, 0.f, nullptr, 0, wsf, lane);
    NSA_WAITBAR();
  }
  lsum = merge_halves_sum(lsum);
  const float invl_c = lsum > 0.f ? 1.f / lsum : 0.f;
  issue_tile(lds, 0, KC, VC, 0, wid, lane, true);
  NSA_WAITBAR();
  for (int ct = 0; ct < nct; ++ct) {
    if (ct + 1 < nct) issue_tile(lds, (ct + 1) & 1, KC, VC, 64 * (ct + 1), wid, lane, true);
    const bool near = ct + 2 >= nct;
    tile_compute<2>(lds, ct & 1, qr, o0, o1, mhat, lsum, near ? 0.f : b31, true, near, t - 31 - 1024 * ct, 16, 1 << 30, tabr, invl_c, dotopk ? imp + qq * 128 : nullptr, 16 * ct, wsf, lane);
    NSA_WAITBAR();
  }
  add_scaled<true>(stg, o0, o1, g_c, wsf, lane);
  {
    const int q = tid >> 3, part = tid & 7; unsigned bits = 0u;
    if (dotopk) {
      unsigned key[16];
#pragma unroll
      for (int i = 0; i < 16; ++i) { const int n = 16 * part + i; const unsigned v = imp[q * 128 + n]; key[i] = (n >= 1 && n <= qb - 2) ? ((v << 7) | (unsigned)(127 - n)) : 0u; }
      unsigned thr = 0u;
      for (int bit = 31; bit >= 0; --bit) { const unsigned cand = thr | (1u << bit); int cnt = 0;
#pragma unroll
        for (int i = 0; i < 16; ++i) cnt += (key[i] >= cand) ? 1 : 0;
        cnt += __shfl_xor(cnt, 1); cnt += __shfl_xor(cnt, 2); cnt += __shfl_xor(cnt, 4);
        if (cnt >= TOPN - 3) thr = cand; }
#pragma unroll
      for (int i = 0; i < 16; ++i) { const int n = 16 * part + i; if ((key[i] >= thr && key[i] != 0u) || n == 0 || n == qb || n == qb - 1) bits |= 1u << i; }
    } else {
#pragma unroll
      for (int i = 0; i < 16; ++i) if (16 * part + i <= qb) bits |= 1u << i;
    }
    ((NLAS unsigned short*)selm)[q * 8 + part] = (unsigned short)bits;
  }
  issue_tile(lds, 0, KS, VS, 0, wid, lane, true);
  NSA_WAITBAR();
  const unsigned long long mlo = (unsigned long long)selm[qq * 4 + 0] | ((unsigned long long)selm[qq * 4 + 1] << 32), mhi = (unsigned long long)selm[qq * 4 + 2] | ((unsigned long long)selm[qq * 4 + 3] << 32);
  mhat = 0.f; lsum = 0.f;
#pragma unroll
  for (int r = 0; r < 16; ++r) { o0[r] = 0.f; o1[r] = 0.f; }
  for (int j = 0; j <= qb; ++j) {
    if (j < qb) issue_tile(lds, (j + 1) & 1, KS, VS, 64 * (j + 1), wid, lane, true);
    const bool near = j + 2 >= qb; const bool sel = (((j < 64 ? mlo : mhi) >> (j & 63)) & 1ull) != 0ull;
    tile_compute<0>(lds, j & 1, qr, o0, o1, mhat, lsum, near ? 0.f : b31, sel, near, t - 64 * j, 1, 1 << 30, tabr, 0.f, nullptr, 0, wsf, lane);
    NSA_WAITBAR();
  }
  lsum = merge_halves_sum(lsum);
  add_scaled<false>(stg, o0, o1, lsum > 0.f ? g_s / lsum : 0.f, wsf, lane);
  const int jw0 = qb >= 8 ? qb - 8 : 0;
  issue_tile(lds, jw0 & 1, KW, VW, 64 * jw0, wid, lane, true);
  NSA_WAITBAR();
  mhat = 0.f; lsum = 0.f;
#pragma unroll
  for (int r = 0; r < 16; ++r) { o0[r] = 0.f; o1[r] = 0.f; }
  for (int j = jw0; j <= qb; ++j) {
    if (j < qb) issue_tile(lds, (j + 1) & 1, KW, VW, 64 * (j + 1), wid, lane, true);
    const bool near = (j + 2 >= qb) || (j + 8 == qb);
    tile_compute<0>(lds, j & 1, qr, o0, o1, mhat, lsum, near ? 0.f : b31, true, near, t - 64 * j, 1, 512, tabr, 0.f, nullptr, 0, wsf, lane);
    NSA_WAITBAR();
  }
  lsum = merge_halves_sum(lsum);
  add_scaled<false>(stg, o0, o1, lsum > 0.f ? g_w / lsum : 0.f, wsf, lane);
  {
    bf16* Ow = T.MIX + ((size_t)b * 8192 + t0 + 32 * qh) * 1024 + h * 64;
#pragma unroll
    for (int i = 0; i < 4; ++i) { const int row = i * 8 + (lane >> 3), ch = lane & 7; const NLAS float* sp = stg + row * 64 + ch * 8;
      u32x4 v; v.x = cvtpk(sp[0], sp[1]); v.y = cvtpk(sp[2], sp[3]); v.z = cvtpk(sp[4], sp[5]); v.w = cvtpk(sp[6], sp[7]); *(u32x4*)(Ow + (size_t)row * 1024 + ch * 8) = v; }
  }
  NSA_WAITBAR();
}
}
namespace rwkv {
#define RLAS __attribute__((address_space(3)))
typedef unsigned short bf16;
typedef short bf16x8 __attribute__((ext_vector_type(8)));
typedef short bf16x4 __attribute__((ext_vector_type(4)));
typedef float f32x4 __attribute__((ext_vector_type(4)));
typedef unsigned u32x2 __attribute__((ext_vector_type(2)));
typedef unsigned u32x4 __attribute__((ext_vector_type(4)));
typedef float f32x2_t __attribute__((ext_vector_type(2))); typedef __bf16 bf16x2_t __attribute__((ext_vector_type(2)));
constexpr int LD = 72, MATB = 64 * LD * 2;
constexpr int M_AT = 0, M_ATT = MATB, M_BT = 2 * MATB, M_BTT = 3 * MATB, M_KT = 4 * MATB, M_KTT = 5 * MATB, M_RT = 6 * MATB, M_VT = 7 * MATB;
constexpr int A_AB = 8 * MATB, A_AK = 9 * MATB, A_RB = 10 * MATB, A_RK = 11 * MATB, L_DIAG = 12 * MATB, L_TII = L_DIAG + 4096, L_E = L_TII + 2048, L_SEG = L_E + 16384, L_PC = L_SEG + 2048, L_BYTES = L_PC + 256;
struct Tensors {
  const bf16* RW; const bf16* LORA;
  const float *mu, *w0, *a0, *k_k, *k_a, *r_k, *ln_w, *ln_b;
  bf16 *G, *HADD, *RWM, *Y0, *HT; float* PC; float* BON; bf16* VM;
  bf16* MIX;
};
__device__ __forceinline__ int opq(int x) { asm volatile("" : "+s"(x)); return x; }
__device__ __forceinline__ float bf2f(bf16 v) { return __uint_as_float((unsigned)v << 16); }
__device__ __forceinline__ unsigned cvtpk(float lo, float hi) { f32x2_t v = {lo, hi}; bf16x2_t b = __builtin_convertvector(v, bf16x2_t); return __builtin_bit_cast(unsigned, b); }
__device__ __forceinline__ bf16x4 pack4(const f32x4& v) { u32x2 r; r.x = cvtpk(v[0], v[1]); r.y = cvtpk(v[2], v[3]); return __builtin_bit_cast(bf16x4, r); }
__device__ __forceinline__ f32x4 mfma16(bf16x4 a, bf16x4 b, f32x4 c) { return __builtin_amdgcn_mfma_f32_16x16x16bf16_1k(a, b, c, 0, 0, 0); }
__device__ __forceinline__ f32x4 mfma32(bf16x8 a, bf16x8 b, f32x4 c) { return __builtin_amdgcn_mfma_f32_16x16x32_bf16(a, b, c, 0, 0, 0); }
__device__ __forceinline__ float sigm(float x) { return __builtin_amdgcn_rcpf(1.f + __expf(-x)); }
__device__ __forceinline__ void unpack8(const u32x4& w, float (&o)[8]) {
  o[0] = __uint_as_float(w.x << 16); o[1] = __uint_as_float(w.x & 0xffff0000u); o[2] = __uint_as_float(w.y << 16); o[3] = __uint_as_float(w.y & 0xffff0000u);
  o[4] = __uint_as_float(w.z << 16); o[5] = __uint_as_float(w.z & 0xffff0000u); o[6] = __uint_as_float(w.w << 16); o[7] = __uint_as_float(w.w & 0xffff0000u);
}
__device__ __forceinline__ void ld8(const float* p, float (&o)[8]) { const f32x4 a = *(const f32x4*)p, b = *(const f32x4*)(p + 4); o[0] = a[0]; o[1] = a[1]; o[2] = a[2]; o[3] = a[3]; o[4] = b[0]; o[5] = b[1]; o[6] = b[2]; o[7] = b[3]; }
struct Prep8 { float r[8], kp[8], v[8], e[8], a[8], kk[8]; };
__device__ __forceinline__ void prep8(const Tensors& T, size_t m, int t, int h, int c0, Prep8& o) {
  const bf16* rw = T.RW + m * 1792 + h * 64 + c0; const bf16* lo = T.LORA + m * 1536 + h * 64 + c0; const int c = h * 64 + c0;
  float rc[8], kc[8], vc[8], rp[8], kp[8], vp[8], al[8], wl[8], mr[8], mk[8], mv[8], a0v[8], w0v[8], kkv[8], kav[8];
  unpack8(*(const u32x4*)rw, rc); unpack8(*(const u32x4*)(rw + 512), kc); unpack8(*(const u32x4*)(rw + 1024), vc);
  if (t > 0) { unpack8(*(const u32x4*)(rw - 1792), rp); unpack8(*(const u32x4*)(rw + 512 - 1792), kp); unpack8(*(const u32x4*)(rw + 1024 - 1792), vp); }
  else {
#pragma unroll
    for (int j = 0; j < 8; ++j) { rp[j] = 0.f; kp[j] = 0.f; vp[j] = 0.f; } }
  unpack8(*(const u32x4*)(lo + 512), al); unpack8(*(const u32x4*)lo, wl);
  ld8(T.mu + c, mr); ld8(T.mu + 512 + c, mk); ld8(T.mu + 1024 + c, mv); ld8(T.a0 + c, a0v); ld8(T.w0 + c, w0v); ld8(T.k_k + c, kkv); ld8(T.k_a + c, kav);
#pragma unroll
  for (int j = 0; j < 8; ++j) {
    const float rm = rc[j] + (rp[j] - rc[j]) * mr[j], km = kc[j] + (kp[j] - kc[j]) * mk[j], vm = vc[j] + (vp[j] - vc[j]) * mv[j];
    const float a = sigm(a0v[j] + al[j]);
    o.r[j] = rm; o.v[j] = vm; o.a[j] = a; o.kk[j] = km * kkv[j]; o.kp[j] = km * (1.f + (a - 1.f) * kav[j]);
    const float wr = w0v[j] + wl[j]; const float sp = (-wr > 20.f) ? -wr : __logf(1.f + __expf(-wr)); o.e[j] = __expf(-sp - 0.5f);
  }
}

__device__ __forceinline__ void p1_item(const Tensors& T, int bh, int ch, RLAS unsigned char* lds) {
  int tid_ = mk_tid(); asm volatile("" : "+v"(tid_));
  const int tid = tid_, lane = tid & 63, wid = __builtin_amdgcn_readfirstlane(tid >> 6), col = lane & 15, q = lane >> 4;
  const int b = bh >> 3, h = bh & 7; const size_t item = (size_t)bh * 128 + ch;
  const int MVT = opq(M_VT);
  RLAS float* E = (RLAS float*)(lds + L_E); RLAS float* SEG = (RLAS float*)(lds + L_SEG); RLAS float* PCL = (RLAS float*)(lds + L_PC);
  const int i = tid >> 3, c0 = (tid & 7) * 8; const int t = ch * 64 + i; const size_t m = (size_t)b * 8192 + t;
  Prep8 P; prep8(T, m, t, h, c0, P);
  float ss = 0.f, bo = 0.f;
  { float rk[8]; ld8(T.r_k + h * 64 + c0, rk);
#pragma unroll
    for (int j = 0; j < 8; ++j) { ss += P.kk[j] * P.kk[j]; bo += P.r[j] * P.kp[j] * rk[j]; } }
  ss += __shfl_xor(ss, 1); ss += __shfl_xor(ss, 2); ss += __shfl_xor(ss, 4);
  bo += __shfl_xor(bo, 1); bo += __shfl_xor(bo, 2); bo += __shfl_xor(bo, 4);
  if ((tid & 7) == 0) T.BON[item * 64 + i] = bo;
  { u32x4 w; w.x = cvtpk(P.v[0], P.v[1]); w.y = cvtpk(P.v[2], P.v[3]); w.z = cvtpk(P.v[4], P.v[5]); w.w = cvtpk(P.v[6], P.v[7]); *(u32x4*)(T.VM + item * 4096 + i * 64 + c0) = w; }
  const float kinv = 1.f / fmaxf(sqrtf(ss), 1e-12f);
#pragma unroll
  for (int j = 0; j < 8; ++j) E[i * 64 + c0 + j] = P.e[j];
  __syncthreads();
  { const int k = tid & 63, sg = tid >> 6; float run = 0.f;
#pragma unroll
    for (int ii = 0; ii < 8; ++ii) { run += E[(sg * 8 + ii) * 64 + k]; E[(sg * 8 + ii) * 64 + k] = run; }
    SEG[sg * 64 + k] = run; }
  __syncthreads();
  { const int k = tid & 63, sg = wid; float off = 0.f;
    for (int s2 = 0; s2 < sg; ++s2) off += SEG[s2 * 64 + k];
#pragma unroll
    for (int ii = 0; ii < 8; ++ii) E[(sg * 8 + ii) * 64 + k] += off; }
  __syncthreads();
  {
    float av[8], bv[8], kv[8], rv[8];
#pragma unroll
    for (int j = 0; j < 8; ++j) {
      const float cum = E[i * 64 + c0 + j];
      const float pinc = __expf(-cum), pexc = __expf(-(cum - P.e[j])), pinv = __expf(cum);
      const float kk = P.kk[j] * kinv;
      av[j] = -kk * pexc; bv[j] = kk * P.a[j] * pinv; kv[j] = P.kp[j] * pinv; rv[j] = P.r[j] * pinc;
      if (i == 63) { PCL[c0 + j] = pinc; T.PC[item * 64 + c0 + j] = pinc; }
    }
    u32x4 w;
    w.x = cvtpk(av[0], av[1]); w.y = cvtpk(av[2], av[3]); w.z = cvtpk(av[4], av[5]); w.w = cvtpk(av[6], av[7]); *(RLAS u32x4*)(lds + M_AT + (i * LD + c0) * 2) = w;
    w.x = cvtpk(bv[0], bv[1]); w.y = cvtpk(bv[2], bv[3]); w.z = cvtpk(bv[4], bv[5]); w.w = cvtpk(bv[6], bv[7]); *(RLAS u32x4*)(lds + M_BT + (i * LD + c0) * 2) = w;
    w.x = cvtpk(kv[0], kv[1]); w.y = cvtpk(kv[2], kv[3]); w.z = cvtpk(kv[4], kv[5]); w.w = cvtpk(kv[6], kv[7]); *(RLAS u32x4*)(lds + M_KT + (i * LD + c0) * 2) = w;
    w.x = cvtpk(rv[0], rv[1]); w.y = cvtpk(rv[2], rv[3]); w.z = cvtpk(rv[4], rv[5]); w.w = cvtpk(rv[6], rv[7]); *(RLAS u32x4*)(lds + M_RT + (i * LD + c0) * 2) = w;
#pragma unroll
    for (int j = 0; j < 8; ++j) {
      *(RLAS bf16*)(lds + M_ATT + ((c0 + j) * LD + i) * 2) = (bf16)(cvtpk(av[j], 0.f) & 0xffffu);
      *(RLAS bf16*)(lds + M_BTT + ((c0 + j) * LD + i) * 2) = (bf16)(cvtpk(bv[j], 0.f) & 0xffffu);
      *(RLAS bf16*)(lds + M_KTT + ((c0 + j) * LD + i) * 2) = (bf16)(cvtpk(kv[j], 0.f) & 0xffffu);
      *(RLAS bf16*)(lds + MVT + ((c0 + j) * LD + i) * 2) = (bf16)(cvtpk(P.v[j], 0.f) & 0xffffu);
    }
  }
  __syncthreads();
  {
    const int it = wid & 3, src = wid >> 2;
    const RLAS unsigned char* SRC = lds + (src ? M_RT : M_AT) + ((16 * it + col) * LD + 8 * q) * 2;
    const bf16x8 b0 = *(const RLAS bf16x8*)SRC, b1 = *(const RLAS bf16x8*)(SRC + 64);
    const int gi = 16 * it + col;
#pragma unroll
    for (int jt = 0; jt < 4; ++jt)
#pragma unroll
      for (int which = 0; which < 2; ++which) {
        const RLAS unsigned char* AM = lds + (which ? M_KT : M_BT) + ((16 * jt + col) * LD + 8 * q) * 2;
        f32x4 acc = {0.f, 0.f, 0.f, 0.f};
        acc = mfma32(*(const RLAS bf16x8*)AM, b0, acc); acc = mfma32(*(const RLAS bf16x8*)(AM + 64), b1, acc);
#pragma unroll
        for (int r = 0; r < 4; ++r) { const int gj = 16 * jt + 4 * q + r; const bool keep = src ? (gj <= gi) : (gj < gi); acc[r] = keep ? acc[r] : 0.f; }
        const int dst = src ? (which ? A_RK : A_RB) : (which ? A_AK : A_AB);
        *(RLAS bf16x4*)(lds + dst + (gi * LD + 16 * jt + 4 * q) * 2) = pack4(acc);
        if (src == 0 && which == 0 && jt == it) {
#pragma unroll
          for (int r = 0; r < 4; ++r) *(RLAS float*)(lds + L_DIAG + ((it * 16 + col) * 16 + 4 * q + r) * 4) = acc[r];
        }
      }
  }
  __syncthreads();
  if (wid == 0) {
    const int blk = lane >> 4, c = lane & 15; const RLAS float* L = (const RLAS float*)(lds + L_DIAG) + blk * 256;
    float x[16];
#pragma unroll
    for (int ii = 0; ii < 16; ++ii) { float s = (ii == c) ? 1.f : 0.f;
#pragma unroll
      for (int mm = 0; mm < ii; ++mm) s += L[ii * 16 + mm] * x[mm];
      x[ii] = s; }
#pragma unroll
    for (int ii = 0; ii < 16; ++ii) *(RLAS bf16*)(lds + L_TII + ((blk * 16 + ii) * 16 + c) * 2) = (bf16)(cvtpk(x[ii], 0.f) & 0xffffu);
  }
  __syncthreads();
  {
    const bool isU = wid >= 4; const int ct = wid & 3;
    bf16x4 Xb[4];
#pragma unroll
    for (int ib = 0; ib < 4; ++ib) {
      f32x4 tmp;
      if (!isU) { const bf16x4 a4 = *(const RLAS bf16x4*)(lds + M_ATT + ((16 * ct + col) * LD + 16 * ib + 4 * q) * 2);
#pragma unroll
        for (int r = 0; r < 4; ++r) tmp[r] = bf2f((bf16)a4[r]); }
      else { tmp = (f32x4){0.f, 0.f, 0.f, 0.f};
#pragma unroll
        for (int ks = 0; ks < 2; ++ks) tmp = mfma32(*(const RLAS bf16x8*)(lds + A_AK + ((16 * ib + col) * LD + 32 * ks + 8 * q) * 2), *(const RLAS bf16x8*)(lds + MVT + ((16 * ct + col) * LD + 32 * ks + 8 * q) * 2), tmp); }
      const f32x4 zero = {0.f, 0.f, 0.f, 0.f};
      f32x4 t16 = zero;
#pragma unroll
      for (int mb = 0; mb < 4; ++mb) if (mb < ib) t16 = mfma16(*(const RLAS bf16x4*)(lds + A_AB + ((16 * ib + col) * LD + 16 * mb + 4 * q) * 2), Xb[mb], t16);
      tmp = tmp + t16;
      const f32x4 X = mfma16(*(const RLAS bf16x4*)(lds + L_TII + ((ib * 16 + col) * 16 + 4 * q) * 2), pack4(tmp), zero);
      Xb[ib] = pack4(X);
    }
    if (!isU) {
#pragma unroll
      for (int ib = 0; ib < 4; ++ib) { const int gi = 16 * ib + col;
        const bf16x4 r4 = *(const RLAS bf16x4*)(lds + M_RT + (gi * LD + 16 * ct + 4 * q) * 2); f32x4 acc;
#pragma unroll
        for (int r = 0; r < 4; ++r) acc[r] = bf2f((bf16)r4[r]);
#pragma unroll
        for (int mb = 0; mb < 4; ++mb) if (mb <= ib) acc = mfma16(Xb[mb], *(const RLAS bf16x4*)(lds + A_RB + (gi * LD + 16 * mb + 4 * q) * 2), acc);
        *(bf16x4*)(T.RWM + item * 4096 + gi * 64 + 16 * ct + 4 * q) = pack4(acc); }
#pragma unroll
      for (int kb = 0; kb < 4; ++kb) { const int gk = 16 * kb + col; f32x4 acc = {0.f, 0.f, 0.f, 0.f};
#pragma unroll
        for (int mb = 0; mb < 4; ++mb) acc = mfma16(Xb[mb], *(const RLAS bf16x4*)(lds + M_BTT + (gk * LD + 16 * mb + 4 * q) * 2), acc);
        const float pc = PCL[gk];
#pragma unroll
        for (int r = 0; r < 4; ++r) acc[r] *= pc;
        *(bf16x4*)(T.G + item * 4096 + gk * 64 + 16 * ct + 4 * q) = pack4(acc); }
    } else {
#pragma unroll
      for (int ib = 0; ib < 4; ++ib) { const int gi = 16 * ib + col; f32x4 acc = {0.f, 0.f, 0.f, 0.f}, acc2 = {0.f, 0.f, 0.f, 0.f};
#pragma unroll
        for (int mb = 0; mb < 4; ++mb) if (mb <= ib) acc = mfma16(Xb[mb], *(const RLAS bf16x4*)(lds + A_RB + (gi * LD + 16 * mb + 4 * q) * 2), acc);
#pragma unroll
        for (int ks = 0; ks < 2; ++ks) acc2 = mfma32(*(const RLAS bf16x8*)(lds + MVT + ((16 * ct + col) * LD + 32 * ks + 8 * q) * 2), *(const RLAS bf16x8*)(lds + A_RK + (gi * LD + 32 * ks + 8 * q) * 2), acc2);
        acc = acc + acc2;
        *(bf16x4*)(T.Y0 + item * 4096 + gi * 64 + 16 * ct + 4 * q) = pack4(acc); }
#pragma unroll
      for (int kb = 0; kb < 4; ++kb) { f32x4 acc = {0.f, 0.f, 0.f, 0.f}, acc2 = {0.f, 0.f, 0.f, 0.f};
#pragma unroll
        for (int mb = 0; mb < 4; ++mb) acc = mfma16(*(const RLAS bf16x4*)(lds + M_BTT + ((16 * kb + col) * LD + 16 * mb + 4 * q) * 2), Xb[mb], acc);
#pragma unroll
        for (int ks = 0; ks < 2; ++ks) acc2 = mfma32(*(const RLAS bf16x8*)(lds + M_KTT + ((16 * kb + col) * LD + 32 * ks + 8 * q) * 2), *(const RLAS bf16x8*)(lds + MVT + ((16 * ct + col) * LD + 32 * ks + 8 * q) * 2), acc2);
        const f32x4 pc = *(const RLAS f32x4*)(PCL + 16 * kb + 4 * q);
        acc = (acc + acc2) * pc;
        *(bf16x4*)(T.HADD + item * 4096 + (16 * ct + col) * 64 + 16 * kb + 4 * q) = pack4(acc); }
    }
  }
  __syncthreads();
}

__device__ __forceinline__ void scan_head(const Tensors& T, int bh, int wv, int lane) {
  const int col = lane & 15, q = lane >> 4, v = 16 * wv + col;
  f32x4 acc[4];
#pragma unroll
  for (int kb = 0; kb < 4; ++kb) acc[kb] = (f32x4){0.f, 0.f, 0.f, 0.f};
  for (int ch = 0; ch < 128; ++ch) {
    const size_t item = (size_t)bh * 128 + ch;
    const bf16* Gp = T.G + item * 4096; const bf16* Hp = T.HADD + item * 4096 + v * 64; const float* Pp = T.PC + item * 64;
    bf16x4 ga[4][4]; bf16x4 ha[4]; f32x4 pc[4];
#pragma unroll
    for (int kb = 0; kb < 4; ++kb) { ha[kb] = *(const bf16x4*)(Hp + 16 * kb + 4 * q); pc[kb] = *(const f32x4*)(Pp + 16 * kb + 4 * q);
#pragma unroll
      for (int mb = 0; mb < 4; ++mb) ga[kb][mb] = *(const bf16x4*)(Gp + (16 * kb + col) * 64 + 16 * mb + 4 * q); }
    bf16x4 hb[4];
#pragma unroll
    for (int kb = 0; kb < 4; ++kb) { hb[kb] = pack4(acc[kb]); *(bf16x4*)(T.HT + item * 4096 + v * 64 + 16 * kb + 4 * q) = hb[kb]; }
    f32x4 nw[4];
#pragma unroll
    for (int kb = 0; kb < 4; ++kb) {
#pragma unroll
      for (int r = 0; r < 4; ++r) nw[kb][r] = pc[kb][r] * acc[kb][r] + bf2f((bf16)ha[kb][r]);
#pragma unroll
      for (int mb = 0; mb < 4; ++mb) nw[kb] = mfma16(ga[kb][mb], hb[mb], nw[kb]);
    }
#pragma unroll
    for (int kb = 0; kb < 4; ++kb) acc[kb] = nw[kb];
  }
}

__device__ __forceinline__ void p2_item(const Tensors& T, int bh, int ch, int ib, int lane) {
  const int col = lane & 15, q = lane >> 4, b = bh >> 3, h = bh & 7; const size_t item = (size_t)bh * 128 + ch;
  const int i = 16 * ib + col, t = ch * 64 + i; const size_t m = (size_t)b * 8192 + t;
  const bf16* RWp = T.RWM + item * 4096 + i * 64 + 8 * q; const bf16* HTp = T.HT + item * 4096 + col * 64 + 8 * q;
  const bf16x8 rb0 = *(const bf16x8*)RWp, rb1 = *(const bf16x8*)(RWp + 32);
  f32x4 y[4];
#pragma unroll
  for (int vt = 0; vt < 4; ++vt) { const bf16x4 y0 = *(const bf16x4*)(T.Y0 + item * 4096 + i * 64 + 16 * vt + 4 * q);
#pragma unroll
    for (int r = 0; r < 4; ++r) y[vt][r] = bf2f((bf16)y0[r]);
    y[vt] = mfma32(*(const bf16x8*)(HTp + vt * 16 * 64), rb0, y[vt]); y[vt] = mfma32(*(const bf16x8*)(HTp + vt * 16 * 64 + 32), rb1, y[vt]); }
  const float bo = T.BON[item * 64 + i]; float vmix[4][4];
#pragma unroll
  for (int vt = 0; vt < 4; ++vt) { const bf16x4 v4 = *(const bf16x4*)(T.VM + item * 4096 + i * 64 + 16 * vt + 4 * q);
#pragma unroll
    for (int r = 0; r < 4; ++r) vmix[vt][r] = bf2f((bf16)v4[r]); }
  float s = 0.f;
#pragma unroll
  for (int vt = 0; vt < 4; ++vt) s += (y[vt][0] + y[vt][1]) + (y[vt][2] + y[vt][3]);
  s += __shfl_xor(s, 16); s += __shfl_xor(s, 32);
  const float mean = s * (1.f / 64.f); float qq = 0.f;
#pragma unroll
  for (int vt = 0; vt < 4; ++vt)
#pragma unroll
    for (int r = 0; r < 4; ++r) { const float d = y[vt][r] - mean; qq += d * d; }
  qq += __shfl_xor(qq, 16); qq += __shfl_xor(qq, 32);
  const float rstd = rsqrtf(qq * (1.f / 64.f) + 64e-5f);
#pragma unroll
  for (int vt = 0; vt < 4; ++vt) { const int c = h * 64 + 16 * vt + 4 * q;
    const f32x4 lw = *(const f32x4*)(T.ln_w + c), lb = *(const f32x4*)(T.ln_b + c); const bf16x4 g4 = *(const bf16x4*)(T.LORA + m * 1536 + 1024 + c);
    f32x4 o;
#pragma unroll
    for (int r = 0; r < 4; ++r) o[r] = ((y[vt][r] - mean) * rstd * lw[r] + lb[r] + bo * vmix[vt][r]) * bf2f((bf16)g4[r]);
    *(bf16x4*)(T.MIX + m * 1024 + 512 + c) = pack4(o); }
}
}
namespace {
#define LAS __attribute__((address_space(3)))
typedef unsigned short bf16;
typedef unsigned v4u __attribute__((ext_vector_type(4)));
typedef float f32x4 __attribute__((ext_vector_type(4)));
typedef short bf16x8 __attribute__((ext_vector_type(8)));
constexpr int NWAVES = 8, NTHREADS = 512;
constexpr int B_ = 2, T_ = 8192, D_ = 1024, M_ = B_ * T_, DIN = 3096, DFF = 2816, NPROJ = 3328, NLORA = 1536, KLORA = 256, NUPH = 2816;
constexpr size_t MiB = 1u << 20;
constexpr size_t WS_CTL = 0, WS_WIN = 1 * MiB, WS_WOUT = 8 * MiB, WS_WUP = 10 * MiB, WS_WDN = 21 * MiB, WS_LORAW = 27 * MiB, WS_B1P = 28 * MiB, WS_CW1T = 29 * MiB;
constexpr size_t WS_XN = 32 * MiB;
constexpr size_t WS_HT = 32 * MiB, WS_VM = 48 * MiB, WS_PC = 210 * MiB, WS_BON = 211 * MiB;
constexpr size_t WS_Q = 64 * MiB;
constexpr size_t WS_SLAB = 80 * MiB;
constexpr size_t WS_GATES = 104 * MiB;
constexpr size_t WS_RW = 106 * MiB;
constexpr size_t WS_LORA = 162 * MiB;
constexpr size_t WS_ACT = 210 * MiB;
constexpr size_t WS_CMP = 218 * MiB;
constexpr size_t WS_MIX = 220 * MiB;
constexpr size_t WS_U = 64 * MiB;
constexpr size_t WS_ACT2 = 64 * MiB;
constexpr size_t WS_END = 256 * MiB;
constexpr int LDS_BYTES = 147456;

__device__ __forceinline__ float bf2f(bf16 v) { return __uint_as_float((unsigned)v << 16); }
__device__ __forceinline__ unsigned f2bf(float f) { unsigned u = __float_as_uint(f); return (u + 0x7fffu + ((u >> 16) & 1u)) >> 16; }
__device__ __forceinline__ unsigned pk2(float lo, float hi) { return f2bf(lo) | (f2bf(hi) << 16); }
__device__ __forceinline__ float wsum(float v) {
#pragma unroll
  for (int o = 32; o >= 1; o >>= 1) v += __shfl_xor(v, o);
  return v;
}
__device__ __forceinline__ float wmax(float v) {
#pragma unroll
  for (int o = 32; o >= 1; o >>= 1) v = fmaxf(v, __shfl_xor(v, o));
  return v;
}
__device__ __forceinline__ int t5b(int n) {
  if (n < 16) return n < 0 ? 0 : n;
  if (n >= 128) return 31;
  int v = 16 + (int)(logf((float)n / 16.f) / 2.0794415416798357f * 16.f);
  return v > 31 ? 31 : v;
}
__device__ __forceinline__ float sigm(float x) { return 1.f / (1.f + expf(-x)); }
__device__ __forceinline__ float gelu_tanh(float x) { return 0.5f * x * (1.f + tanhf(0.7978845608028654f * (x + 0.044715f * x * x * x))); }

#define XB_TMO      128
#define XB_XCNT(j)  (256  + 64 * (j))
#define XB_XSUB(j)  (1280 + 64 * (j))
#define XB_XGEN(j)  (2304 + 64 * (j))
#define XB_TOP      3328
#define XB_TOPGEN   3392
#define XCD_BAR_WORDS 3456
#define XB_SPIN_CAP (1u << 18)

__device__ __forceinline__ unsigned xb_ld(unsigned* p)              { return __hip_atomic_load(p, __ATOMIC_RELAXED, __HIP_MEMORY_SCOPE_AGENT); }
__device__ __forceinline__ unsigned xb_add(unsigned* p, unsigned v) { return __hip_atomic_fetch_add(p, v, __ATOMIC_RELAXED, __HIP_MEMORY_SCOPE_AGENT); }
__device__ __forceinline__ unsigned xb_xcc_id() { return (unsigned)__builtin_amdgcn_s_getreg((3 << 11) | 20) & 0xFu; }
#define XB_SPIN(cond, bar) do { unsigned _sp = 0; while (cond) { __builtin_amdgcn_s_sleep(1); \
    if ((++_sp & 255u) == 0u) { if (xb_ld(&(bar)[XB_TMO])) break; if (_sp > XB_SPIN_CAP) { atomicAdd(&(bar)[XB_TMO], 1u); break; } } } } while (0)

struct XcdBarrier {
    unsigned* bar; unsigned x;
    volatile LAS unsigned* st;
};

__device__ __forceinline__ XcdBarrier xcd_barrier_post(unsigned* bar, volatile LAS unsigned* st) {
    XcdBarrier b; b.bar = bar; b.x = xb_xcc_id(); b.st = st;
    if (mk_tid() == 0) (void)xb_add(&bar[XB_XCNT(b.x)], 1u);
    return b;
}
__device__ __forceinline__ void xcd_barrier_complete(unsigned* bar, unsigned x, unsigned& nloc, unsigned& nx) {
    const unsigned G = gridDim.x * gridDim.y * gridDim.z;
    unsigned sum, cnt, mine, sp = 0u;
    for (;;) {
        sum = 0u; cnt = 0u; mine = 0u;
#pragma unroll
        for (unsigned j = 0; j < 16; ++j) { const unsigned c = xb_ld(&bar[XB_XCNT(j)]); sum += c; cnt += (c > 0u) ? 1u : 0u; mine = (j == x) ? c : mine; }
        if (sum == G) break;
        __builtin_amdgcn_s_sleep(1);
        if ((++sp & 255u) == 0u) { if (xb_ld(&bar[XB_TMO])) break; if (sp > XB_SPIN_CAP) { atomicAdd(&bar[XB_TMO], 1u); break; } }
    }
    nloc = mine > 0u ? mine : 1u; nx = cnt > 0u ? cnt : 1u;
}

__device__ __forceinline__ void xcd_barrier(const XcdBarrier& b) {
    asm volatile("s_waitcnt vmcnt(0)" ::: "memory");
    __syncthreads();
    if (mk_tid() == 0) {
        unsigned* bar = b.bar;
        __builtin_amdgcn_s_waitcnt(0);
        unsigned nloc = b.st[0], nx = b.st[1];
        if (nloc == 0u) { xcd_barrier_complete(bar, b.x, nloc, nx); b.st[0] = nloc; b.st[1] = nx; }
        const unsigned old = xb_add(&bar[XB_XSUB(b.x)], 1u);
        const unsigned gen = old / nloc;
        if (old + 1u == (gen + 1u) * nloc) {
            __builtin_amdgcn_fence(__ATOMIC_RELEASE, "agent");
            asm volatile("s_waitcnt vmcnt(0)" ::: "memory");
            const unsigned og = xb_add(&bar[XB_TOP], 1u);
            const unsigned tg = og / nx;
            if (og + 1u == (tg + 1u) * nx) xb_add(&bar[XB_TOPGEN], 1u);
            else XB_SPIN(xb_ld(&bar[XB_TOPGEN]) == tg, bar);
            __builtin_amdgcn_fence(__ATOMIC_ACQUIRE, "agent");
            xb_add(&bar[XB_XGEN(b.x)], 1u);
            asm volatile("s_waitcnt vmcnt(0)" ::: "memory");
        } else {
            XB_SPIN(xb_ld(&bar[XB_XGEN(b.x)]) == gen, bar);
            __builtin_amdgcn_fence(__ATOMIC_ACQUIRE, "agent");
            asm volatile("s_waitcnt vmcnt(0)" ::: "memory");
        }
    }
    __syncthreads();
}

struct Params {
  const float* in[28]; float* out; unsigned char* ws; int ph_lo, ph_hi, li, pad;
};

__device__ __forceinline__ void tr_item(const float* W, int ldn, int k0, int nsrc0, int nvalid, bf16* WT, int K, int dstrow0, LAS float* scr, int lane) {
#pragma unroll 8
  for (int i = 0; i < 32; ++i) { const int kk = 2 * i + (lane >> 5), c = lane & 31; scr[kk * 33 + c] = (c < nvalid) ? W[(size_t)(k0 + kk) * ldn + nsrc0 + c] : 0.f; }
  asm volatile("s_waitcnt lgkmcnt(0)" ::: "memory");
  const int c = lane & 7;
#pragma unroll
  for (int j = 0; j < 4; ++j) { const int n = (lane >> 3) + 8 * j; const LAS float* s = scr + (8 * c) * 33 + n;
    v4u o; o.x = pk2(s[0 * 33], s[1 * 33]); o.y = pk2(s[2 * 33], s[3 * 33]); o.z = pk2(s[4 * 33], s[5 * 33]); o.w = pk2(s[6 * 33], s[7 * 33]);
    *(v4u*)(WT + (size_t)(dstrow0 + n) * K + k0 + 8 * c) = o; }
  asm volatile("s_waitcnt lgkmcnt(0)" ::: "memory");
}
__device__ __forceinline__ void proj_src(int c, int& src, int& nv) {
  const int pn = c >> 8, bj = (c >> 7) & 1, wc = (c >> 5) & 3, grp = 4 * pn + wc, dim0 = 32 * bj;
  if (grp < 20) { src = grp * 64 + dim0; nv = 32; } else if (grp == 20) { src = 1280 + dim0; nv = bj == 0 ? 24 : 0; } else if (grp < 49) { src = 1304 + (grp - 21) * 64 + dim0; nv = 32; } else { src = 0; nv = 0; }
}
__device__ __forceinline__ void rms_row_to_bf16(const float* xrow, const float* g, bf16* orow, int lane) {
  const f32x4* xr = (const f32x4*)xrow + lane; const f32x4* gr = (const f32x4*)g + lane;
  f32x4 v[4]; float s = 0.f;
#pragma unroll
  for (int j = 0; j < 4; ++j) { v[j] = xr[64 * j]; s += (v[j].x * v[j].x + v[j].y * v[j].y) + (v[j].z * v[j].z + v[j].w * v[j].w); }
  const float r = rsqrtf(wsum(s) * (1.f / D_) + 1e-6f);
  unsigned long long* o8 = (unsigned long long*)orow + lane;
#pragma unroll
  for (int j = 0; j < 4; ++j) { const f32x4 gg = gr[64 * j]; o8[64 * j] = (unsigned long long)pk2(v[j].x * r * gg.x, v[j].y * r * gg.y) | ((unsigned long long)pk2(v[j].z * r * gg.z, v[j].w * r * gg.w) << 32); }
}

__device__ __forceinline__ void phase_prologue(const Params& p, LAS unsigned char* lds, int wave, int lane) {
  LAS float* scr = (LAS float*)(lds + wave * 16384);
  const int gw = blockIdx.x * NWAVES + wave, NGW = gridDim.x * NWAVES;
  const float* w_in = p.in[2]; const float* w_out = p.in[22]; const float* ffn_up = p.in[24]; const float* ffn_down = p.in[27];
  bf16* WIN = (bf16*)(p.ws + WS_WIN); bf16* WOUT = (bf16*)(p.ws + WS_WOUT); bf16* WUP = (bf16*)(p.ws + WS_WUP); bf16* WDN = (bf16*)(p.ws + WS_WDN);
  constexpr int I_IN = 16 * (NPROJ / 32), I_OUT = 16 * 32, I_UP = 16 * (2 * DFF / 32), I_DN = 44 * 32, I_CW = 2 * 32 * 4, NITEMS = I_IN + I_OUT + I_UP + I_DN + I_CW;
  for (int it = gw; it < NITEMS; it += NGW) {
    int r = it;
    if (r < I_IN) { const int nr = NPROJ / 32, kb = r / nr, run = r % nr; int src, nv; proj_src(32 * run, src, nv); tr_item(w_in, DIN, 64 * kb, src, nv, WIN, D_, 32 * run, scr, lane); continue; } r -= I_IN;
    if (r < I_OUT) { const int kb = r / 32, run = r % 32; tr_item(w_out, D_, 64 * kb, 32 * run, 32, WOUT, D_, 32 * run, scr, lane); continue; } r -= I_OUT;
    if (r < I_UP) { const int nr = 2 * DFF / 32, kb = r / nr, run = r % nr; const int c = 32 * run; const int src = ((c >> 7) & 1) * DFF + 128 * (c >> 8) + (c & 127);
      tr_item(ffn_up, 2 * DFF, 64 * kb, src, 32, WUP, D_, c, scr, lane); continue; } r -= I_UP;
    if (r < I_DN) { const int kb = r / 32, run = r % 32; tr_item(ffn_down, D_, 64 * kb, 32 * run, 32, WDN, DFF, 32 * run, scr, lane); continue; } r -= I_DN;
    { const int kv = r >> 7, kb = (r >> 2) & 31, run = r & 3; tr_item(p.in[6] + (size_t)kv * 2048 * 128, 128, 64 * kb, 32 * run, 32, (bf16*)(p.ws + WS_CW1T) + (size_t)kv * 128 * 2048, 2048, 32 * run, scr, lane); }
  }
  { bf16* LW = (bf16*)(p.ws + WS_LORAW); const float* w2 = p.in[13]; const float* a2 = p.in[15]; const float* g2 = p.in[16];
    for (int i = blockIdx.x * NTHREADS + wave * 64 + lane; i < NLORA * KLORA; i += gridDim.x * NTHREADS) { const int n = i >> 8, k = i & 255; float v = 0.f;
      if (n < 512) { if (k < 64) v = w2[k * 512 + n]; } else if (n < 1024) { if (k >= 64 && k < 128) v = a2[(k - 64) * 512 + n - 512]; } else { if (k >= 128) v = g2[(k - 128) * 512 + n - 1024]; }
      LW[i] = (bf16)f2bf(v); } }
  { float* b1p = (float*)(p.ws + WS_B1P); const float* pos = p.in[5]; const float* w1 = p.in[6]; const float* b1 = p.in[7];
    for (int o = gw; o < 256; o += NGW) { const int kv = o >> 7, j = o & 127; float s = 0.f;
      for (int k = lane; k < 2048; k += 64) s += pos[kv * 2048 + k] * w1[((size_t)kv * 2048 + k) * 128 + j];
      s = wsum(s); if (lane == 0) b1p[o] = s + b1[o]; } }
  { const float* x = p.in[0]; const float* g = p.in[1]; bf16* XN = (bf16*)(p.ws + WS_XN);
    for (int m = gw; m < M_; m += NGW) rms_row_to_bf16(x + (size_t)m * D_, g, XN + (size_t)m * D_, lane); }
}

__device__ __forceinline__ void phase_mid(const Params& p, LAS unsigned char* lds, int wave, int lane) {
  const int tid = wave * 64 + lane;
  {
    LAS bf16* blk = (LAS bf16*)lds;
    LAS float* hid = (LAS float*)(lds + 16 * 2056 * 2);
    const float* w2 = p.in[8]; const float* b2 = p.in[9]; const float* kg0 = p.in[4]; const float* b1p = (const float*)(p.ws + WS_B1P);
    const bf16* CW1T = (const bf16*)(p.ws + WS_CW1T);
    bf16* CMP = (bf16*)(p.ws + WS_CMP);
    const int col = lane & 15, q = lane >> 4;
    for (int it = blockIdx.x; it < 256; it += gridDim.x) {
      const int kv = it >> 7, slab = (it >> 5) & 3, ct = it & 31, c0 = ct * 16;
      const bf16* src = (const bf16*)(p.ws + WS_SLAB) + ((size_t)kv * 4 + slab) * (8192 * 64) + (size_t)c0 * 16 * 64;
      for (int i = tid; i < 16 * 256; i += NTHREADS) { const int c = i >> 8, ch8 = i & 255; v4u v = {0u, 0u, 0u, 0u}; if ((c0 + c) * 16 + (ch8 >> 3) < 8192) v = *(const v4u*)(src + (size_t)c * 1024 + ch8 * 8); *(LAS v4u*)(blk + c * 2056 + ch8 * 8) = v; }
      __syncthreads();
      {
        f32x4 acc0 = {0.f, 0.f, 0.f, 0.f}, acc1 = {0.f, 0.f, 0.f, 0.f};
        const bf16* bp = CW1T + ((size_t)kv * 128 + 16 * wave + col) * 2048 + 8 * q; const LAS bf16* ap = blk + col * 2056 + 8 * q;
#pragma unroll 8
        for (int ks = 0; ks < 64; ks += 2) {
          acc0 = __builtin_amdgcn_mfma_f32_16x16x32_bf16(*(const LAS bf16x8*)(ap + 32 * ks), *(const bf16x8*)(bp + 32 * ks), acc0, 0, 0, 0);
          acc1 = __builtin_amdgcn_mfma_f32_16x16x32_bf16(*(const LAS bf16x8*)(ap + 32 * ks + 32), *(const bf16x8*)(bp + 32 * ks + 32), acc1, 0, 0, 0); }
        const float bb = b1p[kv * 128 + 16 * wave + col];
#pragma unroll
        for (int r = 0; r < 4; ++r) hid[(4 * q + r) * 128 + 16 * wave + col] = gelu_tanh(acc0[r] + acc1[r] + bb);
      }
      __syncthreads();
#pragma unroll
      for (int cc = 0; cc < 2; ++cc) { const int c = wave * 2 + cc; float o = b2[kv * 64 + lane];
        for (int k = 0; k < 128; ++k) o += hid[c * 128 + k] * w2[((size_t)kv * 128 + k) * 64 + lane];
        if (kv == 0) { const float ss = wsum(o * o); o = o * rsqrtf(ss * (1.f / 64.f) + 1e-6f) * kg0[lane]; }
        CMP[(((size_t)kv * 4 + slab) * 512 + c0 + c) * 64 + lane] = (c0 + c < 511) ? (bf16)f2bf(o) : (bf16)0; }
      __syncthreads();
    }
  }
  {
    const bf16* RW = (const bf16*)(p.ws + WS_RW); bf16* ACT = (bf16*)(p.ws + WS_ACT); const float* mu = p.in[11];
    const int gw = blockIdx.x * NWAVES + wave, NGW = gridDim.x * NWAVES;
    for (int m = gw; m < M_; m += NGW) {
      const int t = m & (T_ - 1); const bf16* cur = RW + (size_t)m * 1792 + 1536 + lane * 4; float o[4];
#pragma unroll
      for (int i = 0; i < 4; ++i) { const float c = bf2f(cur[i]); const float pv = t > 0 ? bf2f(cur[i - 1792]) : 0.f; const float v = c + (pv - c) * mu[1536 + lane * 4 + i];
        o[i] = (lane < 16) ? tanhf(v) : (lane < 32) ? v : sigm(v); }
      *(unsigned long long*)(ACT + (size_t)m * 256 + lane * 4) = (unsigned long long)pk2(o[0], o[1]) | ((unsigned long long)pk2(o[2], o[3]) << 32);
    }
  }
}

__device__ __forceinline__ rwkv::Tensors rwkv_tensors(const Params& p) {
  const size_t CB = (size_t)16 * 128 * 4096; bf16* CH = (bf16*)p.out;
  rwkv::Tensors T{(const bf16*)(p.ws + WS_RW), (const bf16*)(p.ws + WS_LORA), p.in[11], p.in[12], p.in[14], p.in[17], p.in[18], p.in[19], p.in[20], p.in[21],
                  CH, CH + CB, CH + 2 * CB, CH + 3 * CB, (bf16*)(p.ws + WS_HT), (float*)(p.ws + WS_PC), (float*)(p.ws + WS_BON), (bf16*)(p.ws + WS_VM), (bf16*)(p.ws + WS_MIX)};
  return T;
}
__device__ __forceinline__ void phase_p1(const Params& p, LAS unsigned char* lds) {
  const rwkv::Tensors T = rwkv_tensors(p);
  for (int it = blockIdx.x; it < 16 * 128; it += gridDim.x) rwkv::p1_item(T, it >> 7, it & 127, lds);
}
__device__ __forceinline__ void phase_attn(const Params& p, LAS unsigned char* lds, int wave, int lane, int rep) {
  if (blockIdx.x < 16) {
    if (wave < 4) { const rwkv::Tensors T = rwkv_tensors(p); rwkv::scan_head(T, blockIdx.x, wave, lane); }
    __syncthreads();
  }
  const bf16* SL = (const bf16*)(p.ws + WS_SLAB); const size_t SS = (size_t)4 * 8192 * 64;
  nsa::Tensors T{(const bf16*)(p.ws + WS_Q), SL + 2 * SS, SL + 3 * SS, SL + 4 * SS, SL + 5 * SS, (const bf16*)(p.ws + WS_CMP), (const bf16*)(p.ws + WS_CMP) + (size_t)4 * 512 * 64,
                 (const float*)(p.ws + WS_GATES), p.in[10], (bf16*)(p.ws + WS_MIX)};
  unsigned* ctr = (unsigned*)(p.ws + WS_CTL) + rep;
  LAS unsigned* nxt = (LAS unsigned*)(lds + nsa::L_BYTES);
  for (;;) {
    if (wave == 0 && lane == 0) *nxt = atomicAdd(ctr, 1u);
    __syncthreads();
    const unsigned i = (unsigned)__builtin_amdgcn_readfirstlane((int)*nxt);
    __syncthreads();
    if (i >= 512u) break;
    nsa::unit(T, (int)(i & 1u), (int)((i >> 1) & 1u), 127 - (int)(i >> 2), lds);
  }
}
__device__ __forceinline__ void phase_p2(const Params& p, int wave, int lane) {
  const rwkv::Tensors T = rwkv_tensors(p);
  const int gw = blockIdx.x * NWAVES + wave, NGW = gridDim.x * NWAVES;
  for (int w = gw; w < 16 * 128 * 4; w += NGW) rwkv::p2_item(T, w >> 9, (w >> 2) & 127, w & 3, lane);
}

__device__ __forceinline__ void phase_rms2(const Params& p, int wave, int lane) {
  const int gw = blockIdx.x * NWAVES + wave, NGW = gridDim.x * NWAVES; bf16* XN = (bf16*)(p.ws + WS_XN);
  for (int m = gw; m < M_; m += NGW) rms_row_to_bf16(p.out + (size_t)m * D_, p.in[23], XN + (size_t)m * D_, lane);
}
constexpr int NPHASE = 11;
#ifndef REP_MASK
#define REP_MASK 0u
#endif
__global__ void __launch_bounds__(NTHREADS, 2) mk_fwd(Params p) {
  extern __shared__ __attribute__((aligned(16))) unsigned char lds_raw[];
  LAS unsigned char* lds = (LAS unsigned char*)lds_raw;
  cg::grid_group grid = cg::this_grid();
  volatile LAS unsigned* bst = (volatile LAS unsigned*)(lds + LDS_BYTES - 64);
  if (threadIdx.x < 16) bst[threadIdx.x] = 0u;
  mk_tid_init();
  __syncthreads();
  XcdBarrier xbar = xcd_barrier_post((unsigned*)(p.ws + WS_CTL) + 1024 + p.li * XCD_BAR_WORDS, bst);
  const int lo = p.ph_lo, hi = p.ph_hi;
#define IN(k) (lo <= (k) && (k) < hi)
#define SEAM(k) do { if (IN(k) && IN((k) + 1)) { if ((k) == 0) grid.sync(); else xcd_barrier(xbar); } } while (0)
  unsigned char* ws = p.ws;
#define LW int tid_ = mk_tid(); asm volatile("" : "+v"(tid_)); const int lane = tid_ & 63, wave = __builtin_amdgcn_readfirstlane(tid_ >> 6); (void)lane; (void)wave;
#define PH(k, ...) do { if (IN(k)) { _Pragma("unroll 1") for (int rep_ = 0; rep_ < 1 + (int)((REP_MASK >> (k)) & 1u); ++rep_) { if (rep_) grid.sync(); __VA_ARGS__ } } SEAM(k); } while (0)
  PH(0, { LW phase_prologue(p, lds, wave, lane); });
  PH(1, { pg8::Gemm g{(const pg8::bf16_t*)(ws + WS_XN), (const pg8::bf16_t*)(ws + WS_WIN), M_, NPROJ, D_}; pg8::StaticOrder S; S.init(M_, NPROJ, gridDim.x, blockIdx.x);
    pg8::EpiProj E{(pg8::bf16_t*)(ws + WS_Q), (pg8::bf16_t*)(ws + WS_SLAB), (pg8::bf16_t*)(ws + WS_RW), (float*)(ws + WS_GATES), p.in[3], p.in[4]};
    pg8::gemm_phase<pg8::EpiProj, pg8::StaticOrder, true, true>(lds, g, S, E); });
  PH(2, { LW phase_mid(p, lds, wave, lane); });
  PH(3, { pg8::Gemm g{(const pg8::bf16_t*)(ws + WS_ACT), (const pg8::bf16_t*)(ws + WS_LORAW), M_, NLORA, KLORA}; pg8::StaticOrder S; S.init(M_, NLORA, gridDim.x, blockIdx.x);
    pg8::EpiBf16<0> E{(pg8::bf16_t*)(ws + WS_LORA), NLORA, nullptr, 0, 0, 1.f};
    pg8::gemm_phase<pg8::EpiBf16<0>, pg8::StaticOrder, true, true>(lds, g, S, E); });
  PH(4, { phase_p1(p, lds); });
  PH(5, { LW phase_attn(p, lds, wave, lane, rep_); });
  PH(6, { LW phase_p2(p, wave, lane); });
  PH(7, { pg8::Gemm g{(const pg8::bf16_t*)(ws + WS_MIX), (const pg8::bf16_t*)(ws + WS_WOUT), M_, D_, D_}; pg8::StaticOrder S; S.init(M_, D_, gridDim.x, blockIdx.x);
    pg8::EpiResF32 E{p.in[0], p.out, D_};
    pg8::gemm_phase<pg8::EpiResF32, pg8::StaticOrder, true, true>(lds, g, S, E); });
  PH(8, { LW phase_rms2(p, wave, lane); });
  PH(9, { pg8::Gemm g{(const pg8::bf16_t*)(ws + WS_XN), (const pg8::bf16_t*)(ws + WS_WUP), 66 * 256, 2 * DFF, D_}; pg8::StaticOrder S; S.init(66 * 256, 2 * DFF, gridDim.x, blockIdx.x);
    pg8::EpiConvGate E{(pg8::bf16_t*)(ws + WS_ACT2), p.in[25], p.in[26]};
    pg8::gemm_phase<pg8::EpiConvGate, pg8::StaticOrder, true, true, 1>(lds, g, S, E); });
  if (IN(10)) { pg8::Gemm g{(const pg8::bf16_t*)(ws + WS_ACT2), (const pg8::bf16_t*)(ws + WS_WDN), M_, D_, DFF}; pg8::StaticOrder S; S.init(M_, D_, gridDim.x, blockIdx.x);
    pg8::EpiResF32 E{p.out, p.out, D_};
    pg8::gemm_phase<pg8::EpiResF32, pg8::StaticOrder, true, true>(lds, g, S, E); }
#undef PH
#undef IN
#undef SEAM
}
}

#ifndef MK_N_LAUNCHES
#define MK_N_LAUNCHES 1
#endif
extern "C" void kernel_launch(void* const* d_in, const int* in_sizes, int n_in, void* d_out, int out_size, void* d_ws, size_t ws_size, hipStream_t stream) {
  static int grid = 0;
  if (grid == 0) {
    if (n_in != 28 || out_size != M_ * D_ || ws_size < WS_END) { fprintf(stderr, "kernel_launch: unexpected shapes (n_in %d out %d ws %zu)\n", n_in, out_size, ws_size); grid = -1; return; }
    int dev = 0, cus = 0, per_cu = 0; hipGetDevice(&dev); hipDeviceGetAttribute(&cus, hipDeviceAttributeMultiprocessorCount, dev);
    if (hipFuncSetAttribute((const void*)mk_fwd, hipFuncAttributeMaxDynamicSharedMemorySize, LDS_BYTES) != hipSuccess) { fprintf(stderr, "kernel_launch: hipFuncSetAttribute failed\n"); grid = -1; return; }
    if (hipOccupancyMaxActiveBlocksPerMultiprocessor(&per_cu, (const void*)mk_fwd, NTHREADS, LDS_BYTES) != hipSuccess || per_cu < 1) { fprintf(stderr, "kernel_launch: occupancy query says %d\n", per_cu); (void)hipGetLastError(); per_cu = 1; }
    grid = cus;
    fprintf(stderr, "kernel_launch: cus %d per_cu %d grid %d\n", cus, per_cu, grid);
  }
  if (grid < 0) return;
  Params p{};
  for (int i = 0; i < 28; ++i) p.in[i] = (const float*)d_in[i];
  p.out = (float*)d_out; p.ws = (unsigned char*)d_ws;
#ifndef PROBE_PHASE
#define PROBE_PHASE -1
#endif
  if (hipMemsetAsync((char*)d_ws + WS_CTL, 0, 65536, stream) != hipSuccess) { fprintf(stderr, "kernel_launch: memset failed\n"); return; }
  const int nl = (PROBE_PHASE >= 0) ? 3 : MK_N_LAUNCHES;
  for (int li = 0; li < nl; ++li) {
    if (PROBE_PHASE >= 0) { p.ph_lo = li == 0 ? 0 : (li == 1 ? PROBE_PHASE : PROBE_PHASE + 1); p.ph_hi = li == 0 ? PROBE_PHASE + 1 : (li == 1 ? PROBE_PHASE + 1 : NPHASE); if (p.ph_lo >= p.ph_hi) continue; }
    else { p.ph_lo = (MK_N_LAUNCHES == 1) ? 0 : li; p.ph_hi = (MK_N_LAUNCHES == 1) ? NPHASE : li + 1; }
    p.li = li; void* args[] = {&p};
    hipError_t e = hipLaunchCooperativeKernel((const void*)mk_fwd, dim3(grid), dim3(NTHREADS), args, LDS_BYTES, stream);
    if (e != hipSuccess) { fprintf(stderr, "kernel_launch: cooperative launch %d failed: %s\n", li, hipGetErrorString(e)); break; }
  }
}
```

```cpp
#include <hip/hip_runtime.h>
#include <hip/hip_cooperative_groups.h>
#include <cstdio>
#include <cstdint>
namespace cg = cooperative_groups;

#define MK_LAS __attribute__((address_space(3)))
constexpr int MK_TIDTAB = 147456 - 512;
__device__ __forceinline__ int mk_slot() { return (int)(__builtin_amdgcn_s_getreg((5 << 11) | 4) & 63u); }
__device__ __forceinline__ void mk_tid_init() { if ((threadIdx.x & 63u) == 0u) *(volatile MK_LAS int*)(MK_TIDTAB + 4 * mk_slot()) = (int)(threadIdx.x >> 6); }
__device__ __forceinline__ int mk_tid() { const int w = __builtin_amdgcn_readfirstlane(*(volatile MK_LAS int*)(MK_TIDTAB + 4 * mk_slot())); int l; asm volatile("v_mbcnt_lo_u32_b32 %0, -1, 0\n\tv_mbcnt_hi_u32_b32 %0, -1, %0" : "=v"(l)); return w * 64 + l; }
__device__ __forceinline__ int mk_lane() { int l; asm volatile("v_mbcnt_lo_u32_b32 %0, -1, 0\n\tv_mbcnt_hi_u32_b32 %0, -1, %0" : "=v"(l)); return l; }
__device__ __forceinline__ float mk_shx(float v, int m) { return __int_as_float(__builtin_amdgcn_ds_bpermute((mk_lane() ^ m) << 2, __float_as_int(v))); }
__device__ __forceinline__ int mk_shx(int v, int m) { return __builtin_amdgcn_ds_bpermute((mk_lane() ^ m) << 2, v); }
__device__ __forceinline__ unsigned mk_shx(unsigned v, int m) { return (unsigned)__builtin_amdgcn_ds_bpermute((mk_lane() ^ m) << 2, (int)v); }
#define __shfl_xor(v, m) mk_shx((v), (m))
namespace pg8 {
#define PG8_LAS __attribute__((address_space(3)))
typedef unsigned short bf16_t;
typedef short bf16x8 __attribute__((ext_vector_type(8)));
typedef float f32x4 __attribute__((ext_vector_type(4)));
typedef unsigned u32x4 __attribute__((ext_vector_type(4)));
constexpr int BM = 256, BK = 64, HALF = 128, HTB = HALF * BK * 2  , STAGE_BYTES = 8 * HTB, NXCD = 8, WGM = 8;

__host__ __device__ __forceinline__ int lds_byte(int r, int c) { const int st = (r >> 4) * 2 + (c >> 5), rr = r & 15, cc = c & 31, ob = rr * 64 + cc * 2; return st * 1024 + (ob ^ (((ob >> 9) & 1) << 5)); }
__host__ __device__ __forceinline__ void stage_rc(int b, int& R, int& C) { const int st = b / 1024, sb = b % 1024, swz = sb ^ (((sb >> 9) & 1) << 5); R = (st >> 1) * 16 + swz / 64; C = (st & 1) * 32 + (swz % 64) / 2; }
__host__ __device__ __forceinline__ int perm32(int rho) { const int n = rho >> 4, i = rho & 15; return 8 * (i >> 2) + 4 * n + (i & 3); }

struct Unit { int pm, pn; };
struct Gemm { const bf16_t* A; const bf16_t* Bt; int M, N, K; };

struct StaticOrder {
    int nM, nN, nwg, G, c;
    __host__ __device__ void init(int M, int N, int G_, int c_) { nM = M / BM; nN = N / BM; nwg = nM * nN; G = G_; c = c_; }
    __host__ __device__ bool next(int i, Unit& u) const {
        const long L = (long)i * G + c; if (L >= nwg) return false;
        int wgid = (int)L; { const int q = nwg / NXCD, r = nwg % NXCD, xcd = wgid % NXCD, off = wgid / NXCD; wgid = (xcd < r ? xcd * (q + 1) : r * (q + 1) + (xcd - r) * q) + off; }
        const int nig = WGM * nN, gid = wgid / nig, fm = gid * WGM, gsz = (nM - fm) < WGM ? (nM - fm) : WGM;
        u.pm = fm + ((wgid % nig) % gsz); u.pn = (wgid % nig) / gsz; return true;
    }
    __device__ __forceinline__ void a_ready(const Unit&) const {}
    __device__ __forceinline__ void done(const Unit&) const {}
};

__device__ __forceinline__ unsigned cvt_pk_bf16(float lo, float hi) { unsigned r; asm volatile("v_cvt_pk_bf16_f32 %0, %1, %2" : "=v"(r) : "v"(lo), "v"(hi)); return r; }
typedef float f32x2 __attribute__((ext_vector_type(2)));
__device__ __forceinline__ f32x2 gelu_pk(f32x2 v) {
    const f32x2 av = __builtin_elementwise_abs(v), d = av * 0.2316418882f + 1.0f;
    f32x2 t; t.x = __builtin_amdgcn_rcpf(d.x); t.y = __builtin_amdgcn_rcpf(d.y);
    f32x2 q = t * 0.5307027145f + (-0.7265760135f); q = q * t + 0.7107068705f; q = q * t + (-0.142248368f); q = q * t + 0.127414796f; q = q * t;
    const f32x2 s = (v * v) * (-0.72134752044f);
    f32x2 e; e.x = __builtin_amdgcn_exp2f(s.x); e.y = __builtin_amdgcn_exp2f(s.y);
    const f32x2 m = v * (q * e), r = v - m;
    f32x2 o; o.x = v.x < 0.f ? m.x : r.x; o.y = v.y < 0.f ? m.y : r.y; return o;
}

template <int ACT  > struct EpiBf16 {
    static constexpr bool PERM = true, AFTER_DRAIN = false; static_assert(ACT == 0 || ACT == 1, "EpiBf16: ACT is 0 (none) or 1 (gelu_pk)");
    bf16_t* O; int ldc; const float* bias; int split_cols; size_t split_stride; float scale0;
    __device__ __forceinline__ void operator()(const f32x4 (&acc)[2][2][4][2], const Unit& u, int wr, int wc, int, int) const {
        const int l_ = mk_lane(), fr = l_ & 15, fq = l_ >> 4;
        const int row0 = u.pm * BM + wr * 64 + fr; int colt = u.pn * BM; bf16_t* base = O;
        float sc = 1.f; if (split_cols) { const int t = colt / split_cols; base += (size_t)t * split_stride; colt -= t * split_cols; if (t == 0) sc = scale0; }
        const int col0 = colt + wc * 32 + 8 * fq, bcol0 = u.pn * BM + wc * 32 + 8 * fq;
        f32x4 bv[2][2];
#pragma unroll
        for (int bj = 0; bj < 2; ++bj)
#pragma unroll
            for (int n = 0; n < 2; ++n) bv[bj][n] = bias ? *(const f32x4*)(bias + bcol0 + bj * HALF + 4 * n) : (f32x4){0.f, 0.f, 0.f, 0.f};
#pragma unroll
        for (int ai = 0; ai < 2; ++ai)
#pragma unroll
            for (int m = 0; m < 4; ++m) { bf16_t* rowp = base + (size_t)(row0 + ai * HALF + m * 16) * ldc + col0;
#pragma unroll
                for (int bj = 0; bj < 2; ++bj) { f32x4 v0 = acc[ai][bj][m][0] + bv[bj][0], v1 = acc[ai][bj][m][1] + bv[bj][1];
                    if (ACT == 1) { f32x2 a = gelu_pk((f32x2){v0[0], v0[1]}), b = gelu_pk((f32x2){v0[2], v0[3]}), c = gelu_pk((f32x2){v1[0], v1[1]}), d = gelu_pk((f32x2){v1[2], v1[3]});
                        v0 = (f32x4){a.x, a.y, b.x, b.y}; v1 = (f32x4){c.x, c.y, d.x, d.y}; }
                    v0 = v0 * sc; v1 = v1 * sc; u32x4 w; w.x = cvt_pk_bf16(v0[0], v0[1]); w.y = cvt_pk_bf16(v0[2], v0[3]); w.z = cvt_pk_bf16(v1[0], v1[1]); w.w = cvt_pk_bf16(v1[2], v1[3]);
                    *(u32x4*)(rowp + bj * HALF) = w; } }
    }
};
struct EpiResF32 {
    static constexpr bool PERM = false, AFTER_DRAIN = false;
    const float* base; float* out; int ldc;
    __device__ __forceinline__ void operator()(const f32x4 (&acc)[2][2][4][2], const Unit& u, int wr, int wc, int, int) const {
        const int l_ = mk_lane(), fr = l_ & 15, fq = l_ >> 4;
        const int row0 = u.pm * BM + wr * 64 + fr, col0 = u.pn * BM + wc * 32 + 4 * fq;
#pragma unroll
        for (int ai = 0; ai < 2; ++ai)
#pragma unroll
            for (int m = 0; m < 4; ++m) { const size_t off = (size_t)(row0 + ai * HALF + m * 16) * ldc + col0;
#pragma unroll
                for (int bj = 0; bj < 2; ++bj)
#pragma unroll
                    for (int n = 0; n < 2; ++n) { const f32x4 b = *(const f32x4*)(base + off + bj * HALF + n * 16); *(f32x4*)(out + off + bj * HALF + n * 16) = b + acc[ai][bj][m][n]; } }
    }
};
struct EpiConvGate {
    static constexpr bool PERM = true, AFTER_DRAIN = false;
    bf16_t* ACT2; const float* cw; const float* cb;
    __device__ __forceinline__ void operator()(f32x4 (&acc)[2][2][4][2], const Unit& u, int wr, int wc, int, int) const {
        const int l_ = mk_lane(), fr = l_ & 15, fq = l_ >> 4;
        const int b = u.pm / 33, it = u.pm % 33, tb = it * 252 - 2 + wr * 126 + fr * 8, j0 = 128 * u.pn + 32 * wc + 8 * fq;
        if (tb < 0) {
#pragma unroll
            for (int bj = 0; bj < 2; ++bj)
#pragma unroll
                for (int n = 0; n < 2; ++n) { acc[0][bj][0][n] = (f32x4){0.f, 0.f, 0.f, 0.f}; acc[0][bj][1][n] = (f32x4){0.f, 0.f, 0.f, 0.f}; } }
#pragma unroll
        for (int n = 0; n < 2; ++n) {
            const f32x4 bv = *(const f32x4*)(cb + j0 + 4 * n), bg = *(const f32x4*)(cb + 2816 + j0 + 4 * n);
            f32x4 wv[3], wg[3];
#pragma unroll
            for (int k = 0; k < 3; ++k) { wv[k] = *(const f32x4*)(cw + k * 5632 + j0 + 4 * n); wg[k] = *(const f32x4*)(cw + k * 5632 + 2816 + j0 + 4 * n); }
            f32x4 hv[2], hg[2];
#pragma unroll
            for (int e = 0; e < 4; ++e) {
                hv[0][e] = __int_as_float(__builtin_amdgcn_update_dpp(0, __float_as_int(acc[1][0][2][n][e]), 0x111, 0xf, 0xf, false));
                hv[1][e] = __int_as_float(__builtin_amdgcn_update_dpp(0, __float_as_int(acc[1][0][3][n][e]), 0x111, 0xf, 0xf, false));
                hg[0][e] = __int_as_float(__builtin_amdgcn_update_dpp(0, __float_as_int(acc[1][1][2][n][e]), 0x111, 0xf, 0xf, false));
                hg[1][e] = __int_as_float(__builtin_amdgcn_update_dpp(0, __float_as_int(acc[1][1][3][n][e]), 0x111, 0xf, 0xf, false)); }
#pragma unroll
            for (int o = 0; o < 8; ++o) {
                const int t = tb + o; const bool ok = (o >= 2 || fr > 0) && t >= 0 && t < 8192;
                const f32x4 v2 = (o >= 2) ? acc[(o - 2) >> 2][0][(o - 2) & 3][n] : hv[o & 1], v1 = (o >= 1) ? acc[(o - 1) >> 2][0][(o - 1) & 3][n] : hv[1], v0 = acc[o >> 2][0][o & 3][n];
                const f32x4 g2 = (o >= 2) ? acc[(o - 2) >> 2][1][(o - 2) & 3][n] : hg[o & 1], g1 = (o >= 1) ? acc[(o - 1) >> 2][1][(o - 1) & 3][n] : hg[1], g0 = acc[o >> 2][1][o & 3][n];
                const f32x4 uv = bv + wv[0] * v2 + wv[1] * v1 + wv[2] * v0, ug = bg + wg[0] * g2 + wg[1] * g1 + wg[2] * g0;
                float r[4];
#pragma unroll
                for (int e = 0; e < 4; ++e) r[e] = ug[e] * __builtin_amdgcn_rcpf(1.f + __expf(-ug[e])) * uv[e];
                unsigned long long w = (unsigned long long)cvt_pk_bf16(r[0], r[1]) | ((unsigned long long)cvt_pk_bf16(r[2], r[3]) << 32);
                if (ok) *(unsigned long long*)(ACT2 + ((size_t)b * 8192 + t) * 2816 + j0 + 4 * n) = w;
            }
        }
    }
};
struct EpiProj {
    static constexpr bool PERM = true, AFTER_DRAIN = false; static constexpr float QS = 0.125f * 1.4426950408889634f;
    bf16_t* Q; bf16_t* SLAB;   bf16_t* RW; float* GATES; const float* qg; const float* kg;
    __device__ __forceinline__ void operator()(const f32x4 (&acc)[2][2][4][2], const Unit& u, int wr, int wc, int, int) const {
        const int l_ = mk_lane(), fr = l_ & 15, fq = l_ >> 4;
        const int grp = 4 * u.pn + wc;
        if (grp >= 49) return;
        const int row0 = u.pm * BM + wr * 64 + fr, d0 = 8 * fq;
        int kind; const float* g = nullptr;
        if (grp < 8) { kind = 1; g = qg; } else if (grp < 20) { const int which = (grp - 8) >> 1; kind = (which == 2 || which == 4) ? 1 : 0; g = kg + (which == 2 ? 64 : 128); } else if (grp == 20) kind = 2; else kind = 0;
        float gv[16];
        if (kind == 1) {
#pragma unroll
            for (int i = 0; i < 8; ++i) { gv[i] = g[d0 + i]; gv[8 + i] = g[32 + d0 + i]; }
        }
#pragma unroll
        for (int ai = 0; ai < 2; ++ai)
#pragma unroll
            for (int m = 0; m < 4; ++m) {
                const int row = row0 + ai * HALF + m * 16;
                f32x4 v0 = acc[ai][0][m][0], v1 = acc[ai][0][m][1], v2 = acc[ai][1][m][0], v3 = acc[ai][1][m][1];
                if (kind == 2) {
                    if (fq < 3) { float* gp = GATES + (size_t)row * 32 + d0;
                        f32x4 a, b;
#pragma unroll
                        for (int i = 0; i < 4; ++i) { a[i] = 1.f / (1.f + __expf(-v0[i])); b[i] = 1.f / (1.f + __expf(-v1[i])); }
                        *(f32x4*)gp = a; *(f32x4*)(gp + 4) = b; }
                    continue;
                }
                if (kind == 1) {
                    float ss = 0.f;
#pragma unroll
                    for (int i = 0; i < 4; ++i) ss += v0[i] * v0[i] + v1[i] * v1[i] + v2[i] * v2[i] + v3[i] * v3[i];
                    ss += __shfl_xor(ss, 16); ss += __shfl_xor(ss, 32);
                    const float s = rsqrtf(ss * (1.f / 64.f) + 1e-6f);
#pragma unroll
                    for (int i = 0; i < 4; ++i) { v0[i] *= s * gv[i]; v1[i] *= s * gv[4 + i]; v2[i] *= s * gv[8 + i]; v3[i] *= s * gv[12 + i]; }
                    if (grp < 8) { v0 = v0 * QS; v1 = v1 * QS; v2 = v2 * QS; v3 = v3 * QS; }
                }
                bf16_t* p;
                if (grp < 8) p = Q + (size_t)row * 512 + grp * 64;
                else if (grp < 20) { const int sl = grp - 8; p = SLAB + ((size_t)(sl >> 1) * 4 + (size_t)((row >> 13) * 2 + (sl & 1))) * (8192 * 64) + (size_t)(row & 8191) * 64; }
                else p = RW + (size_t)row * 1792 + (grp - 21) * 64;
                u32x4 w0, w1; w0.x = cvt_pk_bf16(v0[0], v0[1]); w0.y = cvt_pk_bf16(v0[2], v0[3]); w0.z = cvt_pk_bf16(v1[0], v1[1]); w0.w = cvt_pk_bf16(v1[2], v1[3]);
                w1.x = cvt_pk_bf16(v2[0], v2[1]); w1.y = cvt_pk_bf16(v2[2], v2[3]); w1.z = cvt_pk_bf16(v3[0], v3[1]); w1.w = cvt_pk_bf16(v3[2], v3[3]);
                *(u32x4*)(p + d0) = w0; *(u32x4*)(p + 32 + d0) = w1;
            }
    }
};
template <class Epi, class Sched, bool ALIGN_EPI = false, bool SP2 = false, int ROWMAP = 0>
__device__ __forceinline__ void gemm_phase(PG8_LAS unsigned char* lds, const Gemm g, const Sched& S, const Epi& E) {
    const int tid = mk_tid(), wid = __builtin_amdgcn_readfirstlane(tid >> 6), lane = tid & 63, wr = wid >> 2, wc = wid & 3, fr = lane & 15, fq = lane >> 4;
    const int K = g.K, nt = K / BK;
    unsigned voffA[2], voffB[2];
#pragma unroll
    for (int i = 0; i < 2; ++i) { int R, C; stage_rc(tid * 16 + i * 8192, R, C); const int Rb = Epi::PERM ? ((R & ~31) + perm32(R & 31)) : R;
        const int Ra = ROWMAP ? ((R >> 6) * 126 + (R & 15) * 8 + ((R >> 4) & 3)) : R;
        voffA[i] = (unsigned)(Ra * K + C) * 2u; voffB[i] = (unsigned)(Rb * K + C) * 2u; }
    const size_t kstep = (size_t)(BK * 2);
    const size_t hstep = (size_t)HALF * K * 2;
    const size_t tstep = 2 * hstep;
    const size_t hstepA = ROWMAP ? (size_t)4 * K * 2 : hstep;
#define PG8_ABASE(pm) (ROWMAP ? ((long)(((pm) / 33) * 8192 + ((pm) % 33) * 252 - 2) * (long)K * 2) : (long)((size_t)(pm) * tstep))
    const unsigned ldsw = (unsigned)wid * 1024u;
    const int aoff = lds_byte(wr * 64 + fr, fq * 8), boff = lds_byte(wc * 32 + fr, fq * 8);
#define PG8_SA(b, h) (((b) * 2 + (h)) * HTB)
#define PG8_SB(b, h) ((4 + (b) * 2 + (h)) * HTB)
#define PG8_STAGE(bufoff, gbase, voff) do { _Pragma("unroll") for (int _i = 0; _i < 2; ++_i) \
        __builtin_amdgcn_global_load_lds((const unsigned*)((const char*)(gbase) + (voff)[_i]), (PG8_LAS unsigned*)(lds + (bufoff) + ldsw + _i * 8192), 16, 0, 0); } while (0)
#define PG8_LDA(dst, b, h) do { _Pragma("unroll") for (int m = 0; m < 4; ++m) _Pragma("unroll") for (int k = 0; k < 2; ++k) dst[m][k] = *(const PG8_LAS bf16x8*)(lds + PG8_SA(b, h) + aoff + m * 2048 + k * 1024); } while (0)
#define PG8_LDB(dst, b, h) do { _Pragma("unroll") for (int n = 0; n < 2; ++n) _Pragma("unroll") for (int k = 0; k < 2; ++k) dst[n][k] = *(const PG8_LAS bf16x8*)(lds + PG8_SB(b, h) + boff + n * 2048 + k * 1024); } while (0)
#define PG8_MMA(ai, bj, At, Bt) do { __builtin_amdgcn_s_setprio(1); _Pragma("unroll") for (int m = 0; m < 4; ++m) _Pragma("unroll") for (int n = 0; n < 2; ++n) _Pragma("unroll") for (int k = 0; k < 2; ++k) \
        acc[ai][bj][m][n] = __builtin_amdgcn_mfma_f32_16x16x32_bf16(Bt[n][k], At[m][k], acc[ai][bj][m][n], 0, 0, 0); __builtin_amdgcn_s_setprio(0); } while (0)
#define PG8_WAIT_V(n) asm volatile("s_waitcnt vmcnt(" #n ")" ::: "memory")
#define PG8_WAIT_L(n) asm volatile("s_waitcnt lgkmcnt(" #n ")" ::: "memory")
#define PG8_BAR __builtin_amdgcn_s_barrier()
#define PG8_SCHED __builtin_amdgcn_sched_barrier(0)
    Unit cur, nxt; int ui = 0;
    if (!S.next(0, cur)) return;
    f32x4 acc[2][2][4][2];
#pragma unroll
    for (int a = 0; a < 2; ++a)
#pragma unroll
        for (int b = 0; b < 2; ++b)
#pragma unroll
            for (int m = 0; m < 4; ++m)
#pragma unroll
                for (int n = 0; n < 2; ++n) acc[a][b][m][n] = (f32x4){0.f, 0.f, 0.f, 0.f};
    bf16x8 At[4][2], B0[2][2], B1[2][2];
    const char* cA = (const char*)g.A + PG8_ABASE(cur.pm); const char* cB = (const char*)g.Bt + (size_t)cur.pn * tstep;
    S.a_ready(cur);
    if constexpr (SP2) {
        PG8_STAGE(PG8_SB(0, 0), cB, voffB); PG8_STAGE(PG8_SB(0, 1), cB + hstep, voffB); PG8_STAGE(PG8_SA(0, 0), cA, voffA); PG8_STAGE(PG8_SA(0, 1), cA + hstepA, voffA);
        if (wr == 1) PG8_BAR;
        PG8_WAIT_V(2); PG8_BAR;
        PG8_STAGE(PG8_SB(1, 0), cB + kstep, voffB); PG8_STAGE(PG8_SA(1, 0), cA + kstep, voffA); PG8_STAGE(PG8_SB(1, 1), cB + hstep + kstep, voffB);
        PG8_WAIT_V(6); PG8_BAR;
    } else {
        PG8_STAGE(PG8_SB(0, 0), cB, voffB); PG8_STAGE(PG8_SA(0, 0), cA, voffA); PG8_STAGE(PG8_SB(0, 1), cB + hstep, voffB); PG8_STAGE(PG8_SA(0, 1), cA + hstepA, voffA);
        if (wr == 1) PG8_BAR;
        PG8_WAIT_V(4); PG8_BAR;
        PG8_STAGE(PG8_SB(1, 0), cB + kstep, voffB); PG8_STAGE(PG8_SA(1, 0), cA + kstep, voffA); PG8_STAGE(PG8_SB(1, 1), cB + hstep + kstep, voffB);
        PG8_WAIT_V(6); PG8_BAR;
    }
    for (;;) {
        const bool has_next = S.next(ui + 1, nxt);
        const char* nA = has_next ? (const char*)g.A + PG8_ABASE(nxt.pm) : cA; const char* nB = has_next ? (const char*)g.Bt + (size_t)nxt.pn * tstep : cB;
        for (int t = 0; t < nt; t += 2) {
            const bool last = (t == nt - 2);
            const char* a1 = cA + (size_t)(t + 1) * kstep;
            const char* a2 = last ? nA : cA + (size_t)(t + 2) * kstep; const char* b2 = last ? nB : cB + (size_t)(t + 2) * kstep;
            const char* a3 = a2 + kstep; const char* b3 = b2 + kstep;
            if (last && has_next) S.a_ready(nxt);
            if constexpr (SP2) {
            PG8_LDB(B0, 0, 0); PG8_LDB(B1, 0, 1); PG8_SCHED; PG8_LDA(At, 0, 0); PG8_STAGE(PG8_SA(1, 1), a1 + hstepA, voffA);
            PG8_WAIT_V(8); PG8_WAIT_L(0); PG8_BAR; PG8_MMA(0, 0, At, B0); PG8_MMA(0, 1, At, B1); PG8_BAR; PG8_SCHED;
            PG8_LDA(At, 0, 1); PG8_STAGE(PG8_SB(0, 0), b2, voffB); PG8_STAGE(PG8_SB(0, 1), b2 + hstep, voffB); PG8_STAGE(PG8_SA(0, 0), a2, voffA);
            PG8_WAIT_V(8); PG8_WAIT_L(0); PG8_BAR; PG8_MMA(1, 0, At, B0); PG8_MMA(1, 1, At, B1); PG8_BAR; PG8_SCHED;
            PG8_LDB(B0, 1, 0); PG8_LDB(B1, 1, 1); PG8_SCHED; PG8_LDA(At, 1, 0); PG8_STAGE(PG8_SA(0, 1), a2 + hstepA, voffA);
            PG8_WAIT_V(8); PG8_WAIT_L(0); PG8_BAR; PG8_MMA(0, 0, At, B0); PG8_MMA(0, 1, At, B1); PG8_BAR; PG8_SCHED;
            PG8_LDA(At, 1, 1); PG8_STAGE(PG8_SB(1, 0), b3, voffB); PG8_STAGE(PG8_SB(1, 1), b3 + hstep, voffB); PG8_STAGE(PG8_SA(1, 0), a3, voffA);
            PG8_WAIT_V(8); PG8_WAIT_L(0); PG8_BAR; PG8_MMA(1, 0, At, B0); PG8_MMA(1, 1, At, B1); PG8_BAR; PG8_SCHED;
            } else {
            PG8_LDB(B0, 0, 0); PG8_SCHED; PG8_LDA(At, 0, 0); PG8_STAGE(PG8_SA(1, 1), a1 + hstepA, voffA);
            PG8_WAIT_L(8); PG8_BAR; PG8_WAIT_L(0); PG8_MMA(0, 0, At, B0); PG8_BAR; PG8_SCHED;
            PG8_LDB(B1, 0, 1); PG8_STAGE(PG8_SB(0, 0), b2, voffB);
            PG8_BAR; PG8_WAIT_L(0); PG8_MMA(0, 1, At, B1); PG8_BAR;
            PG8_LDA(At, 0, 1); PG8_STAGE(PG8_SA(0, 0), a2, voffA);
            PG8_BAR; PG8_WAIT_L(0); PG8_MMA(1, 0, At, B0); PG8_BAR; PG8_SCHED;
            PG8_STAGE(PG8_SB(0, 1), b2 + hstep, voffB);
            PG8_WAIT_V(6); PG8_BAR; PG8_MMA(1, 1, At, B1); PG8_BAR;
            PG8_LDB(B0, 1, 0); PG8_SCHED; PG8_LDA(At, 1, 0); PG8_STAGE(PG8_SA(0, 1), a2 + hstepA, voffA);
            PG8_WAIT_L(8); PG8_BAR; PG8_WAIT_L(0); PG8_MMA(0, 0, At, B0); PG8_BAR; PG8_SCHED;
            PG8_LDB(B1, 1, 1); PG8_STAGE(PG8_SB(1, 0), b3, voffB);
            PG8_BAR; PG8_WAIT_L(0); PG8_MMA(0, 1, At, B1); PG8_BAR;
            PG8_LDA(At, 1, 1); PG8_STAGE(PG8_SA(1, 0), a3, voffA);
            PG8_BAR; PG8_WAIT_L(0); PG8_MMA(1, 0, At, B0); PG8_BAR; PG8_SCHED;
            PG8_STAGE(PG8_SB(1, 1), b3 + hstep, voffB);
            PG8_WAIT_V(6); PG8_BAR; PG8_MMA(1, 1, At, B1); PG8_BAR;
            }
        }
        if constexpr (ALIGN_EPI) { if (wr == 0) PG8_BAR; }
        if constexpr (!Epi::AFTER_DRAIN) { E(acc, cur, wr, wc, fr, fq); S.done(cur); }
        if (!has_next) break;
#pragma unroll
        for (int a = 0; a < 2; ++a)
#pragma unroll
            for (int b = 0; b < 2; ++b)
#pragma unroll
                for (int m = 0; m < 4; ++m)
#pragma unroll
                    for (int n = 0; n < 2; ++n) acc[a][b][m][n] = (f32x4){0.f, 0.f, 0.f, 0.f};
        cur = nxt; cA = nA; cB = nB; ++ui;
        if constexpr (ALIGN_EPI) { if (wr == 1) PG8_BAR; }
    }
    PG8_WAIT_V(0);
    if constexpr (!ALIGN_EPI) { if (wr == 0) PG8_BAR; }
    PG8_BAR;
    if constexpr (Epi::AFTER_DRAIN) { E.fused(acc, cur, wr, wc, fr, fq, lds, wid, lane); S.done(cur); }
#undef PG8_ABASE
#undef PG8_SA
#undef PG8_SB
#undef PG8_STAGE
#undef PG8_LDA
#undef PG8_LDB
#undef PG8_MMA
#undef PG8_WAIT_V
#undef PG8_WAIT_L
#undef PG8_BAR
#undef PG8_SCHED
}
}

namespace nsa {
#define NLAS __attribute__((address_space(3)))
typedef short bf16x8 __attribute__((ext_vector_type(8)));
typedef short s16x4 __attribute__((ext_vector_type(4)));
typedef float f32x16 __attribute__((ext_vector_type(16)));
typedef unsigned u32x4 __attribute__((ext_vector_type(4)));
typedef short v4i16_t __attribute__((ext_vector_type(4)));
typedef unsigned short bf16;
typedef float f32x2_t __attribute__((ext_vector_type(2))); typedef __bf16 bf16x2_t __attribute__((ext_vector_type(2)));

constexpr float LOG2E = 1.4426950408889634f;
constexpr float QSCALE = 0.125f * LOG2E;
constexpr float NEGBIG = -1e30f;
constexpr int L_K = 0, L_V = 24576, L_OST = 49152, L_IMP = L_OST, L_SELM = 114688, L_TAB = 115712, L_WSF = 118272, L_BYTES = 120320;
constexpr int TOPN = 16;

struct Tensors { const bf16* Q; const bf16* KS; const bf16* VS; const bf16* KW; const bf16* VW; const bf16* KC; const bf16* VC; const float* gates; const float* rel_bias; bf16* MIX; };

__device__ __forceinline__ int crow(int r, int hi) { return (r & 3) + 8 * (r >> 2) + 4 * hi; }
__device__ __forceinline__ int t5bucket(int n) {
  if (n < 16) return n < 0 ? 0 : n;
  if (n >= 128) return 31;
  int v = 16 + (int)(logf((float)n / 16.f) / 2.0794415416798357f * 16.f);
  return v > 31 ? 31 : v;
}
__device__ __forceinline__ unsigned cvtpk(float lo, float hi) { f32x2_t v = {lo, hi}; bf16x2_t b = __builtin_convertvector(v, bf16x2_t); return __builtin_bit_cast(unsigned, b); }
__device__ __forceinline__ void dma16(const void* g, NLAS unsigned char* l) { __builtin_amdgcn_global_load_lds((const unsigned*)g, (NLAS unsigned*)l, 16, 0, 0); }
__device__ __forceinline__ s16x4 vtr(const NLAS unsigned char* p) { return __builtin_bit_cast(s16x4, __builtin_amdgcn_ds_read_tr16_b64_v4i16((NLAS v4i16_t*)p)); }
__device__ __forceinline__ void lds_add(NLAS unsigned* p, unsigned v) { (void)__hip_atomic_fetch_add(p, v, __ATOMIC_RELAXED, __HIP_MEMORY_SCOPE_WORKGROUP); }
#define NSA_WAITBAR() asm volatile("s_waitcnt vmcnt(0) lgkmcnt(0)\n\ts_barrier" ::: "memory")

__device__ __forceinline__ void issue_tile(NLAS unsigned char* lds, int slot, const bf16* Kb, const bf16* Vb, int row0, int wid, int lane, bool withV) {
  dma16(Kb + (size_t)(row0 + lane) * 64 + wid * 8, lds + L_K + slot * 8192 + wid * 1024);
  if (withV) dma16(Vb + (size_t)(row0 + 16 * (wid & 3) + (lane >> 2)) * 64 + (wid >> 2) * 32 + (lane & 3) * 8, lds + L_V + slot * 8192 + wid * 1024);
}

__device__ __forceinline__ void issue_k(NLAS unsigned char* lds, int slot, const bf16* Kb, int row0, int wid, int lane) { dma16(Kb + (size_t)(row0 + lane) * 64 + wid * 8, lds + L_K + slot * 8192 + wid * 1024); }
__device__ __forceinline__ void issue_v(NLAS unsigned char* lds, int slot, const bf16* Vb, int row0, int wid, int lane) { dma16(Vb + (size_t)(row0 + 16 * (wid & 3) + (lane >> 2)) * 64 + (wid >> 2) * 32 + (lane & 3) * 8, lds + L_V + slot * 8192 + wid * 1024); }
__device__ __forceinline__ void qk_tile(NLAS unsigned char* lds, int slot, const bf16x8 (&qr)[4], float cinit, f32x16& p0, f32x16& p1, int lane) {
  const int r32 = lane & 31, hi = lane >> 5;
#pragma unroll
  for (int r = 0; r < 16; ++r) { p0[r] = cinit; p1[r] = cinit; }
  const NLAS unsigned char* kb = lds + L_K + slot * 8192 + hi * 1024 + r32 * 16;
#pragma unroll
  for (int d0 = 0; d0 < 4; ++d0) {
    const bf16x8 b0 = *(const NLAS bf16x8*)(kb + d0 * 2048), b1 = *(const NLAS bf16x8*)(kb + d0 * 2048 + 512);
    p0 = __builtin_amdgcn_mfma_f32_32x32x16_bf16(b0, qr[d0], p0, 0, 0, 0);
    p1 = __builtin_amdgcn_mfma_f32_32x32x16_bf16(b1, qr[d0], p1, 0, 0, 0);
  }
}
__device__ __forceinline__ float soft_pv(NLAS unsigned char* lds, int slot, f32x16& p0, f32x16& p1, f32x16& o0, f32x16& o1, float& mhat, float& lsum,
                                         bool near, int dq, int dmax, const NLAS float* tabr, NLAS float* wsf, int lane) {
  const int r32 = lane & 31, hi = lane >> 5;
  if (near) {
#pragma unroll
    for (int r = 0; r < 16; ++r) {
      const int kk = crow(r, hi);
      { const int d = dq - kk; const bool vis = (d >= 0) && (d < dmax); const int idx = d < 0 ? 0 : (d > 128 ? 128 : d); const float v = p0[r] + tabr[idx]; p0[r] = vis ? v : NEGBIG; }
      { const int d = dq - (kk + 32); const bool vis = (d >= 0) && (d < dmax); const int idx = d < 0 ? 0 : (d > 128 ? 128 : d); const float v = p1[r] + tabr[idx]; p1[r] = vis ? v : NEGBIG; }
    }
  }
  float dl = 0.f;
  {
    float a = fmaxf(fmaxf(p0[0], p0[1]), p1[0]), b = fmaxf(fmaxf(p0[2], p0[3]), p1[1]); a = fmaxf(fmaxf(a, p1[2]), p1[3]);
#pragma unroll
    for (int r = 4; r < 16; r += 4) { a = fmaxf(fmaxf(a, p0[r]), p0[r + 1]); b = fmaxf(fmaxf(b, p0[r + 2]), p0[r + 3]); a = fmaxf(fmaxf(a, p1[r]), p1[r + 1]); b = fmaxf(fmaxf(b, p1[r + 2]), p1[r + 3]); }
    float rm = fmaxf(a, b);
    { auto rr = __builtin_amdgcn_permlane32_swap(__float_as_uint(rm), __float_as_uint(rm), false, false); rm = fmaxf(__uint_as_float(rr[0]), __uint_as_float(rr[1])); }
    if (__any(rm > 8.f)) {
      dl = fmaxf(rm, 0.f); mhat += dl;
#pragma unroll
      for (int r = 0; r < 16; ++r) { p0[r] -= dl; p1[r] -= dl; }
      const float f = __builtin_amdgcn_exp2f(-dl); lsum *= f;
      if (hi == 0) wsf[r32] = f;
      asm volatile("s_waitcnt lgkmcnt(0)" ::: "memory");
#pragma unroll
      for (int r = 0; r < 16; ++r) { const float fr = wsf[crow(r, hi)]; o0[r] *= fr; o1[r] *= fr; }
      asm volatile("s_waitcnt lgkmcnt(0)" ::: "memory");
    }
  }
#pragma unroll
  for (int r = 0; r < 16; ++r) { p0[r] = __builtin_amdgcn_exp2f(p0[r]); p1[r] = __builtin_amdgcn_exp2f(p1[r]); }
  { float s = 0.f;
#pragma unroll
    for (int r = 0; r < 16; ++r) s += p0[r] + p1[r];
    lsum += s; }
  u32x4 pw[4];
#pragma unroll
  for (int k = 0; k < 4; ++k) { pw[0][k] = cvtpk(p0[2 * k], p0[2 * k + 1]); pw[1][k] = cvtpk(p0[8 + 2 * k], p0[8 + 2 * k + 1]); pw[2][k] = cvtpk(p1[2 * k], p1[2 * k + 1]); pw[3][k] = cvtpk(p1[8 + 2 * k], p1[8 + 2 * k + 1]); }
  const NLAS unsigned char* vp = lds + L_V + slot * 8192 + ((lane >> 4) & 1) * 32 + (lane & 3) * 8 + (4 * hi + ((lane & 15) >> 2)) * 64;
#pragma unroll
  for (int ks = 0; ks < 4; ++ks) {
    const bf16x8 pa = __builtin_bit_cast(bf16x8, pw[ks]);
    { const s16x4 lo = vtr(vp + ks * 1024), hh = vtr(vp + ks * 1024 + 512); const bf16x8 vf = {lo[0], lo[1], lo[2], lo[3], hh[0], hh[1], hh[2], hh[3]};
      o0 = __builtin_amdgcn_mfma_f32_32x32x16_bf16(pa, vf, o0, 0, 0, 0); }
    { const s16x4 lo = vtr(vp + 4096 + ks * 1024), hh = vtr(vp + 4096 + ks * 1024 + 512); const bf16x8 vf = {lo[0], lo[1], lo[2], lo[3], hh[0], hh[1], hh[2], hh[3]};
      o1 = __builtin_amdgcn_mfma_f32_32x32x16_bf16(pa, vf, o1, 0, 0, 0); }
  }
  return dl;
}
template <bool WIN>
__device__ __forceinline__ void run_branch(NLAS unsigned char* lds, const bf16* Kb, const bf16* Vb, int j0, int n, int qb, int t, const bf16x8 (&qr)[4], unsigned long long mlo, unsigned long long mhi,
                                           float b31, const NLAS float* tabr, f32x16& o0, f32x16& o1, float& mhat, float& lsum, NLAS float* wsf, int wid, int lane) {
  issue_k(lds, 0, Kb, 64 * j0, wid, lane); issue_v(lds, 0, Vb, 64 * j0, wid, lane);
  if (n > 1) { issue_k(lds, 1, Kb, 64 * (j0 + 1), wid, lane); issue_v(lds, 1, Vb, 64 * (j0 + 1), wid, lane); }
  if (n > 2) issue_k(lds, 2, Kb, 64 * (j0 + 2), wid, lane);
  NSA_WAITBAR();
  auto is_near = [&](int j) -> bool { return WIN ? ((j + 2 >= qb) || (j + 8 == qb)) : (j + 2 >= qb); };
  auto lane_on = [&](int j) -> bool { return WIN ? true : ((((j < 64 ? mlo : mhi) >> (j & 63)) & 1ull) != 0ull); };
  f32x16 pc0, pc1;
  qk_tile(lds, 0, qr, lane_on(j0) ? ((is_near(j0) ? 0.f : b31) - mhat) : NEGBIG, pc0, pc1, lane);
  int sk = 0;
  for (int tt = 0; tt < n; ++tt) {
    const int j = j0 + tt; const int s1 = sk == 2 ? 0 : sk + 1, s2 = sk == 0 ? 2 : sk - 1;
    int nissued = 0;
    if (tt + 3 < n) { issue_k(lds, sk, Kb, 64 * (j + 3), wid, lane); ++nissued; }
    if (tt + 2 < n) { issue_v(lds, s2, Vb, 64 * (j + 2), wid, lane); ++nissued; }
    f32x16 pn0, pn1;
    const bool more = tt + 1 < n;
    if (more) qk_tile(lds, s1, qr, lane_on(j + 1) ? ((is_near(j + 1) ? 0.f : b31) - mhat) : NEGBIG, pn0, pn1, lane);
    const float dl = soft_pv(lds, sk, pc0, pc1, o0, o1, mhat, lsum, is_near(j), t - 64 * j, WIN ? 512 : (1 << 30), tabr, wsf, lane);
    if (more) {
      if (__any(dl > 0.f)) {
#pragma unroll
        for (int r = 0; r < 16; ++r) { pn0[r] -= dl; pn1[r] -= dl; } }
      pc0 = pn0; pc1 = pn1;
    }
    if (nissued == 2) asm volatile("s_waitcnt vmcnt(2) lgkmcnt(0)\n\ts_barrier" ::: "memory");
    else if (nissued == 1) asm volatile("s_waitcnt vmcnt(1) lgkmcnt(0)\n\ts_barrier" ::: "memory");
    else NSA_WAITBAR();
    sk = s1;
  }
}

template <int PASS>
__device__ __forceinline__ void tile_compute(NLAS unsigned char* lds, int slot, const bf16x8 (&qr)[4], f32x16& o0, f32x16& o1, float& mhat, float& lsum,
                                             float cbase, bool lanesel, bool near, int dq, int step, int dmax, const NLAS float* tabr,
                                             float invl, NLAS unsigned* impq, int nbase, NLAS float* wsf, int lane) {
  const int r32 = lane & 31, hi = lane >> 5;
  const float cinit = lanesel ? (cbase - mhat) : NEGBIG;
  f32x16 p0, p1;
#pragma unroll
  for (int r = 0; r < 16; ++r) { p0[r] = cinit; p1[r] = cinit; }
  {
    const NLAS unsigned char* kb = lds + L_K + slot * 8192 + hi * 1024 + r32 * 16;
#pragma unroll
    for (int d0 = 0; d0 < 4; ++d0) {
      const bf16x8 b0 = *(const NLAS bf16x8*)(kb + d0 * 2048), b1 = *(const NLAS bf16x8*)(kb + d0 * 2048 + 512);
      p0 = __builtin_amdgcn_mfma_f32_32x32x16_bf16(b0, qr[d0], p0, 0, 0, 0);
      p1 = __builtin_amdgcn_mfma_f32_32x32x16_bf16(b1, qr[d0], p1, 0, 0, 0);
    }
  }
  if (near) {
#pragma unroll
    for (int r = 0; r < 16; ++r) {
      const int kk = crow(r, hi);
      { const int d = dq - step * kk; const bool vis = (d >= 0) && (d < dmax); const int idx = d < 0 ? 0 : (d > 128 ? 128 : d); const float v = p0[r] + tabr[idx]; p0[r] = vis ? v : NEGBIG; }
      { const int d = dq - step * (kk + 32); const bool vis = (d >= 0) && (d < dmax); const int idx = d < 0 ? 0 : (d > 128 ? 128 : d); const float v = p1[r] + tabr[idx]; p1[r] = vis ? v : NEGBIG; }
    }
  }
  if (PASS != 2) {
    float a = fmaxf(fmaxf(p0[0], p0[1]), p1[0]), b = fmaxf(fmaxf(p0[2], p0[3]), p1[1]); a = fmaxf(fmaxf(a, p1[2]), p1[3]);
#pragma unroll
    for (int r = 4; r < 16; r += 4) { a = fmaxf(fmaxf(a, p0[r]), p0[r + 1]); b = fmaxf(fmaxf(b, p0[r + 2]), p0[r + 3]); a = fmaxf(fmaxf(a, p1[r]), p1[r + 1]); b = fmaxf(fmaxf(b, p1[r + 2]), p1[r + 3]); }
    float rm = fmaxf(a, b);
    { auto rr = __builtin_amdgcn_permlane32_swap(__float_as_uint(rm), __float_as_uint(rm), false, false); rm = fmaxf(__uint_as_float(rr[0]), __uint_as_float(rr[1])); }
    if (__any(rm > 8.f)) {
      const float dl = fmaxf(rm, 0.f); mhat += dl;
#pragma unroll
      for (int r = 0; r < 16; ++r) { p0[r] -= dl; p1[r] -= dl; }
      const float f = __builtin_amdgcn_exp2f(-dl); lsum *= f;
      if (PASS == 0) {
        if (hi == 0) wsf[r32] = f;
        asm volatile("s_waitcnt lgkmcnt(0)" ::: "memory");
#pragma unroll
        for (int r = 0; r < 16; ++r) { const float fr = wsf[crow(r, hi)]; o0[r] *= fr; o1[r] *= fr; }
        asm volatile("s_waitcnt lgkmcnt(0)" ::: "memory");
      }
    }
  }
#pragma unroll
  for (int r = 0; r < 16; ++r) { p0[r] = __builtin_amdgcn_exp2f(p0[r]); p1[r] = __builtin_amdgcn_exp2f(p1[r]); }
  if (PASS == 2) {
#pragma unroll
    for (int r = 0; r < 16; ++r) { p0[r] *= invl; p1[r] *= invl; }
    if (impq) {
#pragma unroll
      for (int a = 0; a < 4; ++a) {
        { const int n = nbase + 2 * a + hi; const float gs = (p0[4 * a] + p0[4 * a + 1]) + (p0[4 * a + 2] + p0[4 * a + 3]);
          lds_add(impq + n, (unsigned)(gs * 1048576.f + 0.5f)); if (n + 1 < 128) lds_add(impq + n + 1, (unsigned)(p0[4 * a + 3] * 1048576.f + 0.5f)); }
        { const int n = nbase + 8 + 2 * a + hi; const float gs = (p1[4 * a] + p1[4 * a + 1]) + (p1[4 * a + 2] + p1[4 * a + 3]);
          lds_add(impq + n, (unsigned)(gs * 1048576.f + 0.5f)); if (n + 1 < 128) lds_add(impq + n + 1, (unsigned)(p1[4 * a + 3] * 1048576.f + 0.5f)); }
      }
    }
  } else {
    float s = 0.f;
#pragma unroll
    for (int r = 0; r < 16; ++r) s += p0[r] + p1[r];
    lsum += s;
  }
  if (PASS != 1) {
    u32x4 pw[4];
#pragma unroll
    for (int k = 0; k < 4; ++k) { pw[0][k] = cvtpk(p0[2 * k], p0[2 * k + 1]); pw[1][k] = cvtpk(p0[8 + 2 * k], p0[8 + 2 * k + 1]); pw[2][k] = cvtpk(p1[2 * k], p1[2 * k + 1]); pw[3][k] = cvtpk(p1[8 + 2 * k], p1[8 + 2 * k + 1]); }
    const NLAS unsigned char* vp = lds + L_V + slot * 8192 + ((lane >> 4) & 1) * 32 + (lane & 3) * 8 + (4 * hi + ((lane & 15) >> 2)) * 64;
#pragma unroll
    for (int ks = 0; ks < 4; ++ks) {
      const bf16x8 pa = __builtin_bit_cast(bf16x8, pw[ks]);
      { const s16x4 lo = vtr(vp + ks * 1024), hh = vtr(vp + ks * 1024 + 512); const bf16x8 vf = {lo[0], lo[1], lo[2], lo[3], hh[0], hh[1], hh[2], hh[3]};
        o0 = __builtin_amdgcn_mfma_f32_32x32x16_bf16(pa, vf, o0, 0, 0, 0); }
      { const s16x4 lo = vtr(vp + 4096 + ks * 1024), hh = vtr(vp + 4096 + ks * 1024 + 512); const bf16x8 vf = {lo[0], lo[1], lo[2], lo[3], hh[0], hh[1], hh[2], hh[3]};
        o1 = __builtin_amdgcn_mfma_f32_32x32x16_bf16(pa, vf, o1, 0, 0, 0); }
    }
  }
}

template <bool FIRST>
__device__ __forceinline__ void add_scaled(NLAS unsigned char* lds, const f32x16& o0, const f32x16& o1, float fac) {
  const int tid = mk_tid(), lane = tid & 63, wid = tid >> 6, r32 = lane & 31, hi = lane >> 5;
  NLAS float* wsf = (NLAS float*)(lds + L_WSF) + wid * 64; NLAS float* stg = (NLAS float*)(lds + L_OST) + wid * 2048;
  if (hi == 0) wsf[r32] = fac;
  asm volatile("s_waitcnt lgkmcnt(0)" ::: "memory");
#pragma unroll
  for (int r = 0; r < 16; ++r) { const int orow = crow(r, hi); const float f = wsf[orow];
    if (FIRST) { stg[orow * 64 + r32] = o0[r] * f; stg[orow * 64 + 32 + r32] = o1[r] * f; }
    else { stg[orow * 64 + r32] += o0[r] * f; stg[orow * 64 + 32 + r32] += o1[r] * f; } }
  asm volatile("s_waitcnt lgkmcnt(0)" ::: "memory");
}
__device__ __forceinline__ float merge_halves_sum(float v) { auto rr = __builtin_amdgcn_permlane32_swap(__float_as_uint(v), __float_as_uint(v), false, false); return __uint_as_float(rr[0]) + __uint_as_float(rr[1]); }

__device__ __forceinline__ float gate_at(const Tensors& T, int b, int g, int qb, int k) {
  const int tid = mk_tid(), wid = tid >> 6, t = 64 * qb + 32 * (wid & 1) + (tid & 31), h = 4 * g + (wid >> 1);
  return T.gates[((size_t)b * 8192 + t) * 32 + h * 3 + k];
}
__device__ __forceinline__ void unit(const Tensors& T, int b, int g, int qb, NLAS unsigned char* lds) {
  int tid_ = mk_tid(); asm volatile("" : "+v"(tid_));
  const int tid = tid_, lane = tid & 63, wid = __builtin_amdgcn_readfirstlane(tid >> 6), r32 = lane & 31, hi = lane >> 5;
  const int hr = wid >> 1, qh = wid & 1, h = 4 * g + hr, slab = b * 2 + g, t0 = 64 * qb, qq = 32 * qh + r32, t = t0 + qq;
  const size_t tok = (size_t)b * 8192 + t;
  NLAS unsigned* imp = (NLAS unsigned*)(lds + L_IMP); NLAS unsigned* selm = (NLAS unsigned*)(lds + L_SELM); NLAS float* tab = (NLAS float*)(lds + L_TAB);
  NLAS float* wsf = (NLAS float*)(lds + L_WSF) + wid * 64; const NLAS float* tabr = tab + hr * 132;
  const bool dotopk = qb >= TOPN;
  for (int i = tid; i < 4 * 129; i += 512) { const int rr = i / 129, d = i % 129; tab[rr * 132 + d] = T.rel_bias[t5bucket(d) * 8 + 4 * g + rr] * LOG2E; }
  if (dotopk) for (int i = tid; i < 64 * 129; i += 512) imp[i] = 0u;
  bf16x8 qr[4];
#pragma unroll
  for (int d0 = 0; d0 < 4; ++d0) qr[d0] = *(const bf16x8*)(T.Q + tok * 512 + h * 64 + d0 * 16 + hi * 8);
  const bf16* KC = T.KC + (size_t)slab * 512 * 64; const bf16* VC = T.VC + (size_t)slab * 512 * 64;
  const bf16* KS = T.KS + (size_t)slab * 8192 * 64; const bf16* VS = T.VS + (size_t)slab * 8192 * 64;
  const bf16* KW = T.KW + (size_t)slab * 8192 * 64; const bf16* VW = T.VW + (size_t)slab * 8192 * 64;
  issue_tile(lds, 0, KC, VC, 0, wid, lane, false);
  NSA_WAITBAR();
  const float b31 = tabr[128];
  const int nct = ((4 * qb + 2) >> 6) + 1;
  float mhat = 0.f, lsum = 0.f; f32x16 o0, o1;
#pragma unroll
  for (int r = 0; r < 16; ++r) { o0[r] = 0.f; o1[r] = 0.f; }
  for (int ct = 0; ct < nct; ++ct) {
    if (ct + 1 < nct) issue_tile(lds, (ct + 1) & 1, KC, VC, 64 * (ct + 1), wid, lane, false);
    const bool near = ct + 2 >= nct;
    tile_compute<1>(lds, ct & 1, qr, o0, o1, mhat, lsum, near ? 0.f : b31, true, near, t - 31 - 1024 * ct, 16, 1 << 30, tabr, 0.f, nullptr, 0, wsf, lane);
    NSA_WAITBAR();
  }
#if defined(DUP_CMP1)
  { float dm = 0.f, dls = 0.f; issue_tile(lds, 0, KC, VC, 0, wid, lane, false); NSA_WAITBAR();
    for (int ct = 0; ct < nct; ++ct) { if (ct + 1 < nct) issue_tile(lds, (ct + 1) & 1, KC, VC, 64 * (ct + 1), wid, lane, false); const bool near = ct + 2 >= nct;
      tile_compute<1>(lds, ct & 1, qr, o0, o1, dm, dls, near ? 0.f : b31, true, near, t - 31 - 1024 * ct, 16, 1 << 30, tabr, 0.f, nullptr, 0, wsf, lane); NSA_WAITBAR(); }
    asm volatile("" :: "v"(dm), "v"(dls)); }
#endif
  lsum = merge_halves_sum(lsum);
  const float invl_c = lsum > 0.f ? 1.f / lsum : 0.f;
  issue_tile(lds, 0, KC, VC, 0, wid, lane, true);
  NSA_WAITBAR();
  for (int ct = 0; ct < nct; ++ct) {
    if (ct + 1 < nct) issue_tile(lds, (ct + 1) & 1, KC, VC, 64 * (ct + 1), wid, lane, true);
    const bool near = ct + 2 >= nct;
    tile_compute<2>(lds, ct & 1, qr, o0, o1, mhat, lsum, near ? 0.f : b31, true, near, t - 31 - 1024 * ct, 16, 1 << 30, tabr, invl_c, dotopk ? imp + qq * 129 : nullptr, 16 * ct, wsf, lane);
    NSA_WAITBAR();
  }
#if defined(DUP_CMP2)
  { f32x16 d0 = o0, d1 = o1; float dls = 0.f; issue_tile(lds, 0, KC, VC, 0, wid, lane, true); NSA_WAITBAR();
    for (int ct = 0; ct < nct; ++ct) { if (ct + 1 < nct) issue_tile(lds, (ct + 1) & 1, KC, VC, 64 * (ct + 1), wid, lane, true); const bool near = ct + 2 >= nct;
      tile_compute<2>(lds, ct & 1, qr, d0, d1, mhat, dls, near ? 0.f : b31, true, near, t - 31 - 1024 * ct, 16, 1 << 30, tabr, invl_c, nullptr, 16 * ct, wsf, lane); NSA_WAITBAR(); }
    asm volatile("" :: "v"(d0), "v"(d1)); }
#endif
  {
    const int q = tid >> 3, part = tid & 7; unsigned bits = 0u;
    if (dotopk) {
      unsigned key[16];
#pragma unroll
      for (int i = 0; i < 16; ++i) { const int n = 16 * part + i; const unsigned v = imp[q * 129 + n]; key[i] = (n >= 1 && n <= qb - 2) ? ((v << 7) | (unsigned)(127 - n)) : 0u; }
      unsigned thr = 0u;
      for (int bit = 31; bit >= 0; --bit) { const unsigned cand = thr | (1u << bit); int cnt = 0;
#pragma unroll
        for (int i = 0; i < 16; ++i) cnt += (key[i] >= cand) ? 1 : 0;
        cnt += __shfl_xor(cnt, 1); cnt += __shfl_xor(cnt, 2); cnt += __shfl_xor(cnt, 4);
        if (cnt >= TOPN - 3) thr = cand; }
#if defined(DUP_TOPK)
      { unsigned thr2 = 0u;
        for (int bit = 31; bit >= 0; --bit) { const unsigned cand = thr2 | (1u << bit); int cnt = 0;
#pragma unroll
          for (int i = 0; i < 16; ++i) cnt += (key[i] >= cand) ? 1 : 0;
          cnt += __shfl_xor(cnt, 1); cnt += __shfl_xor(cnt, 2); cnt += __shfl_xor(cnt, 4);
          if (cnt >= TOPN - 3) thr2 = cand; }
        asm volatile("" :: "v"(thr2)); }
#endif
#pragma unroll
      for (int i = 0; i < 16; ++i) { const int n = 16 * part + i; if ((key[i] >= thr && key[i] != 0u) || n == 0 || n == qb || n == qb - 1) bits |= 1u << i; }
    } else {
#pragma unroll
      for (int i = 0; i < 16; ++i) if (16 * part + i <= qb) bits |= 1u << i;
    }
    ((NLAS unsigned short*)selm)[q * 8 + part] = (unsigned short)bits;
  }
  NSA_WAITBAR();
  const unsigned long long mlo = (unsigned long long)selm[qq * 4 + 0] | ((unsigned long long)selm[qq * 4 + 1] << 32), mhi = (unsigned long long)selm[qq * 4 + 2] | ((unsigned long long)selm[qq * 4 + 3] << 32);
  add_scaled<true>(lds, o0, o1, gate_at(T, b, g, qb, 0));
  mhat = 0.f; lsum = 0.f;
#pragma unroll
  for (int r = 0; r < 16; ++r) { o0[r] = 0.f; o1[r] = 0.f; }
  run_branch<false>(lds, KS, VS, 0, qb + 1, qb, t, qr, mlo, mhi, b31, tabr, o0, o1, mhat, lsum, wsf, wid, lane);
#if defined(DUP_SEL)
  { f32x16 d0 = o0, d1 = o1; float dm = 0.f, dls = 0.f; run_branch<false>(lds, KS, VS, 0, qb + 1, qb, t, qr, mlo, mhi, b31, tabr, d0, d1, dm, dls, wsf, wid, lane); asm volatile("" :: "v"(d0), "v"(d1), "v"(dls)); }
#endif
  lsum = merge_halves_sum(lsum);
  add_scaled<false>(lds, o0, o1, lsum > 0.f ? gate_at(T, b, g, qb, 1) / lsum : 0.f);
  const int jw0 = qb >= 8 ? qb - 8 : 0;
  mhat = 0.f; lsum = 0.f;
#pragma unroll
  for (int r = 0; r < 16; ++r) { o0[r] = 0.f; o1[r] = 0.f; }
  run_branch<true>(lds, KW, VW, jw0, qb - jw0 + 1, qb, t, qr, mlo, mhi, b31, tabr, o0, o1, mhat, lsum, wsf, wid, lane);
#if defined(DUP_WIN)
  { f32x16 d0 = o0, d1 = o1; float dm = 0.f, dls = 0.f; run_branch<true>(lds, KW, VW, jw0, qb - jw0 + 1, qb, t, qr, mlo, mhi, b31, tabr, d0, d1, dm, dls, wsf, wid, lane); asm volatile("" :: "v"(d0), "v"(d1), "v"(dls)); }
#endif
  lsum = merge_halves_sum(lsum);
  add_scaled<false>(lds, o0, o1, lsum > 0.f ? gate_at(T, b, g, qb, 2) / lsum : 0.f);
  {
    const int tid2 = mk_tid(), lane2 = tid2 & 63, wid2 = tid2 >> 6; const NLAS float* stg2 = (const NLAS float*)(lds + L_OST) + wid2 * 2048;
    bf16* Ow = T.MIX + ((size_t)b * 8192 + 64 * qb + 32 * (wid2 & 1)) * 1024 + (4 * g + (wid2 >> 1)) * 64;
#pragma unroll
    for (int i = 0; i < 4; ++i) { const int row = i * 8 + (lane2 >> 3), ch = lane2 & 7; const NLAS float* sp = stg2 + row * 64 + ch * 8;
      u32x4 v; v.x = cvtpk(sp[0], sp[1]); v.y = cvtpk(sp[2], sp[3]); v.z = cvtpk(sp[4], sp[5]); v.w = cvtpk(sp[6], sp[7]); *(u32x4*)(Ow + (size_t)row * 1024 + ch * 8) = v; }
  }
  NSA_WAITBAR();
}
}
namespace rwkv {
#define RLAS __attribute__((address_space(3)))
typedef unsigned short bf16;
typedef short bf16x8 __attribute__((ext_vector_type(8)));
typedef short bf16x4 __attribute__((ext_vector_type(4)));
typedef float f32x4 __attribute__((ext_vector_type(4)));
typedef unsigned u32x2 __attribute__((ext_vector_type(2)));
typedef unsigned u32x4 __attribute__((ext_vector_type(4)));
typedef float f32x2_t __attribute__((ext_vector_type(2))); typedef __bf16 bf16x2_t __attribute__((ext_vector_type(2)));
constexpr int LD = 72, MATB = 64 * LD * 2;
constexpr int M_AT = 0, M_ATT = MATB, M_BT = 2 * MATB, M_BTT = 3 * MATB, M_KT = 4 * MATB, M_KTT = 5 * MATB, M_RT = 6 * MATB, M_VT = 7 * MATB;
constexpr int A_AB = 8 * MATB, A_AK = 9 * MATB, A_RB = 10 * MATB, A_RK = 11 * MATB, L_DIAG = 12 * MATB, L_TII = L_DIAG + 4096, L_E = L_TII + 2048, L_SEG = L_E + 16384, L_PC = L_SEG + 2048, L_BYTES = L_PC + 256;
struct Tensors {
  const bf16* RW; const bf16* LORA;
  const float *mu, *w0, *a0, *k_k, *k_a, *r_k, *ln_w, *ln_b;
  bf16 *G, *HADD, *RWM, *Y0, *HT; float* PC; float* BON; bf16* VM;
  bf16* MIX;
};
__device__ __forceinline__ int opq(int x) { asm volatile("" : "+s"(x)); return x; }
__device__ __forceinline__ float bf2f(bf16 v) { return __uint_as_float((unsigned)v << 16); }
__device__ __forceinline__ unsigned cvtpk(float lo, float hi) { f32x2_t v = {lo, hi}; bf16x2_t b = __builtin_convertvector(v, bf16x2_t); return __builtin_bit_cast(unsigned, b); }
__device__ __forceinline__ bf16x4 pack4(const f32x4& v) { u32x2 r; r.x = cvtpk(v[0], v[1]); r.y = cvtpk(v[2], v[3]); return __builtin_bit_cast(bf16x4, r); }
__device__ __forceinline__ f32x4 mfma16(bf16x4 a, bf16x4 b, f32x4 c) { return __builtin_amdgcn_mfma_f32_16x16x16bf16_1k(a, b, c, 0, 0, 0); }
__device__ __forceinline__ f32x4 mfma32(bf16x8 a, bf16x8 b, f32x4 c) { return __builtin_amdgcn_mfma_f32_16x16x32_bf16(a, b, c, 0, 0, 0); }
__device__ __forceinline__ float sigm(float x) { return __builtin_amdgcn_rcpf(1.f + __expf(-x)); }
__device__ __forceinline__ void unpack8(const u32x4& w, float (&o)[8]) {
  o[0] = __uint_as_float(w.x << 16); o[1] = __uint_as_float(w.x & 0xffff0000u); o[2] = __uint_as_float(w.y << 16); o[3] = __uint_as_float(w.y & 0xffff0000u);
  o[4] = __uint_as_float(w.z << 16); o[5] = __uint_as_float(w.z & 0xffff0000u); o[6] = __uint_as_float(w.w << 16); o[7] = __uint_as_float(w.w & 0xffff0000u);
}
__device__ __forceinline__ void ld8(const float* p, float (&o)[8]) { const f32x4 a = *(const f32x4*)p, b = *(const f32x4*)(p + 4); o[0] = a[0]; o[1] = a[1]; o[2] = a[2]; o[3] = a[3]; o[4] = b[0]; o[5] = b[1]; o[6] = b[2]; o[7] = b[3]; }
struct Prep8 { float r[8], kp[8], v[8], e[8], a[8], kk[8]; };
__device__ __forceinline__ void prep8(const Tensors& T, size_t m, int t, int h, int c0, Prep8& o) {
  const bf16* rw = T.RW + m * 1792 + h * 64 + c0; const bf16* lo = T.LORA + m * 1536 + h * 64 + c0; const int c = h * 64 + c0;
  float rc[8], kc[8], vc[8], rp[8], kp[8], vp[8], al[8], wl[8], mr[8], mk[8], mv[8], a0v[8], w0v[8], kkv[8], kav[8];
  unpack8(*(const u32x4*)rw, rc); unpack8(*(const u32x4*)(rw + 512), kc); unpack8(*(const u32x4*)(rw + 1024), vc);
  if (t > 0) { unpack8(*(const u32x4*)(rw - 1792), rp); unpack8(*(const u32x4*)(rw + 512 - 1792), kp); unpack8(*(const u32x4*)(rw + 1024 - 1792), vp); }
  else {
#pragma unroll
    for (int j = 0; j < 8; ++j) { rp[j] = 0.f; kp[j] = 0.f; vp[j] = 0.f; } }
  unpack8(*(const u32x4*)(lo + 512), al); unpack8(*(const u32x4*)lo, wl);
  ld8(T.mu + c, mr); ld8(T.mu + 512 + c, mk); ld8(T.mu + 1024 + c, mv); ld8(T.a0 + c, a0v); ld8(T.w0 + c, w0v); ld8(T.k_k + c, kkv); ld8(T.k_a + c, kav);
#pragma unroll
  for (int j = 0; j < 8; ++j) {
    const float rm = rc[j] + (rp[j] - rc[j]) * mr[j], km = kc[j] + (kp[j] - kc[j]) * mk[j], vm = vc[j] + (vp[j] - vc[j]) * mv[j];
    const float a = sigm(a0v[j] + al[j]);
    o.r[j] = rm; o.v[j] = vm; o.a[j] = a; o.kk[j] = km * kkv[j]; o.kp[j] = km * (1.f + (a - 1.f) * kav[j]);
    const float wr = w0v[j] + wl[j]; const float sp = (-wr > 20.f) ? -wr : __logf(1.f + __expf(-wr)); o.e[j] = __expf(-sp - 0.5f);
  }
}

__device__ __forceinline__ void p1_item(const Tensors& T, int bh, int ch, RLAS unsigned char* lds) {
  int tid_ = mk_tid(); asm volatile("" : "+v"(tid_));
  const int tid = tid_, lane = tid & 63, wid = __builtin_amdgcn_readfirstlane(tid >> 6), col = lane & 15, q = lane >> 4;
  const int b = bh >> 3, h = bh & 7; const size_t item = (size_t)bh * 128 + ch;
  const int MVT = opq(M_VT);
  RLAS float* E = (RLAS float*)(lds + L_E); RLAS float* SEG = (RLAS float*)(lds + L_SEG); RLAS float* PCL = (RLAS float*)(lds + L_PC);
  const int i = tid >> 3, c0 = (tid & 7) * 8; const int t = ch * 64 + i; const size_t m = (size_t)b * 8192 + t;
  Prep8 P; prep8(T, m, t, h, c0, P);
  float ss = 0.f, bo = 0.f;
  { float rk[8]; ld8(T.r_k + h * 64 + c0, rk);
#pragma unroll
    for (int j = 0; j < 8; ++j) { ss += P.kk[j] * P.kk[j]; bo += P.r[j] * P.kp[j] * rk[j]; } }
  ss += __shfl_xor(ss, 1); ss += __shfl_xor(ss, 2); ss += __shfl_xor(ss, 4);
  bo += __shfl_xor(bo, 1); bo += __shfl_xor(bo, 2); bo += __shfl_xor(bo, 4);
  if ((tid & 7) == 0) T.BON[item * 64 + i] = bo;
  { u32x4 w; w.x = cvtpk(P.v[0], P.v[1]); w.y = cvtpk(P.v[2], P.v[3]); w.z = cvtpk(P.v[4], P.v[5]); w.w = cvtpk(P.v[6], P.v[7]); *(u32x4*)(T.VM + item * 4096 + i * 64 + c0) = w; }
  const float kinv = 1.f / fmaxf(sqrtf(ss), 1e-12f);
#pragma unroll
  for (int j = 0; j < 8; ++j) E[i * 64 + c0 + j] = P.e[j];
  __syncthreads();
  { const int k = tid & 63, sg = tid >> 6; float run = 0.f;
#pragma unroll
    for (int ii = 0; ii < 8; ++ii) { run += E[(sg * 8 + ii) * 64 + k]; E[(sg * 8 + ii) * 64 + k] = run; }
    SEG[sg * 64 + k] = run; }
  __syncthreads();
  { const int k = tid & 63, sg = wid; float off = 0.f;
    for (int s2 = 0; s2 < sg; ++s2) off += SEG[s2 * 64 + k];
#pragma unroll
    for (int ii = 0; ii < 8; ++ii) E[(sg * 8 + ii) * 64 + k] += off; }
  __syncthreads();
  {
    float av[8], bv[8], kv[8], rv[8];
#pragma unroll
    for (int j = 0; j < 8; ++j) {
      const float cum = E[i * 64 + c0 + j];
      const float pinc = __expf(-cum), pexc = __expf(-(cum - P.e[j])), pinv = __expf(cum);
      const float kk = P.kk[j] * kinv;
      av[j] = -kk * pexc; bv[j] = kk * P.a[j] * pinv; kv[j] = P.kp[j] * pinv; rv[j] = P.r[j] * pinc;
      if (i == 63) { PCL[c0 + j] = pinc; T.PC[item * 64 + c0 + j] = pinc; }
    }
    u32x4 w;
    w.x = cvtpk(av[0], av[1]); w.y = cvtpk(av[2], av[3]); w.z = cvtpk(av[4], av[5]); w.w = cvtpk(av[6], av[7]); *(RLAS u32x4*)(lds + M_AT + (i * LD + c0) * 2) = w;
    w.x = cvtpk(bv[0], bv[1]); w.y = cvtpk(bv[2], bv[3]); w.z = cvtpk(bv[4], bv[5]); w.w = cvtpk(bv[6], bv[7]); *(RLAS u32x4*)(lds + M_BT + (i * LD + c0) * 2) = w;
    w.x = cvtpk(kv[0], kv[1]); w.y = cvtpk(kv[2], kv[3]); w.z = cvtpk(kv[4], kv[5]); w.w = cvtpk(kv[6], kv[7]); *(RLAS u32x4*)(lds + M_KT + (i * LD + c0) * 2) = w;
    w.x = cvtpk(rv[0], rv[1]); w.y = cvtpk(rv[2], rv[3]); w.z = cvtpk(rv[4], rv[5]); w.w = cvtpk(rv[6], rv[7]); *(RLAS u32x4*)(lds + M_RT + (i * LD + c0) * 2) = w;
#pragma unroll
    for (int j = 0; j < 8; ++j) {
      *(RLAS bf16*)(lds + M_ATT + ((c0 + j) * LD + i) * 2) = (bf16)(cvtpk(av[j], 0.f) & 0xffffu);
      *(RLAS bf16*)(lds + M_BTT + ((c0 + j) * LD + i) * 2) = (bf16)(cvtpk(bv[j], 0.f) & 0xffffu);
      *(RLAS bf16*)(lds + M_KTT + ((c0 + j) * LD + i) * 2) = (bf16)(cvtpk(kv[j], 0.f) & 0xffffu);
      *(RLAS bf16*)(lds + MVT + ((c0 + j) * LD + i) * 2) = (bf16)(cvtpk(P.v[j], 0.f) & 0xffffu);
    }
  }
  __syncthreads();
  {
    const int it = wid & 3, src = wid >> 2;
    const RLAS unsigned char* SRC = lds + (src ? M_RT : M_AT) + ((16 * it + col) * LD + 8 * q) * 2;
    const bf16x8 b0 = *(const RLAS bf16x8*)SRC, b1 = *(const RLAS bf16x8*)(SRC + 64);
    const int gi = 16 * it + col;
#pragma unroll
    for (int jt = 0; jt < 4; ++jt)
#pragma unroll
      for (int which = 0; which < 2; ++which) {
        const RLAS unsigned char* AM = lds + (which ? M_KT : M_BT) + ((16 * jt + col) * LD + 8 * q) * 2;
        f32x4 acc = {0.f, 0.f, 0.f, 0.f};
        acc = mfma32(*(const RLAS bf16x8*)AM, b0, acc); acc = mfma32(*(const RLAS bf16x8*)(AM + 64), b1, acc);
#pragma unroll
        for (int r = 0; r < 4; ++r) { const int gj = 16 * jt + 4 * q + r; const bool keep = src ? (gj <= gi) : (gj < gi); acc[r] = keep ? acc[r] : 0.f; }
        const int dst = src ? (which ? A_RK : A_RB) : (which ? A_AK : A_AB);
        *(RLAS bf16x4*)(lds + dst + (gi * LD + 16 * jt + 4 * q) * 2) = pack4(acc);
        if (src == 0 && which == 0 && jt == it) {
#pragma unroll
          for (int r = 0; r < 4; ++r) *(RLAS float*)(lds + L_DIAG + ((it * 16 + col) * 16 + 4 * q + r) * 4) = acc[r];
        }
      }
  }
  __syncthreads();
  if (wid == 0) {
    const int blk = lane >> 4, c = lane & 15; const RLAS float* L = (const RLAS float*)(lds + L_DIAG) + blk * 256;
    float x[16];
#pragma unroll
    for (int ii = 0; ii < 16; ++ii) { float s = (ii == c) ? 1.f : 0.f;
#pragma unroll
      for (int mm = 0; mm < ii; ++mm) s += L[ii * 16 + mm] * x[mm];
      x[ii] = s; }
#pragma unroll
    for (int ii = 0; ii < 16; ++ii) *(RLAS bf16*)(lds + L_TII + ((blk * 16 + ii) * 16 + c) * 2) = (bf16)(cvtpk(x[ii], 0.f) & 0xffffu);
  }
  __syncthreads();
  {
    const bool isU = wid >= 4; const int ct = wid & 3;
    bf16x4 Xb[4];
#pragma unroll
    for (int ib = 0; ib < 4; ++ib) {
      f32x4 tmp;
      if (!isU) { const bf16x4 a4 = *(const RLAS bf16x4*)(lds + M_ATT + ((16 * ct + col) * LD + 16 * ib + 4 * q) * 2);
#pragma unroll
        for (int r = 0; r < 4; ++r) tmp[r] = bf2f((bf16)a4[r]); }
      else { tmp = (f32x4){0.f, 0.f, 0.f, 0.f};
#pragma unroll
        for (int ks = 0; ks < 2; ++ks) tmp = mfma32(*(const RLAS bf16x8*)(lds + A_AK + ((16 * ib + col) * LD + 32 * ks + 8 * q) * 2), *(const RLAS bf16x8*)(lds + MVT + ((16 * ct + col) * LD + 32 * ks + 8 * q) * 2), tmp); }
      const f32x4 zero = {0.f, 0.f, 0.f, 0.f};
      f32x4 t16 = zero;
#pragma unroll
      for (int mb = 0; mb < 4; ++mb) if (mb < ib) t16 = mfma16(*(const RLAS bf16x4*)(lds + A_AB + ((16 * ib + col) * LD + 16 * mb + 4 * q) * 2), Xb[mb], t16);
      tmp = tmp + t16;
      const f32x4 X = mfma16(*(const RLAS bf16x4*)(lds + L_TII + ((ib * 16 + col) * 16 + 4 * q) * 2), pack4(tmp), zero);
      Xb[ib] = pack4(X);
    }
    if (!isU) {
#pragma unroll
      for (int ib = 0; ib < 4; ++ib) { const int gi = 16 * ib + col;
        const bf16x4 r4 = *(const RLAS bf16x4*)(lds + M_RT + (gi * LD + 16 * ct + 4 * q) * 2); f32x4 acc;
#pragma unroll
        for (int r = 0; r < 4; ++r) acc[r] = bf2f((bf16)r4[r]);
#pragma unroll
        for (int mb = 0; mb < 4; ++mb) if (mb <= ib) acc = mfma16(Xb[mb], *(const RLAS bf16x4*)(lds + A_RB + (gi * LD + 16 * mb + 4 * q) * 2), acc);
        *(bf16x4*)(T.RWM + item * 4096 + gi * 64 + 16 * ct + 4 * q) = pack4(acc); }
#pragma unroll
      for (int kb = 0; kb < 4; ++kb) { const int gk = 16 * kb + col; f32x4 acc = {0.f, 0.f, 0.f, 0.f};
#pragma unroll
        for (int mb = 0; mb < 4; ++mb) acc = mfma16(Xb[mb], *(const RLAS bf16x4*)(lds + M_BTT + (gk * LD + 16 * mb + 4 * q) * 2), acc);
        const float pc = PCL[gk];
#pragma unroll
        for (int r = 0; r < 4; ++r) acc[r] *= pc;
        *(bf16x4*)(T.G + item * 4096 + gk * 64 + 16 * ct + 4 * q) = pack4(acc); }
    } else {
#pragma unroll
      for (int ib = 0; ib < 4; ++ib) { const int gi = 16 * ib + col; f32x4 acc = {0.f, 0.f, 0.f, 0.f}, acc2 = {0.f, 0.f, 0.f, 0.f};
#pragma unroll
        for (int mb = 0; mb < 4; ++mb) if (mb <= ib) acc = mfma16(Xb[mb], *(const RLAS bf16x4*)(lds + A_RB + (gi * LD + 16 * mb + 4 * q) * 2), acc);
#pragma unroll
        for (int ks = 0; ks < 2; ++ks) acc2 = mfma32(*(const RLAS bf16x8*)(lds + MVT + ((16 * ct + col) * LD + 32 * ks + 8 * q) * 2), *(const RLAS bf16x8*)(lds + A_RK + (gi * LD + 32 * ks + 8 * q) * 2), acc2);
        acc = acc + acc2;
        *(bf16x4*)(T.Y0 + item * 4096 + gi * 64 + 16 * ct + 4 * q) = pack4(acc); }
#pragma unroll
      for (int kb = 0; kb < 4; ++kb) { f32x4 acc = {0.f, 0.f, 0.f, 0.f}, acc2 = {0.f, 0.f, 0.f, 0.f};
#pragma unroll
        for (int mb = 0; mb < 4; ++mb) acc = mfma16(*(const RLAS bf16x4*)(lds + M_BTT + ((16 * kb + col) * LD + 16 * mb + 4 * q) * 2), Xb[mb], acc);
#pragma unroll
        for (int ks = 0; ks < 2; ++ks) acc2 = mfma32(*(const RLAS bf16x8*)(lds + M_KTT + ((16 * kb + col) * LD + 32 * ks + 8 * q) * 2), *(const RLAS bf16x8*)(lds + MVT + ((16 * ct + col) * LD + 32 * ks + 8 * q) * 2), acc2);
        const f32x4 pc = *(const RLAS f32x4*)(PCL + 16 * kb + 4 * q);
        acc = (acc + acc2) * pc;
        *(bf16x4*)(T.HADD + item * 4096 + (16 * ct + col) * 64 + 16 * kb + 4 * q) = pack4(acc); }
    }
  }
  __syncthreads();
}

struct ScanOps { bf16x4 ga[4][4]; bf16x4 ha[4]; f32x4 pc[4]; };
__device__ __forceinline__ void scan_load(const Tensors& T, size_t item, int v, int col, int q, ScanOps& o) {
  const bf16* Gp = T.G + item * 4096; const bf16* Hp = T.HADD + item * 4096 + v * 64; const float* Pp = T.PC + item * 64;
#pragma unroll
  for (int kb = 0; kb < 4; ++kb) { o.ha[kb] = *(const bf16x4*)(Hp + 16 * kb + 4 * q); o.pc[kb] = *(const f32x4*)(Pp + 16 * kb + 4 * q);
#pragma unroll
    for (int mb = 0; mb < 4; ++mb) o.ga[kb][mb] = *(const bf16x4*)(Gp + (16 * kb + col) * 64 + 16 * mb + 4 * q); }
}
__device__ __forceinline__ void scan_step(const Tensors& T, size_t item, int v, int q, const ScanOps& o, f32x4 (&acc)[4]) {
  bf16x4 hb[4];
#pragma unroll
  for (int kb = 0; kb < 4; ++kb) { hb[kb] = pack4(acc[kb]); *(bf16x4*)(T.HT + item * 4096 + v * 64 + 16 * kb + 4 * q) = hb[kb]; }
  f32x4 nw[4];
#pragma unroll
  for (int kb = 0; kb < 4; ++kb) {
#pragma unroll
    for (int r = 0; r < 4; ++r) nw[kb][r] = o.pc[kb][r] * acc[kb][r] + bf2f((bf16)o.ha[kb][r]);
#pragma unroll
    for (int mb = 0; mb < 4; ++mb) nw[kb] = mfma16(o.ga[kb][mb], hb[mb], nw[kb]);
  }
#pragma unroll
  for (int kb = 0; kb < 4; ++kb) acc[kb] = nw[kb];
}
__device__ __forceinline__ void scan_head(const Tensors& T, int bh, int wv, int lane) {
  const int col = lane & 15, q = lane >> 4, v = 16 * wv + col;
  f32x4 acc[4];
#pragma unroll
  for (int kb = 0; kb < 4; ++kb) acc[kb] = (f32x4){0.f, 0.f, 0.f, 0.f};
  const size_t it0 = (size_t)bh * 128;
  ScanOps A, B, C;
  scan_load(T, it0, v, col, q, A); scan_load(T, it0 + 1, v, col, q, B);
  for (int ch = 0; ch < 126; ch += 3) {
    scan_load(T, it0 + ch + 2, v, col, q, C); scan_step(T, it0 + ch, v, q, A, acc);
    scan_load(T, it0 + ch + 3, v, col, q, A); scan_step(T, it0 + ch + 1, v, q, B, acc);
    scan_load(T, it0 + ch + 4, v, col, q, B); scan_step(T, it0 + ch + 2, v, q, C, acc);
  }
  scan_step(T, it0 + 126, v, q, A, acc); scan_step(T, it0 + 127, v, q, B, acc);
}

constexpr int SC_ROWB = 144, SC_G = 0, SC_H = 64 * SC_ROWB, SC_P = 2 * 64 * SC_ROWB, SC_SLOT = 2 * 64 * SC_ROWB + 256;
struct ScanStage { u32x4 g[2], h[2], p; };
__device__ __forceinline__ void scan_stage_load(const Tensors& T, size_t item, int lw, int lane, ScanStage& st) {
#pragma unroll
  for (int j = 0; j < 2; ++j) { const int c = lw * 128 + j * 64 + lane;
    st.g[j] = *(const u32x4*)(T.G + item * 4096 + (size_t)c * 8); st.h[j] = *(const u32x4*)(T.HADD + item * 4096 + (size_t)c * 8); }
  if (lw == 0 && lane < 16) st.p = *(const u32x4*)(T.PC + item * 64 + lane * 4);
}
__device__ __forceinline__ void scan_stage_store(RLAS unsigned char* slot, int lw, int lane, const ScanStage& st) {
#pragma unroll
  for (int j = 0; j < 2; ++j) { const int c = lw * 128 + j * 64 + lane; const int off = (c >> 3) * SC_ROWB + (c & 7) * 16;
    *(RLAS u32x4*)(slot + SC_G + off) = st.g[j]; *(RLAS u32x4*)(slot + SC_H + off) = st.h[j]; }
  if (lw == 0 && lane < 16) *(RLAS u32x4*)(slot + SC_P + lane * 16) = st.p;
}
__device__ __forceinline__ void scan_block(const Tensors& T, int bh, RLAS unsigned char* lds, int wave, int lane) {
  const size_t it0 = (size_t)bh * 128; const bool loader = wave >= 4; const int lw = wave - 4;
  const int col = lane & 15, q = lane >> 4, v = 16 * (wave & 3) + col;
  f32x4 acc[4];
#pragma unroll
  for (int kb = 0; kb < 4; ++kb) acc[kb] = (f32x4){0.f, 0.f, 0.f, 0.f};
  ScanStage st[8];
  if (loader) {
#pragma unroll
    for (int d = 0; d < 8; ++d) scan_stage_load(T, it0 + d, lw, lane, st[d]);
    scan_stage_store(lds, lw, lane, st[0]);
    scan_stage_load(T, it0 + 8, lw, lane, st[0]);
  }
  __syncthreads();
  for (int s0 = 0; s0 < 128; s0 += 8) {
#pragma unroll
    for (int d = 0; d < 8; ++d) {
      const int s = s0 + d; const int slot_c = s % 3, slot_n = (s + 1) % 3;
      if (loader) {
        if (s + 1 < 128) scan_stage_store(lds + slot_n * SC_SLOT, lw, lane, st[(d + 1) & 7]);
        if (s + 9 < 128) scan_stage_load(T, it0 + s + 9, lw, lane, st[(d + 1) & 7]);
      } else {
        const RLAS unsigned char* sl = lds + slot_c * SC_SLOT; const size_t item = it0 + s;
        bf16x4 hb[4];
#pragma unroll
        for (int kb = 0; kb < 4; ++kb) { hb[kb] = pack4(acc[kb]); *(bf16x4*)(T.HT + item * 4096 + v * 64 + 16 * kb + 4 * q) = hb[kb]; }
        f32x4 nw[4];
#pragma unroll
        for (int kb = 0; kb < 4; ++kb) {
          const bf16x4 ha = *(const RLAS bf16x4*)(sl + SC_H + v * SC_ROWB + (16 * kb + 4 * q) * 2); const f32x4 pc = *(const RLAS f32x4*)(sl + SC_P + (16 * kb + 4 * q) * 4);
#pragma unroll
          for (int r = 0; r < 4; ++r) nw[kb][r] = pc[r] * acc[kb][r] + bf2f((bf16)ha[r]);
#pragma unroll
          for (int mb = 0; mb < 4; ++mb) nw[kb] = mfma16(*(const RLAS bf16x4*)(sl + SC_G + (16 * kb + col) * SC_ROWB + (16 * mb + 4 * q) * 2), hb[mb], nw[kb]);
        }
#pragma unroll
        for (int kb = 0; kb < 4; ++kb) acc[kb] = nw[kb];
      }
      __syncthreads();
    }
  }
}

__device__ __forceinline__ void p2_item(const Tensors& T, int bh, int ch, int lane) {
  const int col = lane & 15, q = lane >> 4, b = bh >> 3, h = bh & 7; const size_t item = (size_t)bh * 128 + ch;
  const bf16* HTp = T.HT + item * 4096 + col * 64 + 8 * q;
  bf16x8 ha[4][2];
#pragma unroll
  for (int vt = 0; vt < 4; ++vt) { ha[vt][0] = *(const bf16x8*)(HTp + vt * 16 * 64); ha[vt][1] = *(const bf16x8*)(HTp + vt * 16 * 64 + 32); }
  f32x4 lw[4], lb[4];
#pragma unroll
  for (int vt = 0; vt < 4; ++vt) { const int c = h * 64 + 16 * vt + 4 * q; lw[vt] = *(const f32x4*)(T.ln_w + c); lb[vt] = *(const f32x4*)(T.ln_b + c); }
#pragma unroll 1
  for (int ib = 0; ib < 4; ++ib) {
    const int i = 16 * ib + col, t = ch * 64 + i; const size_t m = (size_t)b * 8192 + t;
    const bf16* RWp = T.RWM + item * 4096 + i * 64 + 8 * q;
    const bf16x8 rb0 = *(const bf16x8*)RWp, rb1 = *(const bf16x8*)(RWp + 32);
    f32x4 y[4];
#pragma unroll
    for (int vt = 0; vt < 4; ++vt) { const bf16x4 y0 = *(const bf16x4*)(T.Y0 + item * 4096 + i * 64 + 16 * vt + 4 * q);
#pragma unroll
      for (int r = 0; r < 4; ++r) y[vt][r] = bf2f((bf16)y0[r]);
      y[vt] = mfma32(ha[vt][0], rb0, y[vt]); y[vt] = mfma32(ha[vt][1], rb1, y[vt]); }
    const float bo = T.BON[item * 64 + i];
    float s = 0.f;
#pragma unroll
    for (int vt = 0; vt < 4; ++vt) s += (y[vt][0] + y[vt][1]) + (y[vt][2] + y[vt][3]);
    s += __shfl_xor(s, 16); s += __shfl_xor(s, 32);
    const float mean = s * (1.f / 64.f); float qq = 0.f;
#pragma unroll
    for (int vt = 0; vt < 4; ++vt)
#pragma unroll
      for (int r = 0; r < 4; ++r) { const float d = y[vt][r] - mean; qq += d * d; }
    qq += __shfl_xor(qq, 16); qq += __shfl_xor(qq, 32);
    const float rstd = rsqrtf(qq * (1.f / 64.f) + 64e-5f);
#pragma unroll
    for (int vt = 0; vt < 4; ++vt) { const int c = h * 64 + 16 * vt + 4 * q;
      const bf16x4 g4 = *(const bf16x4*)(T.LORA + m * 1536 + 1024 + c); const bf16x4 v4 = *(const bf16x4*)(T.VM + item * 4096 + i * 64 + 16 * vt + 4 * q);
      f32x4 o;
#pragma unroll
      for (int r = 0; r < 4; ++r) o[r] = ((y[vt][r] - mean) * rstd * lw[vt][r] + lb[vt][r] + bo * bf2f((bf16)v4[r])) * bf2f((bf16)g4[r]);
      *(bf16x4*)(T.MIX + m * 1024 + 512 + c) = pack4(o); }
  }
}
}
namespace {
#define LAS __attribute__((address_space(3)))
typedef unsigned short bf16;
typedef unsigned v4u __attribute__((ext_vector_type(4)));
typedef float f32x4 __attribute__((ext_vector_type(4)));
typedef short bf16x8 __attribute__((ext_vector_type(8)));
constexpr int NWAVES = 8, NTHREADS = 512;
constexpr int B_ = 2, T_ = 8192, D_ = 1024, M_ = B_ * T_, DIN = 3096, DFF = 2816, NPROJ = 3328, NLORA = 1536, KLORA = 256, NUPH = 2816;
constexpr size_t MiB = 1u << 20;
constexpr size_t WS_CTL = 0, WS_WIN = 1 * MiB, WS_WOUT = 8 * MiB, WS_WUP = 10 * MiB, WS_WDN = 21 * MiB, WS_LORAW = 27 * MiB, WS_B1P = 28 * MiB, WS_CW1T = 29 * MiB;
constexpr size_t WS_XN = 32 * MiB;
constexpr size_t WS_HT = 32 * MiB, WS_VM = 48 * MiB, WS_PC = 210 * MiB, WS_BON = 211 * MiB;
constexpr size_t WS_Q = 64 * MiB;
constexpr size_t WS_SLAB = 80 * MiB;
constexpr size_t WS_GATES = 104 * MiB;
constexpr size_t WS_RW = 106 * MiB;
constexpr size_t WS_LORA = 162 * MiB;
constexpr size_t WS_ACT = 210 * MiB;
constexpr size_t WS_CMP = 218 * MiB;
constexpr size_t WS_MIX = 220 * MiB;
constexpr size_t WS_U = 64 * MiB;
constexpr size_t WS_ACT2 = 64 * MiB;
constexpr size_t WS_END = 256 * MiB;
constexpr int LDS_BYTES = 147456;

__device__ __forceinline__ float bf2f(bf16 v) { return __uint_as_float((unsigned)v << 16); }
__device__ __forceinline__ unsigned f2bf(float f) { unsigned u = __float_as_uint(f); return (u + 0x7fffu + ((u >> 16) & 1u)) >> 16; }
__device__ __forceinline__ unsigned pk2(float lo, float hi) { return f2bf(lo) | (f2bf(hi) << 16); }
__device__ __forceinline__ float wsum(float v) {
#pragma unroll
  for (int o = 32; o >= 1; o >>= 1) v += __shfl_xor(v, o);
  return v;
}
__device__ __forceinline__ float wmax(float v) {
#pragma unroll
  for (int o = 32; o >= 1; o >>= 1) v = fmaxf(v, __shfl_xor(v, o));
  return v;
}
__device__ __forceinline__ int t5b(int n) {
  if (n < 16) return n < 0 ? 0 : n;
  if (n >= 128) return 31;
  int v = 16 + (int)(logf((float)n / 16.f) / 2.0794415416798357f * 16.f);
  return v > 31 ? 31 : v;
}
__device__ __forceinline__ float sigm(float x) { return 1.f / (1.f + expf(-x)); }
__device__ __forceinline__ float gelu_tanh(float x) { return 0.5f * x * (1.f + tanhf(0.7978845608028654f * (x + 0.044715f * x * x * x))); }

#define XB_TMO      128
#define XB_XCNT(j)  (256  + 64 * (j))
#define XB_XSUB(j)  (1280 + 64 * (j))
#define XB_XGEN(j)  (2304 + 64 * (j))
#define XB_TOP      3328
#define XB_TOPGEN   3392
#define XCD_BAR_WORDS 3456
#define XB_SPIN_CAP (1u << 18)

__device__ __forceinline__ unsigned xb_ld(unsigned* p)              { return __hip_atomic_load(p, __ATOMIC_RELAXED, __HIP_MEMORY_SCOPE_AGENT); }
__device__ __forceinline__ unsigned xb_add(unsigned* p, unsigned v) { return __hip_atomic_fetch_add(p, v, __ATOMIC_RELAXED, __HIP_MEMORY_SCOPE_AGENT); }
__device__ __forceinline__ unsigned xb_xcc_id() { return (unsigned)__builtin_amdgcn_s_getreg((3 << 11) | 20) & 0xFu; }
#define XB_SPIN(cond, bar) do { unsigned _sp = 0; while (cond) { __builtin_amdgcn_s_sleep(1); \
    if ((++_sp & 255u) == 0u) { if (xb_ld(&(bar)[XB_TMO])) break; if (_sp > XB_SPIN_CAP) { atomicAdd(&(bar)[XB_TMO], 1u); break; } } } } while (0)

struct XcdBarrier {
    unsigned* bar; unsigned x;
    volatile LAS unsigned* st;
};

__device__ __forceinline__ XcdBarrier xcd_barrier_post(unsigned* bar, volatile LAS unsigned* st) {
    XcdBarrier b; b.bar = bar; b.x = xb_xcc_id(); b.st = st;
    if (mk_tid() == 0) (void)xb_add(&bar[XB_XCNT(b.x)], 1u);
    return b;
}
__device__ __forceinline__ void xcd_barrier_complete(unsigned* bar, unsigned x, unsigned& nloc, unsigned& nx) {
    const unsigned G = gridDim.x * gridDim.y * gridDim.z;
    unsigned sum, cnt, mine, sp = 0u;
    for (;;) {
        sum = 0u; cnt = 0u; mine = 0u;
#pragma unroll
        for (unsigned j = 0; j < 16; ++j) { const unsigned c = xb_ld(&bar[XB_XCNT(j)]); sum += c; cnt += (c > 0u) ? 1u : 0u; mine = (j == x) ? c : mine; }
        if (sum == G) break;
        __builtin_amdgcn_s_sleep(1);
        if ((++sp & 255u) == 0u) { if (xb_ld(&bar[XB_TMO])) break; if (sp > XB_SPIN_CAP) { atomicAdd(&bar[XB_TMO], 1u); break; } }
    }
    nloc = mine > 0u ? mine : 1u; nx = cnt > 0u ? cnt : 1u;
}

__device__ __forceinline__ void xcd_barrier(const XcdBarrier& b) {
    asm volatile("s_waitcnt vmcnt(0)" ::: "memory");
    __syncthreads();
    if (mk_tid() == 0) {
        unsigned* bar = b.bar;
        __builtin_amdgcn_s_waitcnt(0);
        unsigned nloc = b.st[0], nx = b.st[1];
        if (nloc == 0u) { xcd_barrier_complete(bar, b.x, nloc, nx); b.st[0] = nloc; b.st[1] = nx; }
        const unsigned old = xb_add(&bar[XB_XSUB(b.x)], 1u);
        const unsigned gen = old / nloc;
        if (old + 1u == (gen + 1u) * nloc) {
            __builtin_amdgcn_fence(__ATOMIC_RELEASE, "agent");
            asm volatile("s_waitcnt vmcnt(0)" ::: "memory");
            const unsigned og = xb_add(&bar[XB_TOP], 1u);
            const unsigned tg = og / nx;
            if (og + 1u == (tg + 1u) * nx) xb_add(&bar[XB_TOPGEN], 1u);
            else XB_SPIN(xb_ld(&bar[XB_TOPGEN]) == tg, bar);
            __builtin_amdgcn_fence(__ATOMIC_ACQUIRE, "agent");
            xb_add(&bar[XB_XGEN(b.x)], 1u);
            asm volatile("s_waitcnt vmcnt(0)" ::: "memory");
        } else {
            XB_SPIN(xb_ld(&bar[XB_XGEN(b.x)]) == gen, bar);
            __builtin_amdgcn_fence(__ATOMIC_ACQUIRE, "agent");
            asm volatile("s_waitcnt vmcnt(0)" ::: "memory");
        }
    }
    __syncthreads();
}

struct Params {
  const float* in[28]; float* out; unsigned char* ws; int ph_lo, ph_hi, li, pad;
};

__device__ __forceinline__ void tr_item(const float* W, int ldn, int k0, int nsrc0, int nvalid, bf16* WT, int K, int dstrow0, LAS float* scr, int lane) {
#pragma unroll 8
  for (int i = 0; i < 32; ++i) { const int kk = 2 * i + (lane >> 5), c = lane & 31; scr[kk * 33 + c] = (c < nvalid) ? W[(size_t)(k0 + kk) * ldn + nsrc0 + c] : 0.f; }
  asm volatile("s_waitcnt lgkmcnt(0)" ::: "memory");
  const int c = lane & 7;
#pragma unroll
  for (int j = 0; j < 4; ++j) { const int n = (lane >> 3) + 8 * j; const LAS float* s = scr + (8 * c) * 33 + n;
    v4u o; o.x = pk2(s[0 * 33], s[1 * 33]); o.y = pk2(s[2 * 33], s[3 * 33]); o.z = pk2(s[4 * 33], s[5 * 33]); o.w = pk2(s[6 * 33], s[7 * 33]);
    *(v4u*)(WT + (size_t)(dstrow0 + n) * K + k0 + 8 * c) = o; }
  asm volatile("s_waitcnt lgkmcnt(0)" ::: "memory");
}
__device__ __forceinline__ void proj_src(int c, int& src, int& nv) {
  const int pn = c >> 8, bj = (c >> 7) & 1, wc = (c >> 5) & 3, grp = 4 * pn + wc, dim0 = 32 * bj;
  if (grp < 20) { src = grp * 64 + dim0; nv = 32; } else if (grp == 20) { src = 1280 + dim0; nv = bj == 0 ? 24 : 0; } else if (grp < 49) { src = 1304 + (grp - 21) * 64 + dim0; nv = 32; } else { src = 0; nv = 0; }
}
__device__ __forceinline__ void rms_row_to_bf16(const float* xrow, const float* g, bf16* orow, int lane) {
  const f32x4* xr = (const f32x4*)xrow + lane; const f32x4* gr = (const f32x4*)g + lane;
  f32x4 v[4]; float s = 0.f;
#pragma unroll
  for (int j = 0; j < 4; ++j) { v[j] = xr[64 * j]; s += (v[j].x * v[j].x + v[j].y * v[j].y) + (v[j].z * v[j].z + v[j].w * v[j].w); }
  const float r = rsqrtf(wsum(s) * (1.f / D_) + 1e-6f);
  unsigned long long* o8 = (unsigned long long*)orow + lane;
#pragma unroll
  for (int j = 0; j < 4; ++j) { const f32x4 gg = gr[64 * j]; o8[64 * j] = (unsigned long long)pk2(v[j].x * r * gg.x, v[j].y * r * gg.y) | ((unsigned long long)pk2(v[j].z * r * gg.z, v[j].w * r * gg.w) << 32); }
}

__device__ __forceinline__ void phase_prologue(const Params& p, LAS unsigned char* lds, int wave, int lane) {
  LAS float* scr = (LAS float*)(lds + wave * 16384);
  const int gw = blockIdx.x * NWAVES + wave, NGW = gridDim.x * NWAVES;
  const float* w_in = p.in[2]; const float* w_out = p.in[22]; const float* ffn_up = p.in[24]; const float* ffn_down = p.in[27];
  bf16* WIN = (bf16*)(p.ws + WS_WIN); bf16* WOUT = (bf16*)(p.ws + WS_WOUT); bf16* WUP = (bf16*)(p.ws + WS_WUP); bf16* WDN = (bf16*)(p.ws + WS_WDN);
  constexpr int I_IN = 16 * (NPROJ / 32), I_OUT = 16 * 32, I_UP = 16 * (2 * DFF / 32), I_DN = 44 * 32, I_CW = 2 * 32 * 4, NITEMS = I_IN + I_OUT + I_UP + I_DN + I_CW;
  for (int it = gw; it < NITEMS; it += NGW) {
    int r = it;
    if (r < I_IN) { const int nr = NPROJ / 32, kb = r / nr, run = r % nr; int src, nv; proj_src(32 * run, src, nv); tr_item(w_in, DIN, 64 * kb, src, nv, WIN, D_, 32 * run, scr, lane); continue; } r -= I_IN;
    if (r < I_OUT) { const int kb = r / 32, run = r % 32; tr_item(w_out, D_, 64 * kb, 32 * run, 32, WOUT, D_, 32 * run, scr, lane); continue; } r -= I_OUT;
    if (r < I_UP) { const int nr = 2 * DFF / 32, kb = r / nr, run = r % nr; const int c = 32 * run; const int src = ((c >> 7) & 1) * DFF + 128 * (c >> 8) + (c & 127);
      tr_item(ffn_up, 2 * DFF, 64 * kb, src, 32, WUP, D_, c, scr, lane); continue; } r -= I_UP;
    if (r < I_DN) { const int kb = r / 32, run = r % 32; tr_item(ffn_down, D_, 64 * kb, 32 * run, 32, WDN, DFF, 32 * run, scr, lane); continue; } r -= I_DN;
    { const int kv = r >> 7, kb = (r >> 2) & 31, run = r & 3; tr_item(p.in[6] + (size_t)kv * 2048 * 128, 128, 64 * kb, 32 * run, 32, (bf16*)(p.ws + WS_CW1T) + (size_t)kv * 128 * 2048, 2048, 32 * run, scr, lane); }
  }
  { bf16* LW = (bf16*)(p.ws + WS_LORAW); const float* w2 = p.in[13]; const float* a2 = p.in[15]; const float* g2 = p.in[16];
    for (int i = blockIdx.x * NTHREADS + wave * 64 + lane; i < NLORA * KLORA; i += gridDim.x * NTHREADS) { const int n = i >> 8, k = i & 255; float v = 0.f;
      if (n < 512) { if (k < 64) v = w2[k * 512 + n]; } else if (n < 1024) { if (k >= 64 && k < 128) v = a2[(k - 64) * 512 + n - 512]; } else { if (k >= 128) v = g2[(k - 128) * 512 + n - 1024]; }
      LW[i] = (bf16)f2bf(v); } }
  { float* b1p = (float*)(p.ws + WS_B1P); const float* pos = p.in[5]; const float* w1 = p.in[6]; const float* b1 = p.in[7];
    for (int o = gw; o < 256; o += NGW) { const int kv = o >> 7, j = o & 127; float s = 0.f;
      for (int k = lane; k < 2048; k += 64) s += pos[kv * 2048 + k] * w1[((size_t)kv * 2048 + k) * 128 + j];
      s = wsum(s); if (lane == 0) b1p[o] = s + b1[o]; } }
  { const float* x = p.in[0]; const float* g = p.in[1]; bf16* XN = (bf16*)(p.ws + WS_XN);
    for (int m = gw; m < M_; m += NGW) rms_row_to_bf16(x + (size_t)m * D_, g, XN + (size_t)m * D_, lane); }
}

__device__ __forceinline__ void phase_mid(const Params& p, LAS unsigned char* lds, int wave, int lane) {
  const int tid = wave * 64 + lane;
  {
    LAS bf16* blk = (LAS bf16*)lds;
    LAS float* hid = (LAS float*)(lds + 16 * 2056 * 2);
    const float* w2 = p.in[8]; const float* b2 = p.in[9]; const float* kg0 = p.in[4]; const float* b1p = (const float*)(p.ws + WS_B1P);
    const bf16* CW1T = (const bf16*)(p.ws + WS_CW1T);
    bf16* CMP = (bf16*)(p.ws + WS_CMP);
    const int col = lane & 15, q = lane >> 4;
    for (int it = blockIdx.x; it < 256; it += gridDim.x) {
      const int kv = it >> 7, slab = (it >> 5) & 3, ct = it & 31, c0 = ct * 16;
      const bf16* src = (const bf16*)(p.ws + WS_SLAB) + ((size_t)kv * 4 + slab) * (8192 * 64) + (size_t)c0 * 16 * 64;
      for (int i = tid; i < 16 * 256; i += NTHREADS) { const int c = i >> 8, ch8 = i & 255; v4u v = {0u, 0u, 0u, 0u}; if ((c0 + c) * 16 + (ch8 >> 3) < 8192) v = *(const v4u*)(src + (size_t)c * 1024 + ch8 * 8); *(LAS v4u*)(blk + c * 2056 + ch8 * 8) = v; }
      __syncthreads();
      {
        f32x4 acc0 = {0.f, 0.f, 0.f, 0.f}, acc1 = {0.f, 0.f, 0.f, 0.f};
        const bf16* bp = CW1T + ((size_t)kv * 128 + 16 * wave + col) * 2048 + 8 * q; const LAS bf16* ap = blk + col * 2056 + 8 * q;
#pragma unroll 16
        for (int ks = 0; ks < 64; ks += 2) {
          acc0 = __builtin_amdgcn_mfma_f32_16x16x32_bf16(*(const LAS bf16x8*)(ap + 32 * ks), *(const bf16x8*)(bp + 32 * ks), acc0, 0, 0, 0);
          acc1 = __builtin_amdgcn_mfma_f32_16x16x32_bf16(*(const LAS bf16x8*)(ap + 32 * ks + 32), *(const bf16x8*)(bp + 32 * ks + 32), acc1, 0, 0, 0); }
        const float bb = b1p[kv * 128 + 16 * wave + col];
#pragma unroll
        for (int r = 0; r < 4; ++r) hid[(4 * q + r) * 128 + 16 * wave + col] = gelu_tanh(acc0[r] + acc1[r] + bb);
      }
      __syncthreads();
#pragma unroll
      for (int cc = 0; cc < 2; ++cc) { const int c = wave * 2 + cc; float o = b2[kv * 64 + lane];
        for (int k = 0; k < 128; ++k) o += hid[c * 128 + k] * w2[((size_t)kv * 128 + k) * 64 + lane];
        if (kv == 0) { const float ss = wsum(o * o); o = o * rsqrtf(ss * (1.f / 64.f) + 1e-6f) * kg0[lane]; }
        CMP[(((size_t)kv * 4 + slab) * 512 + c0 + c) * 64 + lane] = (c0 + c < 511) ? (bf16)f2bf(o) : (bf16)0; }
      __syncthreads();
    }
  }
  {
    const bf16* RW = (const bf16*)(p.ws + WS_RW); bf16* ACT = (bf16*)(p.ws + WS_ACT); const float* mu = p.in[11];
    const int gw = blockIdx.x * NWAVES + wave, NGW = gridDim.x * NWAVES;
    for (int m = gw; m < M_; m += NGW) {
      const int t = m & (T_ - 1); const bf16* cur = RW + (size_t)m * 1792 + 1536 + lane * 4; float o[4];
#pragma unroll
      for (int i = 0; i < 4; ++i) { const float c = bf2f(cur[i]); const float pv = t > 0 ? bf2f(cur[i - 1792]) : 0.f; const float v = c + (pv - c) * mu[1536 + lane * 4 + i];
        o[i] = (lane < 16) ? tanhf(v) : (lane < 32) ? v : sigm(v); }
      *(unsigned long long*)(ACT + (size_t)m * 256 + lane * 4) = (unsigned long long)pk2(o[0], o[1]) | ((unsigned long long)pk2(o[2], o[3]) << 32);
    }
  }
}

__device__ __forceinline__ rwkv::Tensors rwkv_tensors(const Params& p) {
  const size_t CB = (size_t)16 * 128 * 4096; bf16* CH = (bf16*)p.out;
  rwkv::Tensors T{(const bf16*)(p.ws + WS_RW), (const bf16*)(p.ws + WS_LORA), p.in[11], p.in[12], p.in[14], p.in[17], p.in[18], p.in[19], p.in[20], p.in[21],
                  CH, CH + CB, CH + 2 * CB, CH + 3 * CB, (bf16*)(p.ws + WS_HT), (float*)(p.ws + WS_PC), (float*)(p.ws + WS_BON), (bf16*)(p.ws + WS_VM), (bf16*)(p.ws + WS_MIX)};
  return T;
}
__device__ __forceinline__ void phase_p1(const Params& p, LAS unsigned char* lds) {
  const rwkv::Tensors T = rwkv_tensors(p);
  for (int it = blockIdx.x; it < 16 * 128; it += gridDim.x) rwkv::p1_item(T, it >> 7, it & 127, lds);
}
__device__ __forceinline__ void phase_attn(const Params& p, LAS unsigned char* lds, int wave, int lane, int rep) {
  if (blockIdx.x < 16) {
    { const rwkv::Tensors T = rwkv_tensors(p); rwkv::scan_block(T, blockIdx.x, lds, wave, lane); }
  }
  if (p.pad == 1) return;
  if (p.pad == 2 && blockIdx.x < 16) { }
  const bf16* SL = (const bf16*)(p.ws + WS_SLAB); const size_t SS = (size_t)4 * 8192 * 64;
  nsa::Tensors T{(const bf16*)(p.ws + WS_Q), SL + 2 * SS, SL + 3 * SS, SL + 4 * SS, SL + 5 * SS, (const bf16*)(p.ws + WS_CMP), (const bf16*)(p.ws + WS_CMP) + (size_t)4 * 512 * 64,
                 (const float*)(p.ws + WS_GATES), p.in[10], (bf16*)(p.ws + WS_MIX)};
  unsigned* ctr = (unsigned*)(p.ws + WS_CTL) + rep * 4;
  const int home = (blockIdx.x & 7) >> 1;
  for (int qi = 0; qi < 4; ++qi) {
    const int slab = (home + qi) & 3;
    for (;;) {
      int noff = nsa::L_BYTES; asm volatile("" : "+s"(noff)); LAS unsigned* nxt = (LAS unsigned*)(lds + noff);
      if (mk_tid() == 0) *nxt = atomicAdd(ctr + slab, 1u);
      __syncthreads();
      const unsigned i = (unsigned)__builtin_amdgcn_readfirstlane((int)*nxt);
      __syncthreads();
      if (i >= 128u) break;
      nsa::unit(T, slab >> 1, slab & 1, 127 - (int)i, lds);
    }
  }
}
__device__ __forceinline__ void phase_p2(const Params& p, int wave, int lane) {
  const rwkv::Tensors T = rwkv_tensors(p);
  const int gw = blockIdx.x * NWAVES + wave, NGW = gridDim.x * NWAVES;
  for (int w = gw; w < 16 * 128; w += NGW) rwkv::p2_item(T, w >> 7, w & 127, lane);
}

__device__ __forceinline__ void phase_rms2(const Params& p, int wave, int lane) {
  const int gw = blockIdx.x * NWAVES + wave, NGW = gridDim.x * NWAVES; bf16* XN = (bf16*)(p.ws + WS_XN);
  for (int m = gw; m < M_; m += NGW) rms_row_to_bf16(p.out + (size_t)m * D_, p.in[23], XN + (size_t)m * D_, lane);
}
constexpr int NPHASE = 11;
#ifndef REP_MASK
#define REP_MASK 0u
#endif
__global__ void __launch_bounds__(NTHREADS, 2) mk_fwd(Params p) {
  extern __shared__ __attribute__((aligned(16))) unsigned char lds_raw[];
  LAS unsigned char* lds = (LAS unsigned char*)lds_raw;
  cg::grid_group grid = cg::this_grid();
  volatile LAS unsigned* bst = (volatile LAS unsigned*)(lds + LDS_BYTES - 64);
  if (threadIdx.x < 16) bst[threadIdx.x] = 0u;
  mk_tid_init();
  __syncthreads();
  XcdBarrier xbar = xcd_barrier_post((unsigned*)(p.ws + WS_CTL) + 1024 + p.li * XCD_BAR_WORDS, bst);
  const int lo = p.ph_lo, hi = p.ph_hi;
#define IN(k) (lo <= (k) && (k) < hi)
#define SEAM(k) do { if (IN(k) && IN((k) + 1)) { if ((k) == 0) grid.sync(); else xcd_barrier(xbar); } } while (0)
  unsigned char* ws = p.ws;
#define LW int tid_ = mk_tid(); asm volatile("" : "+v"(tid_)); const int lane = tid_ & 63, wave = __builtin_amdgcn_readfirstlane(tid_ >> 6); (void)lane; (void)wave;
#define PH(k, ...) do { if (IN(k)) { _Pragma("unroll 1") for (int rep_ = 0; rep_ < 1 + (int)((REP_MASK >> (k)) & 1u); ++rep_) { if (rep_) grid.sync(); __VA_ARGS__ } } SEAM(k); } while (0)
  PH(0, { LW phase_prologue(p, lds, wave, lane); });
  PH(1, { pg8::Gemm g{(const pg8::bf16_t*)(ws + WS_XN), (const pg8::bf16_t*)(ws + WS_WIN), M_, NPROJ, D_}; pg8::StaticOrder S; S.init(M_, NPROJ, gridDim.x, blockIdx.x);
    pg8::EpiProj E{(pg8::bf16_t*)(ws + WS_Q), (pg8::bf16_t*)(ws + WS_SLAB), (pg8::bf16_t*)(ws + WS_RW), (float*)(ws + WS_GATES), p.in[3], p.in[4]};
    pg8::gemm_phase<pg8::EpiProj, pg8::StaticOrder, true, true>(lds, g, S, E); });
  PH(2, { LW phase_mid(p, lds, wave, lane); });
  PH(3, { pg8::Gemm g{(const pg8::bf16_t*)(ws + WS_ACT), (const pg8::bf16_t*)(ws + WS_LORAW), M_, NLORA, KLORA}; pg8::StaticOrder S; S.init(M_, NLORA, gridDim.x, blockIdx.x);
    pg8::EpiBf16<0> E{(pg8::bf16_t*)(ws + WS_LORA), NLORA, nullptr, 0, 0, 1.f};
    pg8::gemm_phase<pg8::EpiBf16<0>, pg8::StaticOrder, true, true>(lds, g, S, E); });
  PH(4, { phase_p1(p, lds); });
  PH(5, { LW phase_attn(p, lds, wave, lane, rep_); });
  PH(6, { LW phase_p2(p, wave, lane); });
  PH(7, { pg8::Gemm g{(const pg8::bf16_t*)(ws + WS_MIX), (const pg8::bf16_t*)(ws + WS_WOUT), M_, D_, D_}; pg8::StaticOrder S; S.init(M_, D_, gridDim.x, blockIdx.x);
    pg8::EpiResF32 E{p.in[0], p.out, D_};
    pg8::gemm_phase<pg8::EpiResF32, pg8::StaticOrder, true, true>(lds, g, S, E); });
  PH(8, { LW phase_rms2(p, wave, lane); });
  PH(9, { pg8::Gemm g{(const pg8::bf16_t*)(ws + WS_XN), (const pg8::bf16_t*)(ws + WS_WUP), 66 * 256, 2 * DFF, D_}; pg8::StaticOrder S; S.init(66 * 256, 2 * DFF, gridDim.x, blockIdx.x);
    pg8::EpiConvGate E{(pg8::bf16_t*)(ws + WS_ACT2), p.in[25], p.in[26]};
    pg8::gemm_phase<pg8::EpiConvGate, pg8::StaticOrder, true, true, 1>(lds, g, S, E); });
  if (IN(10)) { pg8::Gemm g{(const pg8::bf16_t*)(ws + WS_ACT2), (const pg8::bf16_t*)(ws + WS_WDN), M_, D_, DFF}; pg8::StaticOrder S; S.init(M_, D_, gridDim.x, blockIdx.x);
    pg8::EpiResF32 E{p.out, p.out, D_};
    pg8::gemm_phase<pg8::EpiResF32, pg8::StaticOrder, true, true>(lds, g, S, E); }
#undef PH
#undef IN
#undef SEAM
}
}

#ifndef MK_N_LAUNCHES
#define MK_N_LAUNCHES 1
#endif
extern "C" void kernel_launch(void* const* d_in, const int* in_sizes, int n_in, void* d_out, int out_size, void* d_ws, size_t ws_size, hipStream_t stream) {
  static int grid = 0;
  if (grid == 0) {
    if (n_in != 28 || out_size != M_ * D_ || ws_size < WS_END) { fprintf(stderr, "kernel_launch: unexpected shapes (n_in %d out %d ws %zu)\n", n_in, out_size, ws_size); grid = -1; return; }
    int dev = 0, cus = 0, per_cu = 0; hipGetDevice(&dev); hipDeviceGetAttribute(&cus, hipDeviceAttributeMultiprocessorCount, dev);
    if (hipFuncSetAttribute((const void*)mk_fwd, hipFuncAttributeMaxDynamicSharedMemorySize, LDS_BYTES) != hipSuccess) { fprintf(stderr, "kernel_launch: hipFuncSetAttribute failed\n"); grid = -1; return; }
    if (hipOccupancyMaxActiveBlocksPerMultiprocessor(&per_cu, (const void*)mk_fwd, NTHREADS, LDS_BYTES) != hipSuccess || per_cu < 1) { fprintf(stderr, "kernel_launch: occupancy query says %d\n", per_cu); (void)hipGetLastError(); per_cu = 1; }
    grid = cus;
    fprintf(stderr, "kernel_launch: cus %d per_cu %d grid %d\n", cus, per_cu, grid);
  }
  if (grid < 0) return;
  Params p{};
  for (int i = 0; i < 28; ++i) p.in[i] = (const float*)d_in[i];
  p.out = (float*)d_out; p.ws = (unsigned char*)d_ws;
#ifndef PROBE_SUB
#define PROBE_SUB 0
#endif
#ifndef PROBE_PHASE
#define PROBE_PHASE -1
#endif
  if (hipMemsetAsync((char*)d_ws + WS_CTL, 0, 65536, stream) != hipSuccess) { fprintf(stderr, "kernel_launch: memset failed\n"); return; }
  const int nl = (PROBE_PHASE >= 0) ? 3 : MK_N_LAUNCHES;
  for (int li = 0; li < nl; ++li) {
    if (PROBE_PHASE >= 0) { p.ph_lo = li == 0 ? 0 : (li == 1 ? PROBE_PHASE : PROBE_PHASE + 1); p.ph_hi = li == 0 ? PROBE_PHASE + 1 : (li == 1 ? PROBE_PHASE + 1 : NPHASE); if (p.ph_lo >= p.ph_hi) continue; }
    else { p.ph_lo = (MK_N_LAUNCHES == 1) ? 0 : li; p.ph_hi = (MK_N_LAUNCHES == 1) ? NPHASE : li + 1; }
    p.li = li; p.pad = (PROBE_PHASE == 5 && li == 1) ? PROBE_SUB : 0; void* args[] = {&p};
    hipError_t e = hipLaunchCooperativeKernel((const void*)mk_fwd, dim3(grid), dim3(NTHREADS), args, LDS_BYTES, stream);
    if (e != hipSuccess) { fprintf(stderr, "kernel_launch: cooperative launch %d failed: %s\n", li, hipGetErrorString(e)); break; }
  }
}
```
